# Optimizing an MI355X kernel written in HIP

```python
import math
import jax
import jax.numpy as jnp
from jax import lax
import numpy as np

D_MODEL = 2048
BATCH = 4
SEQ = 2048
DEPTH = 1

GRID_W = 64
CTX_LEN = 256
EPS = 1e-6
N_MOD = 6

S5_WIDTH = D_MODEL // 2
S5_GROUP = 16
S5_GROUPS = S5_WIDTH // S5_GROUP
S5_STATE = 64
S5_DT_MIN = 0.001
S5_DT_MAX = 0.1

GLA_HEADS = 4
GLA_KEY_WIDTH = D_MODEL // 4
GLA_VAL_WIDTH = D_MODEL // 2
GLA_DK = GLA_KEY_WIDTH // GLA_HEADS
GLA_DV = GLA_VAL_WIDTH // GLA_HEADS
GLA_GATE_RANK = 16
GLA_GATE_NORM = 16.0
GLA_CHUNK = 64

IN_SPLITS = (S5_WIDTH, GLA_KEY_WIDTH, GLA_KEY_WIDTH, GLA_VAL_WIDTH, GLA_VAL_WIDTH, 2 * GLA_GATE_RANK, D_MODEL, D_MODEL)
IN_WIDTH = sum(IN_SPLITS)

N_EXPERTS = 64
TOP_K = 8
N_GROUPS = 8
TOPK_GROUPS = 4
D_EXPERT = D_MODEL // 4
D_SHARED = D_MODEL // 4
ROUTED_SCALE = 2.5
EXPERT_BLOCK = 128

kernel_name = 'hybrid_s5_gla_moe_diffusion_block'


def _flip(t):
    return jnp.flip(t, axis=1)


def _ident(t):
    return t


def rmsnorm(x, w):
    xf = x.astype(jnp.float32)
    y = xf * lax.rsqrt(jnp.mean(xf * xf, axis=-1, keepdims=True) + EPS)
    return (y * w.astype(jnp.float32)).astype(x.dtype)


def modulate(x, w, shift, scale):
    return rmsnorm(x, w) * (1.0 + scale) + shift


def s5_discretize(lam_re, lam_im, log_dt, b_re, b_im):
    lam = lax.complex(lam_re.astype(jnp.float32), lam_im.astype(jnp.float32))
    dt = jnp.exp(log_dt.astype(jnp.float32))[:, None]
    lam_bar = jnp.exp(lam * dt)
    b = lax.complex(b_re.astype(jnp.float32), b_im.astype(jnp.float32))
    b_bar = ((lam_bar - 1.0) / lam)[..., None] * b
    return lam_bar, b_bar


def _linear_recurrence(e1, e2):
    a1, b1 = e1
    a2, b2 = e2
    return a1 * a2, a2 * b1 + b2


def s5_scan(u, lam_bar, b_bar, h0):
    bu = jnp.einsum('blgh,gph->blgp', u.astype(jnp.complex64), b_bar)
    if h0 is not None:
        bu = bu.at[:, 0].add(lam_bar * h0)
    a = jnp.broadcast_to(lam_bar, bu.shape)
    _, hs = lax.associative_scan(_linear_recurrence, (a, bu), axis=1)
    return hs


def s5_readout(hs, c_mat):
    return jnp.einsum('blgp,ghp->blgh', hs, c_mat).real


def s5_bidir(u, uc, lam_re, lam_im, log_dt, b_re, b_im, c_re, c_im, d_skip, ctx_out):
    def grp(t):
        return t.astype(jnp.float32).reshape(t.shape[0], t.shape[1], S5_GROUPS, S5_GROUP)
    ug, ucg = grp(u), grp(uc)
    dsk = d_skip.astype(jnp.float32).reshape(S5_GROUPS, S5_GROUP)
    y = dsk * ug
    yc = dsk * ucg if ctx_out else None
    for dr in range(2):
        flip = _flip if dr else _ident
        lam_bar, b_bar = s5_discretize(lam_re[dr], lam_im[dr], log_dt[dr], b_re[dr], b_im[dr])
        c_mat = lax.complex(c_re[dr].astype(jnp.float32), c_im[dr].astype(jnp.float32))
        hs_c = s5_scan(flip(ucg), lam_bar, b_bar, None)
        hs = s5_scan(flip(ug), lam_bar, b_bar, hs_c[:, -1])
        y = y + flip(s5_readout(hs, c_mat))
        if ctx_out:
            yc = yc + flip(s5_readout(hs_c, c_mat))
    y = y.reshape(u.shape).astype(u.dtype)
    if ctx_out:
        yc = yc.reshape(uc.shape).astype(uc.dtype)
    return y, yc


def s5_glu(y, w):
    y = jax.nn.gelu(y)
    return y * jax.nn.sigmoid(y @ w)


def gla_states(k, v, b, s0):
    b_last = b[:, :, :, -1:, :]
    ds = jnp.einsum('bhnck,bhncv->bhnkv', k * jnp.exp(b_last - b), v)
    decay = jnp.exp(b_last[:, :, :, 0, :])

    def step(s, xs):
        d, dsn = xs
        return d[..., None] * s + dsn, s

    s_final, starts = lax.scan(step, s0, (jnp.moveaxis(decay, 2, 0), jnp.moveaxis(ds, 2, 0)))
    return jnp.moveaxis(starts, 0, 2), s_final


def gla_readout(q, k, v, b, starts, strict):
    qb = q * jnp.exp(b)
    kb = k * jnp.exp(-b)
    scores = jnp.einsum('bhnik,bhnjk->bhnij', qb, kb)
    mask = jnp.tril(jnp.ones((GLA_CHUNK, GLA_CHUNK), bool), k=-1 if strict else 0)
    intra = jnp.einsum('bhnij,bhnjv->bhniv', jnp.where(mask, scores, 0.0), v)
    inter = jnp.einsum('bhnik,bhnkv->bhniv', qb, starts)
    return intra + inter


def gla_bidir(q, k, v, gkd, qc, kc, vc, gkdc, gk_up, gk_b, ctx_out):
    f32 = jnp.float32

    def chunks(t, d, flip):
        t = flip(t.astype(f32))
        b_, l_ = t.shape[:2]
        t = t.reshape(b_, l_, GLA_HEADS, d).transpose(0, 2, 1, 3)
        return t.reshape(b_, GLA_HEADS, l_ // GLA_CHUNK, GLA_CHUNK, d)

    def unchunk(t, flip):
        b_, h_, n_, c_, d_ = t.shape
        t = t.reshape(b_, h_, n_ * c_, d_).transpose(0, 2, 1, 3)
        return flip(t.reshape(b_, n_ * c_, h_ * d_))

    def log_decay(gd, dr):
        z = gd[..., dr * GLA_GATE_RANK:(dr + 1) * GLA_GATE_RANK] @ gk_up[dr] + gk_b[dr]
        return jax.nn.log_sigmoid(z.astype(f32)) / GLA_GATE_NORM

    q = q * GLA_DK ** -0.5
    qc = qc * GLA_DK ** -0.5
    s0 = jnp.zeros((kc.shape[0], GLA_HEADS, GLA_DK, GLA_DV), f32)
    o, oc = 0.0, 0.0
    for dr in range(2):
        flip = _flip if dr else _ident
        strict = dr == 1
        kcn, vcn = chunks(kc, GLA_DK, flip), chunks(vc, GLA_DV, flip)
        bcn = jnp.cumsum(chunks(log_decay(gkdc, dr), GLA_DK, flip), axis=3)
        starts_c, s_ctx = gla_states(kcn, vcn, bcn, s0)
        kn, vn = chunks(k, GLA_DK, flip), chunks(v, GLA_DV, flip)
        bn = jnp.cumsum(chunks(log_decay(gkd, dr), GLA_DK, flip), axis=3)
        starts, _ = gla_states(kn, vn, bn, s_ctx)
        o = o + unchunk(gla_readout(chunks(q, GLA_DK, flip), kn, vn, bn, starts, strict), flip)
        if ctx_out:
            oc = oc + unchunk(gla_readout(chunks(qc, GLA_DK, flip), kcn, vcn, bcn, starts_c, strict), flip)
    return o, (oc if ctx_out else None)


def gla_output(o, go, norm_w):
    b_, l_ = o.shape[:2]
    oh = rmsnorm(o.reshape(b_, l_, GLA_HEADS, GLA_DV), norm_w).reshape(b_, l_, GLA_VAL_WIDTH)
    return oh.astype(go.dtype) * jax.nn.silu(go)


def token_mixer(h, hc, w_in, lam_re, lam_im, log_dt, b_re, b_im, c_re, c_im, d_skip,
                glu_w, gk_up, gk_b, gla_norm_w, w_s5_proj, w_gla_proj, w_out, ctx_out):
    cuts = [int(v) for v in np.cumsum(IN_SPLITS)[:-1]]
    u, q, k, v, go, gkd, gs, gg = jnp.split(h @ w_in, cuts, axis=-1)
    uc, qc, kc, vc, goc, gkdc, gsc, ggc = jnp.split(hc @ w_in, cuts, axis=-1)
    ys, ysc = s5_bidir(u, uc, lam_re, lam_im, log_dt, b_re, b_im, c_re, c_im, d_skip, ctx_out)
    yg, ygc = gla_bidir(q, k, v, gkd, qc, kc, vc, gkdc, gk_up, gk_b, ctx_out)

    def merge(ys_, yg_, go_, gs_, gg_):
        a = s5_glu(ys_, glu_w) @ w_s5_proj
        b = gla_output(yg_, go_, gla_norm_w) @ w_gla_proj
        return (jax.nn.sigmoid(gs_) * a + jax.nn.sigmoid(gg_) * b) @ w_out

    y = merge(ys, yg, go, gs, gg)
    yc = merge(ysc, ygc, goc, gsc, ggc) if ctx_out else None
    return y, yc


def moe(h, router_w, router_bias, w_gate, w_up, w_down, s_gate, s_up, s_down):
    shp = h.shape
    t = h.reshape(-1, D_MODEL)
    n_tok = t.shape[0]
    scores = jax.nn.sigmoid((t @ router_w).astype(jnp.float32))
    choice = scores + router_bias.astype(jnp.float32)
    grp = choice.reshape(n_tok, N_GROUPS, N_EXPERTS // N_GROUPS)
    grp_score = lax.top_k(grp, 2)[0].sum(-1)
    _, gidx = lax.top_k(grp_score, TOPK_GROUPS)
    gmask = jax.nn.one_hot(gidx, N_GROUPS).sum(axis=1) > 0
    emask = jnp.repeat(gmask, N_EXPERTS // N_GROUPS, axis=1)
    _, eidx = lax.top_k(jnp.where(emask, choice, -jnp.inf), TOP_K)
    wts = jnp.take_along_axis(scores, eidx, axis=1)
    wts = wts / jnp.sum(wts, axis=-1, keepdims=True) * ROUTED_SCALE

    n_asg = n_tok * TOP_K
    n_blocks = (n_asg + N_EXPERTS * (EXPERT_BLOCK - 1) + EXPERT_BLOCK - 1) // EXPERT_BLOCK
    flat_e = eidx.reshape(-1)
    order = jnp.argsort(flat_e)
    sorted_e = flat_e[order]
    sizes = jnp.bincount(flat_e, length=N_EXPERTS)
    padded = (sizes + EXPERT_BLOCK - 1) // EXPERT_BLOCK * EXPERT_BLOCK
    pad_ends = jnp.cumsum(padded)
    rank = jnp.arange(n_asg) - (jnp.cumsum(sizes) - sizes)[sorted_e]
    dest = (pad_ends - padded)[sorted_e] + rank
    row_buf = jnp.full((n_blocks * EXPERT_BLOCK,), n_tok, jnp.int32).at[dest].set((order // TOP_K).astype(jnp.int32))
    w_buf = jnp.zeros((n_blocks * EXPERT_BLOCK,), jnp.float32).at[dest].set(wts.reshape(-1)[order])
    block_e = jnp.minimum(jnp.searchsorted(pad_ends, jnp.arange(n_blocks) * EXPERT_BLOCK, side='right'), N_EXPERTS - 1)
    t_pad = jnp.concatenate([t, jnp.zeros((1, D_MODEL), t.dtype)], axis=0)

    def expert_block(args):
        rows, e = args
        xb = t_pad[rows]
        hid = jax.nn.silu(xb @ w_gate[e]) * (xb @ w_up[e])
        return hid @ w_down[e]

    y_buf = lax.map(expert_block, (row_buf.reshape(n_blocks, EXPERT_BLOCK), block_e))
    y_buf = y_buf.reshape(n_blocks * EXPERT_BLOCK, D_MODEL) * w_buf[:, None].astype(t.dtype)
    routed = jax.ops.segment_sum(y_buf, row_buf, num_segments=n_tok + 1)[:n_tok]
    shared = (jax.nn.silu(t @ s_gate) * (t @ s_up)) @ s_down
    return (routed + shared).reshape(shp)


def setup_inputs(seed: int = 0) -> dict:
    key = jax.random.key(seed)
    ks = iter(list(jax.random.split(key, 40)))
    f32 = jnp.float32

    def nrm(shape, scale):
        return jax.random.normal(next(ks), shape, f32) * scale

    L, D, E, F = DEPTH, D_MODEL, N_EXPERTS, D_EXPERT
    G, P, H = S5_GROUPS, S5_STATE, S5_GROUP
    lam_im_init = jnp.pi * jnp.arange(P, dtype=f32)
    return {
        'x': nrm((BATCH, SEQ, D), 1.0),
        'c': nrm((BATCH, D), 1.0),
        'ctx': nrm((BATCH, CTX_LEN, D), 1.0),
        'c_ctx': nrm((D,), 1.0),
        'ada_w': nrm((L, D, N_MOD * D), 0.5 * D ** -0.5),
        'ada_b': nrm((L, N_MOD * D), 0.01),
        'norm1_w': 1.0 + nrm((L, D), 0.02),
        'norm2_w': 1.0 + nrm((L, D), 0.02),
        'w_in': nrm((L, D, IN_WIDTH), D ** -0.5),
        's5_lam_re': -0.5 + nrm((L, 2, G, P), 0.01),
        's5_lam_im': lam_im_init + nrm((L, 2, G, P), 0.01),
        's5_log_dt': jax.random.uniform(next(ks), (L, 2, G), f32, math.log(S5_DT_MIN), math.log(S5_DT_MAX)),
        's5_b_re': nrm((L, 2, G, P, H), (2 * H) ** -0.5),
        's5_b_im': nrm((L, 2, G, P, H), (2 * H) ** -0.5),
        's5_c_re': nrm((L, 2, G, H, P), P ** -0.5),
        's5_c_im': nrm((L, 2, G, H, P), P ** -0.5),
        's5_d': nrm((L, S5_WIDTH), 1.0),
        's5_glu_w': nrm((L, S5_WIDTH, S5_WIDTH), S5_WIDTH ** -0.5),
        'gla_gk_up': nrm((L, 2, GLA_GATE_RANK, GLA_KEY_WIDTH), GLA_GATE_RANK ** -0.5),
        'gla_gk_b': nrm((L, 2, GLA_KEY_WIDTH), 0.1),
        'gla_norm_w': 1.0 + nrm((L, GLA_DV), 0.02),
        'w_s5_proj': nrm((L, S5_WIDTH, D), S5_WIDTH ** -0.5),
        'w_gla_proj': nrm((L, GLA_VAL_WIDTH, D), GLA_VAL_WIDTH ** -0.5),
        'w_out': nrm((L, D, D), D ** -0.5),
        'router_w': nrm((L, D, E), D ** -0.5),
        'router_bias': nrm((L, E), 0.01),
        'exp_w_gate': nrm((L, E, D, F), D ** -0.5),
        'exp_w_up': nrm((L, E, D, F), D ** -0.5),
        'exp_w_down': nrm((L, E, F, D), F ** -0.5),
        'sh_w_gate': nrm((L, D, D_SHARED), D ** -0.5),
        'sh_w_up': nrm((L, D, D_SHARED), D ** -0.5),
        'sh_w_down': nrm((L, D_SHARED, D), D_SHARED ** -0.5),
        'final_norm_w': 1.0 + nrm((D,), 0.02),
    }


def reference(x, c, ctx, c_ctx, ada_w, ada_b, norm1_w, norm2_w, w_in, s5_lam_re, s5_lam_im,
              s5_log_dt, s5_b_re, s5_b_im, s5_c_re, s5_c_im, s5_d, s5_glu_w, gla_gk_up, gla_gk_b,
              gla_norm_w, w_s5_proj, w_gla_proj, w_out, router_w, router_bias, exp_w_gate, exp_w_up,
              exp_w_down, sh_w_gate, sh_w_up, sh_w_down, final_norm_w):
    for i in range(DEPTH):
        last = i == DEPTH - 1
        mod = jax.nn.silu(c) @ ada_w[i] + ada_b[i]
        mod_c = jax.nn.silu(c_ctx) @ ada_w[i] + ada_b[i]
        sh1, sc1, g1, sh2, sc2, g2 = jnp.split(mod[:, None, :], N_MOD, axis=-1)
        csh1, csc1, cg1, csh2, csc2, cg2 = jnp.split(mod_c, N_MOD, axis=-1)
        h = modulate(x, norm1_w[i], sh1, sc1)
        hc = modulate(ctx, norm1_w[i], csh1, csc1)
        y, yc = token_mixer(h, hc, w_in[i], s5_lam_re[i], s5_lam_im[i], s5_log_dt[i], s5_b_re[i],
                            s5_b_im[i], s5_c_re[i], s5_c_im[i], s5_d[i], s5_glu_w[i], gla_gk_up[i],
                            gla_gk_b[i], gla_norm_w[i], w_s5_proj[i], w_gla_proj[i], w_out[i],
                            ctx_out=not last)
        x = x + g1 * y
        x = x + g2 * moe(modulate(x, norm2_w[i], sh2, sc2), router_w[i], router_bias[i],
                         exp_w_gate[i], exp_w_up[i], exp_w_down[i], sh_w_gate[i], sh_w_up[i], sh_w_down[i])
        if not last:
            ctx = ctx + cg1 * yc
            ctx = ctx + cg2 * moe(modulate(ctx, norm2_w[i], csh2, csc2), router_w[i], router_bias[i],
                                  exp_w_gate[i], exp_w_up[i], exp_w_down[i], sh_w_gate[i], sh_w_up[i], sh_w_down[i])
    return rmsnorm(x, final_norm_w)
```

```cpp
#include <hip/hip_runtime.h>
#include <cstdio>
#include <cstdint>

#ifndef MK_N_LAUNCHES
#define MK_N_LAUNCHES 1
#endif

constexpr int D = 2048, NB = 4, SEQ = 2048, CTX = 256;
constexpr int T = NB * SEQ;
constexpr int TC = NB * CTX;
constexpr int TA = T + TC;
constexpr int NMOD = 6;
constexpr int S5W = 1024, S5G_ = 16, S5NG = 64, S5P = 64;
constexpr int GH = 4, GKW = 512, GVW = 1024, GDK = 128, GDV = 256, GRANK = 16, GCH = 64;
constexpr int INW = 8224;
constexpr int NE = 64, TOPK = 8, NGRP = 8, TOPKG = 4, DEXP = 512;
constexpr float EPS = 1e-6f;
constexpr int NCH = (SEQ + CTX) / GCH;
constexpr int NCHC = CTX / GCH;
constexpr int NCHL = SEQ / GCH;
constexpr int HIDROWS = 90112;

constexpr size_t MiB = 1u << 20;
constexpr size_t WS_CTL = 0, CTL_ZERO_BYTES = 65536;
constexpr size_t WS_MOD = 1 * MiB;
constexpr size_t WS_S5TAB = 2 * MiB;
constexpr size_t S5TAB_LAM = 0, S5TAB_LAM64 = 65536, S5TAB_BT = 131072, S5TAB_CT = 131072 + 524288;
constexpr size_t WS_ROUT_T = 4 * MiB;
constexpr size_t WS_ROUTE = 5 * MiB;
constexpr size_t ROUTE_LIST = 0, ROUTE_EIDX = 3 * MiB, ROUTE_SLOT = 3 * MiB + 262144, ROUTE_WTS = 3 * MiB + 524288;
constexpr size_t WS_WGU_T = 9 * MiB;
constexpr size_t WS_WD_T = 269 * MiB;
constexpr size_t WS_X1 = 399 * MiB;
constexpr size_t WS_AB = 463 * MiB;
constexpr size_t WS_WIN_T = WS_AB + 0 * MiB;
constexpr size_t WS_WGKD_T = WS_AB + 32 * MiB;
constexpr size_t WS_GLU_T = WS_AB + 33 * MiB;
constexpr size_t WS_S5P_T = WS_AB + 35 * MiB;
constexpr size_t WS_GLAP_T = WS_AB + 39 * MiB;
constexpr size_t WS_WOUT_T = WS_AB + 43 * MiB;
constexpr size_t WS_H = WS_AB + 51 * MiB;
constexpr size_t WS_GKD = WS_AB + 87 * MiB;
constexpr size_t WS_U = WS_AB + 89 * MiB;
constexpr size_t WS_KK = WS_AB + 107 * MiB;
constexpr size_t WS_V = WS_AB + 116 * MiB;
constexpr size_t WS_Q = WS_AB + 134 * MiB;
constexpr size_t WS_GO = WS_AB + 142 * MiB;
constexpr size_t WS_GS = WS_AB + 158 * MiB;
constexpr size_t WS_GG = WS_AB + 190 * MiB;
constexpr size_t WS_S5ST = WS_AB + 222 * MiB;
constexpr size_t WS_GST = WS_AB + 232 * MiB;
constexpr size_t WS_GDEC = WS_AB + 304 * MiB;
constexpr size_t WS_YS = WS_AB + 305 * MiB;
constexpr size_t WS_OG = WS_AB + 321 * MiB;
constexpr size_t WS_S5G = WS_AB + 337 * MiB;
constexpr size_t WS_M = WS_AB + 353 * MiB;
constexpr size_t WS_M8 = WS_AB + 410 * MiB;
constexpr size_t WS_A_END = WS_AB + 385 * MiB;
constexpr size_t WS_T2 = WS_AB + 0 * MiB;
constexpr size_t WS_HID = WS_AB + 32 * MiB;
constexpr size_t WS_YBUF = WS_AB + 120 * MiB;
constexpr size_t WS_WIN8 = WS_WIN_T + 16 * MiB;
constexpr size_t WS_H8 = WS_AB + 390 * MiB;
constexpr size_t WS_END = WS_AB + 472 * MiB;
static_assert(WS_A_END <= WS_END, "ws map");

constexpr int CW_TMO = 0, CW_CODE = 1;
constexpr int CW_BAR = 4096;
constexpr int CW_CNT = 8192;

constexpr int SCR_BYTES = 155648;
constexpr int MISC_OFF = SCR_BYTES;
constexpr int LDS_BYTES = 163840;

#define GAS __attribute__((address_space(1)))
#define LAS __attribute__((address_space(3)))
typedef unsigned short bf16_t;
typedef unsigned v4u __attribute__((ext_vector_type(4)));
typedef unsigned v2u __attribute__((ext_vector_type(2)));
typedef float f32x2 __attribute__((ext_vector_type(2)));
typedef float f32x4 __attribute__((ext_vector_type(4)));
typedef float f32x16 __attribute__((ext_vector_type(16)));
typedef short bf16x8 __attribute__((ext_vector_type(8)));
typedef GAS unsigned gu32;

#define DI __device__ __forceinline__
#define LDS_WAIT() asm volatile("s_waitcnt lgkmcnt(0)" ::: "memory")
#define LDS_BAR() do { asm volatile("s_waitcnt lgkmcnt(0)" ::: "memory"); __builtin_amdgcn_s_barrier(); asm volatile("" ::: "memory"); } while (0)
#define VM_WAIT() asm volatile("s_waitcnt vmcnt(0)" ::: "memory")
#define RLX_AGENT __ATOMIC_RELAXED, __HIP_MEMORY_SCOPE_AGENT

typedef __bf16 bf16x2_hw __attribute__((ext_vector_type(2)));
DI unsigned pk2(float lo, float hi) { const f32x2 v = {lo, hi}; return __builtin_bit_cast(unsigned, __builtin_convertvector(v, bf16x2_hw)); }
DI unsigned f2bf(float f) { return pk2(f, 0.f) & 0xffffu; }
DI float bflo(unsigned w) { return __builtin_bit_cast(float, w << 16); }
DI float bfhi(unsigned w) { return __builtin_bit_cast(float, w & 0xffff0000u); }
DI float bf2f(bf16_t b) { return __builtin_bit_cast(float, ((unsigned)b) << 16); }
DI float sigmoidf_(float x) { return __builtin_amdgcn_rcpf(1.0f + __expf(-x)); }
DI float siluf_(float x) { return x * sigmoidf_(x); }
DI float wave_sum(float v) {
#pragma unroll
    for (int o = 1; o < 64; o <<= 1) v += __shfl_xor(v, o);
    return v;
}
DI int crow32(int r, int hi) { return (r & 3) + 8 * (r >> 2) + 4 * hi; }
#define MFMA32(a, b, c) __builtin_amdgcn_mfma_f32_32x32x16_bf16((a), (b), (c), 0, 0, 0)
#define MFMA16(a, b, c) __builtin_amdgcn_mfma_f32_16x16x32_bf16((a), (b), (c), 0, 0, 0)

namespace pg8 {
constexpr int BM = 256, BK = 64, HALF = 128, HTB = HALF * BK * 2, STAGE_BYTES = 8 * HTB;
DI int lds_byte(int r, int c) { const int st = (r >> 4) * 2 + (c >> 5), rr = r & 15, cc = c & 31, ob = rr * 64 + cc * 2; return st * 1024 + (ob ^ (((ob >> 9) & 1) << 5)); }
DI void stage_rc(int b, int& R, int& C) { const int st = b / 1024, sb = b % 1024, swz = sb ^ (((sb >> 9) & 1) << 5); R = (st >> 1) * 16 + swz / 64; C = (st & 1) * 32 + (swz % 64) / 2; }
DI int perm32(int rho) { const int n = rho >> 4, i = rho & 15; return 8 * (i >> 2) + 4 * n + (i & 3); }
DI unsigned cvt_pk_bf16(float lo, float hi) { unsigned r; asm volatile("v_cvt_pk_bf16_f32 %0, %1, %2" : "=v"(r) : "v"(lo), "v"(hi)); return r; }

typedef short v8i __attribute__((ext_vector_type(16)));
DI v8i ld32(const LAS unsigned char* p) { const bf16x8 lo = *(const LAS bf16x8*)p, hi = *(const LAS bf16x8*)(p + 16); return __builtin_shufflevector(lo, hi, 0, 1, 2, 3, 4, 5, 6, 7, 8, 9, 10, 11, 12, 13, 14, 15); }
constexpr int FP8_WSHIFT = 5;
constexpr int FP8_SCALE_W = 0x01010101 * (127 - FP8_WSHIFT);
constexpr int FP8_SCALE_A = 0x7f7f7f7f;
struct Unit {
    const char* a;
    const char* b;
    const int* idx;
    int nvalid;
    int pm, pn, e;
    int cb;
    int flags;
};

template <class Epi, class Sched, bool GATHER, int ES = 2, bool ALIGN_EPI = true, bool SP2 = true, int BKT = 0, bool P64 = false>
DI void gemm_phase(LAS unsigned char* lds, const int K, const Sched& S, const Epi& E) {
    const int tid = threadIdx.x, wid = __builtin_amdgcn_readfirstlane(tid >> 6), lane = tid & 63, wr = wid >> 2, wc = wid & 3, fr = lane & 15, fq = lane >> 4;
    const int nt = (K * ES) / 128;
    int Rr[2], Cc[2];
    unsigned voffB[2], vc[2][2], vn[2][2];
#pragma unroll
    for (int i = 0; i < 2; ++i) { int R, C; stage_rc(tid * 16 + i * 8192, R, C); const int Rb = P64 ? (2 * (R & ~31) + perm32(R & 31)) : (Epi::PERM ? ((R & ~31) + perm32(R & 31)) : R);
        Rr[i] = R; Cc[i] = C; voffB[i] = BKT ? ((unsigned)Rb * 128u + (unsigned)C * 2u) : ((unsigned)(Rb * K) * (unsigned)ES + (unsigned)C * 2u);
#pragma unroll
        for (int h = 0; h < 2; ++h) { vc[h][i] = (unsigned)((h * HALF + R) * K) * (unsigned)ES + (unsigned)C * 2u; vn[h][i] = vc[h][i]; } }
    const size_t kstep = (size_t)(BK * 2);
    const size_t hstep = (size_t)HALF * K * ES;
    const size_t kstepB = BKT ? (size_t)BKT * 128 : kstep, hstepB = (size_t)(P64 ? 32 : HALF) * (BKT ? (size_t)128 : (size_t)K * ES);
    const unsigned ldsw = (unsigned)wid * 1024u;
    const int aoff = lds_byte(wr * 64 + fr, (ES == 2 ? 8 : 16) * fq), boff = lds_byte(wc * 32 + fr, (ES == 2 ? 8 : 16) * fq);
#define PG8_SA(b, h) (((b) * 2 + (h)) * HTB)
#define PG8_SB(b, h) ((4 + (b) * 2 + (h)) * HTB)
#define PG8_STAGE_B(bufoff, gbase) do { _Pragma("unroll") for (int _i = 0; _i < 2; ++_i) \
        __builtin_amdgcn_global_load_lds((const unsigned*)((const char*)(gbase) + voffB[_i]), (LAS unsigned*)(lds + (bufoff) + ldsw + _i * 8192), 16, 0, 0); } while (0)
#define PG8_STAGE_A(bufoff, gbase, h, usen) do { _Pragma("unroll") for (int _i = 0; _i < 2; ++_i) \
        __builtin_amdgcn_global_load_lds((const unsigned*)((const char*)(gbase) + ((usen) ? vn[h][_i] : vc[h][_i])), (LAS unsigned*)(lds + (bufoff) + ldsw + _i * 8192), 16, 0, 0); } while (0)
#define PG8_LDA(dst, b, h) do { if constexpr (ES == 2) { _Pragma("unroll") for (int m = 0; m < 4; ++m) _Pragma("unroll") for (int k = 0; k < 2; ++k) dst[m][k] = *(const LAS bf16x8*)(lds + PG8_SA(b, h) + aoff + m * 2048 + k * 1024); } \
        else { _Pragma("unroll") for (int m = 0; m < 4; ++m) dst##8[m] = ld32(lds + PG8_SA(b, h) + aoff + m * 2048); } } while (0)
#define PG8_LDB(dst, b, h) do { if constexpr (ES == 2) { _Pragma("unroll") for (int n = 0; n < 2; ++n) _Pragma("unroll") for (int k = 0; k < 2; ++k) dst[n][k] = *(const LAS bf16x8*)(lds + PG8_SB(b, h) + boff + n * 2048 + k * 1024); } \
        else { _Pragma("unroll") for (int n = 0; n < 2; ++n) dst##8[n] = ld32(lds + PG8_SB(b, h) + boff + n * 2048); } } while (0)
#define PG8_MMA(ai, bj, At, Bt) do { __builtin_amdgcn_s_setprio(1); _Pragma("unroll") for (int m = 0; m < 4; ++m) _Pragma("unroll") for (int n = 0; n < 2; ++n) { \
        if constexpr (ES == 2) { _Pragma("unroll") for (int k = 0; k < 2; ++k) acc[ai][bj][m][n] = __builtin_amdgcn_mfma_f32_16x16x32_bf16(Bt[n][k], At[m][k], acc[ai][bj][m][n], 0, 0, 0); } \
        else { asm volatile("v_mfma_scale_f32_16x16x128_f8f6f4 %0, %1, %2, %0, %3, %4 op_sel_hi:[0,0,0]" : "+v"(acc[ai][bj][m][n]) : "v"(Bt##8[n]), "v"(At##8[m]), "v"(sc_w), "v"(sc_a)); } } \
        __builtin_amdgcn_s_setprio(0); } while (0)
#define PG8_WAIT_V(n) asm volatile("s_waitcnt vmcnt(" #n ")" ::: "memory")
#define PG8_WAIT_L(n) asm volatile("s_waitcnt lgkmcnt(" #n ")" ::: "memory")
#define PG8_BAR __builtin_amdgcn_s_barrier()
#define PG8_SCHED __builtin_amdgcn_sched_barrier(0)
    Unit cur, nxt; int ui = 0;
    if (!S.next(0, cur)) return;
    f32x4 acc[2][2][4][2];
#pragma unroll
    for (int a = 0; a < 2; ++a)
#pragma unroll
        for (int b = 0; b < 2; ++b)
#pragma unroll
            for (int m = 0; m < 4; ++m)
#pragma unroll
                for (int n = 0; n < 2; ++n) acc[a][b][m][n] = (f32x4){0.f, 0.f, 0.f, 0.f};
    bf16x8 At[4][2], B0[2][2], B1[2][2];
    v8i At8[4], B08[2], B18[2];
    int sc_w = FP8_SCALE_W, sc_a = FP8_SCALE_A;
    asm volatile("" : "+v"(sc_w), "+v"(sc_a));
    const char* cA = cur.a; const char* cB = cur.b;
    if constexpr (GATHER) {
#pragma unroll
        for (int h = 0; h < 2; ++h)
#pragma unroll
            for (int i = 0; i < 2; ++i) { const int r = h * HALF + Rr[i]; const int row = (r < cur.nvalid) ? cur.idx[r] : 0; vc[h][i] = (unsigned)(row * K) * (unsigned)ES + (unsigned)Cc[i] * 2u; }
    }
    if constexpr (SP2) {
        PG8_STAGE_B(PG8_SB(0, 0), cB); PG8_STAGE_B(PG8_SB(0, 1), cB + hstepB); PG8_STAGE_A(PG8_SA(0, 0), cA, 0, false); PG8_STAGE_A(PG8_SA(0, 1), cA, 1, false);
        if (wr == 1) PG8_BAR;
        PG8_WAIT_V(2); PG8_BAR;
        PG8_STAGE_B(PG8_SB(1, 0), cB + kstepB); PG8_STAGE_A(PG8_SA(1, 0), cA + kstep, 0, false); PG8_STAGE_B(PG8_SB(1, 1), cB + hstepB + kstepB);
        PG8_WAIT_V(6); PG8_BAR;
    } else {
        PG8_STAGE_B(PG8_SB(0, 0), cB); PG8_STAGE_A(PG8_SA(0, 0), cA, 0, false); PG8_STAGE_B(PG8_SB(0, 1), cB + hstepB); PG8_STAGE_A(PG8_SA(0, 1), cA, 1, false);
        if (wr == 1) PG8_BAR;
        PG8_WAIT_V(4); PG8_BAR;
        PG8_STAGE_B(PG8_SB(1, 0), cB + kstepB); PG8_STAGE_A(PG8_SA(1, 0), cA + kstep, 0, false); PG8_STAGE_B(PG8_SB(1, 1), cB + hstepB + kstepB);
        PG8_WAIT_V(6); PG8_BAR;
    }
    for (;;) {
        const bool has_next = S.next(ui + 1, nxt);
        const int fl = cur.flags;
        const char* nA = has_next ? nxt.a : cA; const char* nB = has_next ? nxt.b : cB;
        if constexpr (GATHER) {
            if (has_next) { if (wid == 0) __builtin_amdgcn_global_load_lds((const unsigned*)(nxt.idx + 4 * lane), (LAS unsigned*)(lds + STAGE_BYTES + ((ui + 1) & 1) * 1024), 16, 0, 0); }
            else {
#pragma unroll
                for (int h = 0; h < 2; ++h)
#pragma unroll
                    for (int i = 0; i < 2; ++i) vn[h][i] = vc[h][i];
            }
        }
        for (int t = 0; t < nt; t += 2) {
            const bool last = (t == nt - 2);
            const char* a1 = cA + (size_t)(t + 1) * kstep;
            const char* a2 = last ? nA : cA + (size_t)(t + 2) * kstep; const char* b2 = last ? nB : cB + (size_t)(t + 2) * kstepB;
            const char* a3 = a2 + kstep; const char* b3 = b2 + kstepB;
            const bool un = GATHER && last;
            if constexpr (GATHER) { if (last && has_next) {
                const LAS int* ib = (const LAS int*)(lds + STAGE_BYTES + ((ui + 1) & 1) * 1024);
#pragma unroll
                for (int h = 0; h < 2; ++h)
#pragma unroll
                    for (int i = 0; i < 2; ++i) { const int r = h * HALF + Rr[i]; const int row = (r < nxt.nvalid) ? ib[r] : 0; vn[h][i] = (unsigned)(row * K) * (unsigned)ES + (unsigned)Cc[i] * 2u; } } }
            if constexpr (SP2) {
            PG8_LDB(B0, 0, 0); PG8_LDB(B1, 0, 1); PG8_SCHED; PG8_LDA(At, 0, 0); PG8_STAGE_A(PG8_SA(1, 1), a1, 1, false);
            PG8_WAIT_V(8); PG8_WAIT_L(0); PG8_BAR; PG8_MMA(0, 0, At, B0); if (!(fl & 2)) PG8_MMA(0, 1, At, B1); PG8_BAR; PG8_SCHED;
            PG8_LDA(At, 0, 1); PG8_STAGE_B(PG8_SB(0, 0), b2); PG8_STAGE_B(PG8_SB(0, 1), b2 + hstepB); PG8_STAGE_A(PG8_SA(0, 0), a2, 0, un);
            PG8_WAIT_V(8); PG8_WAIT_L(0); PG8_BAR; if (!(fl & 1)) { PG8_MMA(1, 0, At, B0); if (!(fl & 2)) PG8_MMA(1, 1, At, B1); } PG8_BAR; PG8_SCHED;
            PG8_LDB(B0, 1, 0); PG8_LDB(B1, 1, 1); PG8_SCHED; PG8_LDA(At, 1, 0); PG8_STAGE_A(PG8_SA(0, 1), a2, 1, un);
            PG8_WAIT_V(8); PG8_WAIT_L(0); PG8_BAR; PG8_MMA(0, 0, At, B0); if (!(fl & 2)) PG8_MMA(0, 1, At, B1); PG8_BAR; PG8_SCHED;
            PG8_LDA(At, 1, 1); PG8_STAGE_B(PG8_SB(1, 0), b3); PG8_STAGE_B(PG8_SB(1, 1), b3 + hstepB); PG8_STAGE_A(PG8_SA(1, 0), a3, 0, un);
            PG8_WAIT_V(8); PG8_WAIT_L(0); PG8_BAR; if (!(fl & 1)) { PG8_MMA(1, 0, At, B0); if (!(fl & 2)) PG8_MMA(1, 1, At, B1); } PG8_BAR; PG8_SCHED;
            } else {
            PG8_LDB(B0, 0, 0); PG8_SCHED; PG8_LDA(At, 0, 0); PG8_STAGE_A(PG8_SA(1, 1), a1, 1, false);
            PG8_WAIT_L(8); PG8_BAR; PG8_WAIT_L(0); PG8_MMA(0, 0, At, B0); PG8_BAR; PG8_SCHED;
            PG8_LDB(B1, 0, 1); PG8_STAGE_B(PG8_SB(0, 0), b2);
            PG8_BAR; PG8_WAIT_L(0); PG8_MMA(0, 1, At, B1); PG8_BAR;
            PG8_LDA(At, 0, 1); PG8_STAGE_A(PG8_SA(0, 0), a2, 0, un);
            PG8_BAR; PG8_WAIT_L(0); PG8_MMA(1, 0, At, B0); PG8_BAR; PG8_SCHED;
            PG8_STAGE_B(PG8_SB(0, 1), b2 + hstepB);
            PG8_WAIT_V(6); PG8_BAR; PG8_MMA(1, 1, At, B1); PG8_BAR;
            PG8_LDB(B0, 1, 0); PG8_SCHED; PG8_LDA(At, 1, 0); PG8_STAGE_A(PG8_SA(0, 1), a2, 1, un);
            PG8_WAIT_L(8); PG8_BAR; PG8_WAIT_L(0); PG8_MMA(0, 0, At, B0); PG8_BAR; PG8_SCHED;
            PG8_LDB(B1, 1, 1); PG8_STAGE_B(PG8_SB(1, 0), b3);
            PG8_BAR; PG8_WAIT_L(0); PG8_MMA(0, 1, At, B1); PG8_BAR;
            PG8_LDA(At, 1, 1); PG8_STAGE_A(PG8_SA(1, 0), a3, 0, un);
            PG8_BAR; PG8_WAIT_L(0); PG8_MMA(1, 0, At, B0); PG8_BAR; PG8_SCHED;
            PG8_STAGE_B(PG8_SB(1, 1), b3 + hstepB);
            PG8_WAIT_V(6); PG8_BAR; PG8_MMA(1, 1, At, B1); PG8_BAR;
            }
        }
        if constexpr (ALIGN_EPI) { if (wr == 0) PG8_BAR; }
        if constexpr (ES == 1) asm volatile("s_nop 15\n\ts_nop 15" ::: "memory");
        E(acc, cur, wr, wc, fr, fq);
        if (!has_next) break;
#pragma unroll
        for (int a = 0; a < 2; ++a)
#pragma unroll
            for (int b = 0; b < 2; ++b)
#pragma unroll
                for (int m = 0; m < 4; ++m)
#pragma unroll
                    for (int n = 0; n < 2; ++n) acc[a][b][m][n] = (f32x4){0.f, 0.f, 0.f, 0.f};
        cur = nxt; cA = nA; cB = nB; ++ui;
        if constexpr (GATHER) {
#pragma unroll
            for (int h = 0; h < 2; ++h)
#pragma unroll
                for (int i = 0; i < 2; ++i) vc[h][i] = vn[h][i];
        }
        if constexpr (ALIGN_EPI) { if (wr == 1) PG8_BAR; }
    }
    PG8_WAIT_V(0);
    if constexpr (!ALIGN_EPI) { if (wr == 0) PG8_BAR; }
    PG8_BAR;
#undef PG8_SA
#undef PG8_SB
#undef PG8_STAGE_A
#undef PG8_STAGE_B
#undef PG8_LDA
#undef PG8_LDB
#undef PG8_MMA
#undef PG8_WAIT_V
#undef PG8_WAIT_L
#undef PG8_BAR
#undef PG8_SCHED
}
}

#define XB_TMO      128
#define XB_XCNT(j)  (256  + 64 * (j))
#define XB_XSUB(j)  (1280 + 64 * (j))
#define XB_XGEN(j)  (2304 + 64 * (j))
#define XB_TOP      3328
#define XB_TOPGEN   3392
#define XCD_BAR_WORDS 3456
#define XB_SPIN_CAP (1u << 18)
DI unsigned xb_ld(unsigned* p)              { return __hip_atomic_load(p, __ATOMIC_RELAXED, __HIP_MEMORY_SCOPE_AGENT); }
DI unsigned xb_add(unsigned* p, unsigned v) { return __hip_atomic_fetch_add(p, v, __ATOMIC_RELAXED, __HIP_MEMORY_SCOPE_AGENT); }
DI unsigned xb_xcc_id() { return (unsigned)__builtin_amdgcn_s_getreg((3 << 11) | 20) & 0xFu; }
#define XB_SPIN(cond, bar) do { unsigned _sp = 0; while (cond) { __builtin_amdgcn_s_sleep(1); \
    if ((++_sp & 255u) == 0u) { if (xb_ld(&(bar)[XB_TMO])) break; if (_sp > XB_SPIN_CAP) { atomicAdd(&(bar)[XB_TMO], 1u); break; } } } } while (0)
struct XcdBarrier { unsigned* bar; unsigned x; volatile LAS unsigned* st; };
DI XcdBarrier xcd_barrier_post(unsigned* bar, volatile LAS unsigned* st) {
    XcdBarrier b; b.bar = bar; b.x = xb_xcc_id(); b.st = st;
    if (threadIdx.x == 0) (void)xb_add(&bar[XB_XCNT(b.x)], 1u);
    return b;
}
DI void xcd_barrier_complete(unsigned* bar, unsigned x, unsigned& nloc, unsigned& nx) {
    const unsigned G = gridDim.x * gridDim.y * gridDim.z;
    unsigned sum, cnt, mine, sp = 0u;
    for (;;) {
        sum = 0u; cnt = 0u; mine = 0u;
#pragma unroll
        for (unsigned j = 0; j < 16; ++j) { const unsigned c = xb_ld(&bar[XB_XCNT(j)]); sum += c; cnt += (c > 0u) ? 1u : 0u; mine = (j == x) ? c : mine; }
        if (sum == G) break;
        __builtin_amdgcn_s_sleep(1);
        if ((++sp & 255u) == 0u) { if (xb_ld(&bar[XB_TMO])) break; if (sp > XB_SPIN_CAP) { atomicAdd(&bar[XB_TMO], 1u); break; } }
    }
    nloc = mine > 0u ? mine : 1u; nx = cnt > 0u ? cnt : 1u;
}
DI void xcd_barrier(const XcdBarrier& b) {
    asm volatile("s_waitcnt vmcnt(0)" ::: "memory");
    __syncthreads();
    if (threadIdx.x == 0) {
        unsigned* bar = b.bar;
        __builtin_amdgcn_s_waitcnt(0);
        unsigned nloc = b.st[0], nx = b.st[1];
        if (nloc == 0u) { xcd_barrier_complete(bar, b.x, nloc, nx); b.st[0] = nloc; b.st[1] = nx; }
        const unsigned old = xb_add(&bar[XB_XSUB(b.x)], 1u);
        const unsigned gen = old / nloc;
        if (old + 1u == (gen + 1u) * nloc) {
            __builtin_amdgcn_fence(__ATOMIC_RELEASE, "agent");
            asm volatile("s_waitcnt vmcnt(0)" ::: "memory");
            const unsigned og = xb_add(&bar[XB_TOP], 1u);
            const unsigned tg = og / nx;
            if (og + 1u == (tg + 1u) * nx) xb_add(&bar[XB_TOPGEN], 1u);
            else XB_SPIN(xb_ld(&bar[XB_TOPGEN]) == tg, bar);
            __builtin_amdgcn_fence(__ATOMIC_ACQUIRE, "agent");
            xb_add(&bar[XB_XGEN(b.x)], 1u);
            asm volatile("s_waitcnt vmcnt(0)" ::: "memory");
        } else {
            XB_SPIN(xb_ld(&bar[XB_XGEN(b.x)]) == gen, bar);
            __builtin_amdgcn_fence(__ATOMIC_ACQUIRE, "agent");
            asm volatile("s_waitcnt vmcnt(0)" ::: "memory");
        }
    }
    __syncthreads();
}

constexpr int NIN = 33;
struct Args { const float* in[NIN]; float* out; unsigned char* ws; int ph_lo, ph_hi; };
struct Frame {
    LAS unsigned char* lds;
    unsigned char* ws;
    const float* const* in;
    float* out;
    int tid, lane, wave, G, bid;
};
enum InIdx { I_X = 0, I_C, I_CTX, I_CCTX, I_ADAW, I_ADAB, I_N1W, I_N2W, I_WIN, I_LAMRE, I_LAMIM, I_LOGDT, I_BRE, I_BIM, I_CRE, I_CIM, I_S5D, I_GLUW, I_GKUP, I_GKB, I_GNW,
             I_WS5P, I_WGLAP, I_WOUT, I_RW, I_RB, I_EWG, I_EWU, I_EWD, I_SWG, I_SWU, I_SWD, I_FNW };

struct TrItem { const float* src; bf16_t* dst; int ldw, ldt; int fp8; };
DI void tr_load(const TrItem& it, f32x4 (&v)[8], int lane) {
    const int kk = lane >> 3, n4 = lane & 7;
    const float* src = it.src + (size_t)kk * it.ldw + 4 * n4;
#pragma unroll
    for (int i = 0; i < 8; ++i) v[i] = *(const GAS f32x4*)(src + (size_t)(8 * i) * it.ldw);
}
DI void tr_finish(const TrItem& it, const f32x4 (&v)[8], LAS float* scr, int lane) {
    const int kk = lane >> 3, n4 = lane & 7;
#pragma unroll
    for (int i = 0; i < 8; ++i) { LAS float* d = scr + (8 * i + kk) * 33 + 4 * n4; d[0] = v[i].x; d[1] = v[i].y; d[2] = v[i].z; d[3] = v[i].w; }
    LDS_WAIT(); asm volatile("" ::: "memory");
    const int c = lane & 7;
    if (it.fp8) {
        unsigned char* dst8 = (unsigned char*)it.dst; const float sc = (float)(1 << pg8::FP8_WSHIFT);
#pragma unroll
        for (int j = 0; j < 4; ++j) { const int n = (lane >> 3) + 8 * j; const LAS float* s = scr + (8 * c) * 33 + n;
            unsigned w0 = 0, w1 = 0;
            w0 = __builtin_amdgcn_cvt_pk_fp8_f32(s[0 * 33] * sc, s[1 * 33] * sc, w0, false); w0 = __builtin_amdgcn_cvt_pk_fp8_f32(s[2 * 33] * sc, s[3 * 33] * sc, w0, true);
            w1 = __builtin_amdgcn_cvt_pk_fp8_f32(s[4 * 33] * sc, s[5 * 33] * sc, w1, false); w1 = __builtin_amdgcn_cvt_pk_fp8_f32(s[6 * 33] * sc, s[7 * 33] * sc, w1, true);
            *(GAS v2u*)(dst8 + (size_t)n * it.ldt + 8 * c) = (v2u){w0, w1}; }
    } else {
#pragma unroll
        for (int j = 0; j < 4; ++j) { const int n = (lane >> 3) + 8 * j; const LAS float* s = scr + (8 * c) * 33 + n;
            v4u o; o.x = pk2(s[0 * 33], s[1 * 33]); o.y = pk2(s[2 * 33], s[3 * 33]); o.z = pk2(s[4 * 33], s[5 * 33]); o.w = pk2(s[6 * 33], s[7 * 33]);
            *(GAS v4u*)(it.dst + (size_t)n * it.ldt + 8 * c) = o; }
    }
    LDS_WAIT(); asm volatile("" ::: "memory");
}
DI TrItem tr_make(const float* W, int ldw, int k0, int col0, bf16_t* WT, int ldt, int row0) { TrItem t; t.src = W + (size_t)k0 * ldw + col0; t.dst = WT + (size_t)row0 * ldt + k0; t.ldw = ldw; t.ldt = ldt; t.fp8 = 0; return t; }
DI TrItem tr_dense(const float* W, int ldw, int col0, int ncols, bf16_t* WT, int ldt, int row0, int it) {
    const int nblk = ncols / 32, kb = it / nblk, nb = it % nblk;
    return tr_make(W, ldw, 64 * kb, col0 + 32 * nb, WT, ldt, row0 + 32 * nb);
}
constexpr int NP_EXPERT = 65 * 2 * 32 + 65 * 32, NP_CONV_ALL = NP_EXPERT + 16 * 32 + (16 * 4 + 16 * 8 + 16 * 8 + 32 * 8) / 2;
DI void p0_convert(Frame& F, const int qbeg, const int qend) {
    const float* const* in = F.in;
    {
        __syncthreads();
        LAS float* img = (LAS float*)F.lds;
        LAS unsigned char* obuf = F.lds + 66560;
        int tid = F.tid; asm volatile("" : "+v"(tid));
        constexpr int NP_GU = 65 * 2 * 32, NP_DN = 65 * 32, NP_WIN = 16 * 32, NT_GLU = 16 * 4, NT_S5P = 16 * 8, NT_GLAP = 16 * 8, NT_WOUT = 32 * 8;
        constexpr int NP_ALL = NP_GU + NP_DN + NP_WIN + (NT_GLU + NT_S5P + NT_GLAP + NT_WOUT) / 2;
        static_assert(NP_GU + NP_DN == NP_EXPERT && NP_ALL == NP_CONV_ALL, "item counts");
        struct Tile { const float* src; unsigned char* dst; int ldw, ldt, fp8, gu; };
        auto make = [&](int q, const int half) -> Tile {
            Tile t; t.fp8 = 1; t.gu = 0; t.ldt = 128;
            if (q < NP_GU) {
                const int blk = q >> 5, ii = q & 31, e = blk >> 1, gu = blk & 1, kt = ii >> 1, nb = ii & 1, kb = 2 * kt + half;
                const float* W = (e < 64) ? ((gu ? in[I_EWU] : in[I_EWG]) + (size_t)e * 2048 * 512) : (gu ? in[I_SWU] : in[I_SWG]);
                t.src = W + (size_t)(64 * kb) * 512 + 256 * nb; t.ldw = 512; t.gu = 1;
                t.dst = F.ws + WS_WGU_T + (size_t)e * 1024 * 2048 + (size_t)kt * (1024 * 128) + (size_t)(512 * nb + 128 * gu) * 128; return t; }
            q -= NP_GU;
            if (q < NP_DN) { const int e = q >> 5, ii = q & 31, kt = ii >> 3, nb = ii & 7, kb = 2 * kt + half;
                const float* W = (e < 64) ? (in[I_EWD] + (size_t)e * 512 * 2048) : in[I_SWD];
                t.src = W + (size_t)(64 * kb) * 2048 + 256 * nb; t.ldw = 2048;
                t.dst = F.ws + WS_WD_T + (size_t)e * 2048 * 512 + (size_t)kt * (2048 * 128) + (size_t)(256 * nb) * 128; return t; }
            q -= NP_DN;
            if (q < NP_WIN) { const int kbp = q >> 5, nb = q & 31, drow = 256 * nb, kb = 2 * kbp + half; int scol;
                if (drow < 1024) scol = drow; else if (drow < 1536) scol = 1536 + (drow - 1024); else if (drow < 2560) scol = 2048 + (drow - 1536); else if (drow < 3072) scol = 1024 + (drow - 2560);
                else if (drow < 4096) scol = 3072 + (drow - 3072); else if (drow < 6144) scol = 4128 + (drow - 4096); else scol = 6176 + (drow - 6144);
                t.src = in[I_WIN] + (size_t)(64 * kb) * INW + scol; t.ldw = INW;
                if (nb == 4 || nb == 5 || nb == 10 || nb == 11) { t.fp8 = 0; t.ldt = 2048 * 2; t.dst = F.ws + WS_WIN_T + ((size_t)drow * 2048 + 64 * kb) * 2; }
                else { t.ldt = 2048; t.dst = F.ws + WS_WIN8 + (size_t)drow * 2048 + 128 * kbp; }
                return t; }
            q -= NP_WIN;
            if (q < NT_WOUT / 2) { const int kbp = q >> 3, nb = q & 7, kb = 2 * kbp + half;
                t.src = in[I_WOUT] + (size_t)(64 * kb) * 2048 + 256 * nb; t.ldw = 2048; t.ldt = 2048; t.dst = F.ws + WS_WOUT_T + (size_t)(256 * nb) * 2048 + 128 * kbp; return t; }
            q -= NT_WOUT / 2;
            if (q < NT_S5P / 2 + NT_GLAP / 2) { const int which = q >= NT_S5P / 2, qq = which ? q - NT_S5P / 2 : q, kbp = qq >> 3, nb = qq & 7, kb = 2 * kbp + half;
                t.src = (which ? in[I_WGLAP] : in[I_WS5P]) + (size_t)(64 * kb) * 2048 + 256 * nb; t.ldw = 2048; t.ldt = 1024; t.dst = F.ws + (which ? WS_GLAP_T : WS_S5P_T) + (size_t)(256 * nb) * 1024 + 128 * kbp; return t; }
            q -= NT_S5P / 2 + NT_GLAP / 2;
            t.fp8 = 0;
            int r = 2 * q + half;
            { const int kb = r >> 2, nb = r & 3; t.src = in[I_GLUW] + (size_t)(64 * kb) * 1024 + 256 * nb; t.ldw = 1024; t.ldt = 1024 * 2; t.dst = F.ws + WS_GLU_T + ((size_t)(256 * nb) * 1024 + 64 * kb) * 2; return t; }
            return t;
        };
        f32x4 va[8], vb[8]; Tile ta, tb;
        auto issue = [&](f32x4 (&v)[8], const Tile& t) {
            const float* p_ = t.src + (size_t)(tid >> 6) * t.ldw + 4 * (tid & 63);
#pragma unroll
            for (int i = 0; i < 8; ++i) v[i] = __builtin_nontemporal_load((const GAS f32x4*)(p_ + (size_t)(8 * i) * t.ldw));
        };
#define CV_WAIT(v, n) do { } while (0)
        auto stage = [&](const f32x4 (&v)[8]) {
#pragma unroll
            for (int i = 0; i < 8; ++i) *(LAS f32x4*)(img + (8 * i + (tid >> 6)) * 260 + 4 * (tid & 63)) = v[i];
        };
        auto convert = [&](const Tile& cur, const int half) {
            const int n = tid & 255, kh = tid >> 8;
            const LAS float* sp = img + (32 * kh) * 260 + n;
            LAS unsigned char* orow = obuf + n * 128; const int sw = n & 7;
            if (cur.fp8) {
                const float sc = (float)(1 << pg8::FP8_WSHIFT);
                unsigned w[8];
#pragma unroll
                for (int q = 0; q < 8; ++q) { unsigned x = 0;
                    x = __builtin_amdgcn_cvt_pk_fp8_f32(sp[(4 * q) * 260] * sc, sp[(4 * q + 1) * 260] * sc, x, false);
                    x = __builtin_amdgcn_cvt_pk_fp8_f32(sp[(4 * q + 2) * 260] * sc, sp[(4 * q + 3) * 260] * sc, x, true); w[q] = x; }
                const int c0 = 4 * half + 2 * kh;
                *(LAS v4u*)(orow + (((c0) ^ sw) << 4)) = (v4u){w[0], w[1], w[2], w[3]}; *(LAS v4u*)(orow + (((c0 + 1) ^ sw) << 4)) = (v4u){w[4], w[5], w[6], w[7]};
            } else {
                unsigned w[16];
#pragma unroll
                for (int q = 0; q < 16; ++q) w[q] = pk2(sp[(2 * q) * 260], sp[(2 * q + 1) * 260]);
#pragma unroll
                for (int q4 = 0; q4 < 4; ++q4) *(LAS v4u*)(orow + (((4 * kh + q4) ^ sw) << 4)) = (v4u){w[4 * q4], w[4 * q4 + 1], w[4 * q4 + 2], w[4 * q4 + 3]};
            }
        };
        auto flush = [&](const Tile& cur) {
#pragma unroll
            for (int i = 0; i < 4; ++i) { const int p = i * 512 + tid, n = p >> 3, c = p & 7;
                const v4u x = *(const LAS v4u*)(obuf + n * 128 + ((c ^ (n & 7)) << 4));
                const int drow = cur.gu ? (256 * (n >> 7) + (n & 127)) : n;
                *(GAS v4u*)(cur.dst + (size_t)drow * cur.ldt + 16 * c) = x; }
        };
        int q = qbeg + F.bid;
        if (q < qend) { ta = make(q, 0); issue(va, ta); tb = make(q, 1); issue(vb, tb); CV_WAIT(va, 8); }
        while (q < qend) {
            const bool hn = q + F.G < qend;
            CV_WAIT(va, 12);
            stage(va);
            LDS_BAR();
            const Tile ca = ta;
            if (hn) { ta = make(q + F.G, 0); issue(va, ta); }
            convert(ca, 0);
            LDS_BAR();
            if (!ca.fp8) flush(ca);
            if (hn) CV_WAIT(vb, 8); else CV_WAIT(vb, 0);
            stage(vb);
            LDS_BAR();
            const Tile cb = tb;
            if (hn) { tb = make(q + F.G, 1); issue(vb, tb); }
            convert(cb, 1 & cb.fp8);
            LDS_BAR();
            flush(cb);
            q += F.G;
        }
#undef CV_WAIT
        LDS_BAR();
    }
}
constexpr int IT_GKD = 32 * 1, IT_RW = 32 * 2;
DI void p0_prologue(Frame& F) {
    const float* const* in = F.in;
    {
        LAS float* sv = (LAS float*)F.lds;
        LAS float* red = (LAS float*)(F.lds + 40960);
        for (int i = F.tid; i < 5 * 2048; i += 512) { const int r = i >> 11, k = i & 2047; const float c = (r < 4) ? in[I_C][r * 2048 + k] : in[I_CCTX][k]; sv[i] = siluf_(c); }
        __syncthreads();
        const int NCOLB = 48;
        for (int cb = F.bid; cb < (NMOD * D) / NCOLB; cb += F.G) {
            const int n0 = cb * NCOLB;
            const int c4 = F.tid % 12, kr = F.tid / 12;
            f32x4 acc[5];
#pragma unroll
            for (int r = 0; r < 5; ++r) acc[r] = (f32x4){0.f, 0.f, 0.f, 0.f};
            if (kr < 42) {
                const float* wp = in[I_ADAW] + n0 + 4 * c4;
#pragma unroll 1
                for (int j0 = 0; j0 < 48; j0 += 8) {
                    f32x4 w[8];
#pragma unroll
                    for (int j = 0; j < 8; ++j) w[j] = __builtin_nontemporal_load((const GAS f32x4*)(wp + (size_t)(kr + 42 * (j0 + j)) * (NMOD * D)));
#pragma unroll
                    for (int j = 0; j < 8; ++j)
#pragma unroll
                        for (int r = 0; r < 5; ++r) acc[r] += w[j] * sv[r * 2048 + kr + 42 * (j0 + j)];
                }
                if (kr < 32) { const int k = kr + 42 * 48; const f32x4 w = __builtin_nontemporal_load((const GAS f32x4*)(wp + (size_t)k * (NMOD * D)));
#pragma unroll
                    for (int r = 0; r < 5; ++r) acc[r] += w * sv[r * 2048 + k]; }
#pragma unroll
                for (int r = 0; r < 5; ++r) *(LAS f32x4*)(red + (kr * 5 + r) * 48 + 4 * c4) = acc[r];
            }
            __syncthreads();
            if (F.tid < 240) { const int r = F.tid / 48, n = F.tid % 48; float s = 0.f;
                for (int k = 0; k < 42; ++k) s += red[(k * 5 + r) * 48 + n];
                ((float*)(F.ws + WS_MOD))[r * (NMOD * D) + n0 + n] = s + in[I_ADAB][n0 + n]; }
            __syncthreads();
        }
    }
    {
        for (int gid = (F.tid < 32) ? (F.bid * 32 + F.tid) : (2 * S5NG * S5P); gid < 2 * S5NG * S5P; gid += F.G * 32) {
            const int dr = gid >> 12, g = (gid >> 6) & 63, p = gid & 63;
            const float lre = in[I_LAMRE][gid], lim = in[I_LAMIM][gid];
            const float dt = expf(in[I_LOGDT][dr * 64 + g]);
            const float mag = expf(lre * dt), ph = lim * dt;
            const float lbr = mag * cosf(ph), lbi = mag * sinf(ph);
            const float mag64 = expf(lre * dt * 64.f), ph64 = ph * 64.f;
            f32x2* lam = (f32x2*)(F.ws + WS_S5TAB + S5TAB_LAM); f32x2* lam64 = (f32x2*)(F.ws + WS_S5TAB + S5TAB_LAM64);
            lam[gid] = (f32x2){lbr, lbi};
            lam64[gid] = (f32x2){mag64 * cosf(ph64), mag64 * sinf(ph64)};
            const float nr = lbr - 1.f, ni = lbi, den = lre * lre + lim * lim;
            const float cr = (nr * lre + ni * lim) / den, ci = (ni * lre - nr * lim) / den;
            bf16_t* BT = (bf16_t*)(F.ws + WS_S5TAB + S5TAB_BT) + (size_t)(dr * 64 + g) * 128 * 16;
            bf16_t* CT = (bf16_t*)(F.ws + WS_S5TAB + S5TAB_CT) + (size_t)(dr * 64 + g) * 16 * 128;
            const float* bre = in[I_BRE] + (size_t)gid * 16; const float* bim = in[I_BIM] + (size_t)gid * 16;
#pragma unroll
            for (int h = 0; h < 16; ++h) {
                const float br = bre[h], bi = bim[h];
                BT[(64 * (p >> 5) + (p & 31)) * 16 + h] = (bf16_t)f2bf(cr * br - ci * bi);
                BT[(64 * (p >> 5) + 32 + (p & 31)) * 16 + h] = (bf16_t)f2bf(cr * bi + ci * br);
                const size_t ci_idx = ((size_t)(dr * 64 + g) * 16 + h) * 64 + p;
                CT[h * 128 + 2 * p] = (bf16_t)f2bf(in[I_CRE][ci_idx]);
                CT[h * 128 + 2 * p + 1] = (bf16_t)f2bf(-in[I_CIM][ci_idx]);
            }
        }
    }
    p0_convert(F, NP_EXPERT, NP_CONV_ALL);
    {
        {
            LAS float* scr = (LAS float*)(F.lds + F.wave * 16384);
            const int gw = F.bid * 8 + F.wave, NGW = F.G * 8;
            f32x4 va[8];
            for (int it = gw; it < IT_GKD + IT_RW; it += NGW) {
                const TrItem ti = (it < IT_GKD) ? tr_make(in[I_WIN], INW, 64 * it, 4096, (bf16_t*)(F.ws + WS_WGKD_T), 2048, 0) : tr_dense(in[I_RW], 64, 0, 64, (bf16_t*)(F.ws + WS_ROUT_T), 2048, 0, it - IT_GKD);
                tr_load(ti, va, F.lane); tr_finish(ti, va, scr, F.lane);
            }
        }
    }
}

constexpr int AST = 2056;
DI void norm_row_load(f32x4 (&v)[8], const float* xrow, int lane) {
    const GAS f32x4* xr = (const GAS f32x4*)xrow + lane;
#pragma unroll
    for (int j = 0; j < 8; ++j) v[j] = __builtin_nontemporal_load(xr + 64 * j);
}
template <int FP8OUT>
DI void norm_row_finish(const f32x4 (&v)[8], const float* nw, const float* sh, const float* sc, bf16_t* grow, LAS bf16_t* lrow, int lane, unsigned char* grow8 = nullptr) {
    float s = 0.f;
#pragma unroll
    for (int j = 0; j < 8; ++j) s += (v[j].x * v[j].x + v[j].y * v[j].y) + (v[j].z * v[j].z + v[j].w * v[j].w);
    const float rstd = rsqrtf(wave_sum(s) * (1.f / 2048.f) + EPS);
#pragma unroll
    for (int j = 0; j < 8; ++j) {
        const int i4 = lane + 64 * j;
        const f32x4 w = ((const GAS f32x4*)nw)[i4], a = ((const GAS f32x4*)sh)[i4], c = ((const GAS f32x4*)sc)[i4];
        const f32x4 y = (v[j] * rstd) * w * (c + 1.0f) + a;
        v2u o; o.x = pk2(y.x, y.y); o.y = pk2(y.z, y.w);
        if (FP8OUT) { unsigned w8 = 0; w8 = __builtin_amdgcn_cvt_pk_fp8_f32(y.x, y.y, w8, false); w8 = __builtin_amdgcn_cvt_pk_fp8_f32(y.z, y.w, w8, true); *(GAS unsigned*)((FP8OUT == 2 ? grow8 : (unsigned char*)grow) + 4 * i4) = w8; }
        if (FP8OUT != 1) *(GAS v2u*)(grow + 4 * i4) = o;
        *(LAS v2u*)(lrow + 4 * i4) = o;
    }
}
template <int NT32>
DI void skinny_bload(bf16x8 (&bf)[16][NT32], const bf16_t* Bt, int wave, int lane) {
#pragma unroll
    for (int ks = 0; ks < 16; ++ks)
#pragma unroll
        for (int j = 0; j < NT32; ++j) bf[ks][j] = *(const GAS bf16x8*)(Bt + (size_t)(32 * j + (lane & 31)) * 2048 + 256 * wave + 16 * ks + 8 * (lane >> 5));
}
template <int NT32>
DI void skinny_gemm(LAS unsigned char* tile, const bf16x8 (&bf)[16][NT32], f32x16 (&acc)[NT32], int wave, int lane, int row0 = 0, int rowmax = 31) {
    const int arow = (row0 + (lane & 31)) < rowmax ? (row0 + (lane & 31)) : rowmax;
#pragma unroll
    for (int ks = 0; ks < 16; ++ks) {
        const int k = 256 * wave + 16 * ks + 8 * (lane >> 5);
        const bf16x8 a = *(const LAS bf16x8*)(tile + arow * (AST * 2) + k * 2);
#pragma unroll
        for (int j = 0; j < NT32; ++j) acc[j] = MFMA32(a, bf[ks][j], acc[j]);
        if ((ks & 3) == 3) asm volatile("" ::: "memory");
    }
}
template <int NT32>
DI void skinny_store_partial(LAS float* red, const f32x16 (&acc)[NT32], int wave, int lane) {
#pragma unroll
    for (int j = 0; j < NT32; ++j)
#pragma unroll
        for (int r = 0; r < 16; ++r) red[(wave * 32 + crow32(r, lane >> 5)) * (32 * NT32) + 32 * j + (lane & 31)] = acc[j][r];
}

DI void p1_norm1(Frame& F) {
    const float* MOD = (const float*)(F.ws + WS_MOD);
    bf16_t* H = (bf16_t*)(F.ws + WS_H);
    float* GKD = (float*)(F.ws + WS_GKD);
    const bf16_t* WG = (const bf16_t*)(F.ws + WS_WGKD_T);
    const float* n1w = F.in[I_N1W];
    constexpr int RPT = 36;
    for (int tile = F.bid; tile < TA / RPT; tile += F.G) {
        const int nr = (F.wave < 4) ? 5 : 4, r0 = (F.wave < 4) ? 5 * F.wave : 20 + 4 * (F.wave - 4);
        {
            f32x4 va[8], vb[8];
            auto rowsrc = [&](int lr) -> const float* { const int row = tile * RPT + lr; return (row < T) ? (F.in[I_X] + (size_t)row * D) : (F.in[I_CTX] + (size_t)(row - T) * D); };
            auto finish = [&](const f32x4 (&v)[8], int lr) { const int row = tile * RPT + lr; const float* mr = MOD + (size_t)((row < T) ? (row / SEQ) : 4) * (NMOD * D);
                norm_row_finish<2>(v, n1w, mr, mr + D, H + (size_t)row * D, (LAS bf16_t*)F.lds + lr * AST, F.lane, F.ws + WS_H8 + (size_t)row * D); };
            norm_row_load(va, rowsrc(r0), F.lane);
            norm_row_load(vb, rowsrc(r0 + 1), F.lane); finish(va, r0);
            norm_row_load(va, rowsrc(r0 + 2), F.lane); finish(vb, r0 + 1);
            norm_row_load(vb, rowsrc(r0 + 3), F.lane); finish(va, r0 + 2);
            if (nr == 5) { norm_row_load(va, rowsrc(r0 + 4), F.lane); finish(vb, r0 + 3); finish(va, r0 + 4); }
            else finish(vb, r0 + 3);
        }
        bf16x8 bfr[16][1]; skinny_bload<1>(bfr, WG, F.wave, F.lane);
        __syncthreads();
        f32x16 acc0[1], acc1[1];
#pragma unroll
        for (int r = 0; r < 16; ++r) { acc0[0][r] = 0.f; acc1[0][r] = 0.f; }
        skinny_gemm<1>(F.lds, bfr, acc0, F.wave, F.lane, 0, 31);
        skinny_gemm<1>(F.lds, bfr, acc1, F.wave, F.lane, 32, RPT - 1);
        __syncthreads();
        LAS float* red = (LAS float*)F.lds;
        skinny_store_partial<1>(red, acc0, F.wave, F.lane);
        skinny_store_partial<1>(red + 8192, acc1, F.wave, F.lane);
        __syncthreads();
        for (int o = F.tid; o < RPT * 32; o += 512) { const int lr = o >> 5, n = o & 31; const LAS float* rp = red + (lr >> 5) * 8192 + (lr & 31) * 32 + n; float s = 0.f;
#pragma unroll
            for (int w = 0; w < 8; ++w) s += rp[w * 1024];
            GKD[(size_t)(tile * RPT + lr) * 32 + n] = s; }
        __syncthreads();
    }
}

DI bool static_tile(int L, int nM, int nN, int& pm, int& pn) {
    const int nwg = nM * nN; if (L >= nwg) return false;
    int wgid = L; { const int q = nwg / 8, r = nwg % 8, xcd = wgid % 8, off = wgid / 8; wgid = (xcd < r ? xcd * (q + 1) : r * (q + 1) + (xcd - r) * q) + off; }
    const int nig = 8 * nN, gid = wgid / nig, fm = gid * 8, gsz = (nM - fm) < 8 ? (nM - fm) : 8;
    pm = fm + ((wgid % nig) % gsz); pn = (wgid % nig) / gsz; return true;
}
struct DenseOrder {
    const bf16_t* A; const bf16_t* Bt; int nM, nN, K, G, c; bool halfn;
    DI bool next(int i, pg8::Unit& u) const {
        int pm, pn; const int L = i * G + c;
        if (!static_tile(halfn ? (L >> 1) : L, nM, nN, pm, pn)) return false;
        const int half = halfn ? (L & 1) : 0;
        u.a = (const char*)(A + (size_t)pm * 256 * K); u.b = (const char*)(Bt + ((size_t)pn * 256 + 128 * half) * K); u.idx = nullptr; u.nvalid = 256; u.pm = pm; u.pn = pn; u.e = 0;
        u.cb = 256 * pn + 128 * half; u.flags = halfn ? 2 : 0; return true;
    }
};
struct DenseOrder8 {
    const unsigned char* A; const unsigned char* Bt; int nM, nN, K, G, c;
    DI bool next(int i, pg8::Unit& u) const {
        int pm, pn; if (!static_tile(i * G + c, nM, nN, pm, pn)) return false;
        u.a = (const char*)(A + (size_t)pm * 256 * K); u.b = (const char*)(Bt + (size_t)pn * 256 * K); u.idx = nullptr; u.nvalid = 256; u.pm = pm; u.pn = pn; u.e = 0;
        u.cb = 256 * pn; u.flags = 0; return true;
    }
};
struct G1Order {
    const bf16_t* A; const bf16_t* Bt; int G, c;
    DI bool next(int i, pg8::Unit& u) const {
        const int L = i * G + c; int pm, pn;
        if (L < 128) { int j; static_tile(L, 32, 4, pm, j); pn = (j < 2) ? 4 + j : 8 + j; }
        else if (L < 136) { const int j = L - 128; pm = 32 + (j & 3); pn = 4 + (j >> 2); }
        else return false;
        u.a = (const char*)(A + (size_t)pm * 256 * D); u.b = (const char*)(Bt + (size_t)pn * 256 * D); u.idx = nullptr; u.nvalid = 256; u.pm = pm; u.pn = pn; u.e = 0;
        u.cb = 256 * pn; u.flags = 0; return true;
    }
};
struct G1Order8 {
    const unsigned char* A; const unsigned char* Bt; int G, c;
    DI bool next(int i, pg8::Unit& u) const {
        int L;
        if (G == 256) {
            if (i < 3) L = i * 256 + c;
            else { const int cc = c - 136; if (cc < 0) return false;
                if (i == 3) { if (cc >= 120) return false; L = 768 + cc; } else if (i == 4) { if (cc >= 40) return false; L = 888 + cc; } else return false; }
        } else { L = i * G + c; if (L >= 928) return false; }
        int pm, pn;
        if (L < 896) { int j; static_tile(L, 32, 28, pm, j); pn = (j < 4) ? j : ((j < 8) ? j + 2 : j + 4); }
        else { const int jj = L - 896, q = jj >> 2; pm = 32 + (jj & 3); pn = (q < 4) ? q : q + 2; }
        u.a = (const char*)(A + (size_t)pm * 256 * D); u.b = (const char*)(Bt + (size_t)pn * 256 * D); u.idx = nullptr; u.nvalid = 256; u.pm = pm; u.pn = pn; u.e = 0;
        u.cb = 256 * pn; u.flags = 0; return true;
    }
};
constexpr int MT_CNT = 0, MT_MT = 80, MT_NF = 160, MT_HB = 240, MT_XF = 320, MT_XL = 400, MT_WORDS = 480;
DI void moe_tables(Frame& F, volatile LAS int* tb) {
    if (F.tid < 65) {
        const unsigned* cnt = (const unsigned*)(F.ws + WS_CTL) + CW_CNT;
        tb[MT_CNT + F.tid] = (F.tid < 64) ? (int)__hip_atomic_load(cnt + 16 * F.tid, RLX_AGENT) : T;
    }
    __syncthreads();
    if (F.tid == 0) {
        int hb = 0;
        for (int e = 0; e <= 64; ++e) { const int c = tb[MT_CNT + e]; const int m = (c + 255) >> 8; tb[MT_MT + e] = m; tb[MT_NF + e] = (c + 127) >> 8; tb[MT_HB + e] = hb; hb += m * 256; }
        tb[MT_HB + 65] = hb;
        int af = 0, al = 0;
        for (int x = 0; x < 8; ++x) {
            for (int k = 0; k < 8; ++k) { const int e = x + 8 * k; tb[MT_XF + 10 * x + k] = af; tb[MT_XL + 10 * x + k] = al; af += tb[MT_NF + e]; al += tb[MT_MT + e] - tb[MT_NF + e]; }
            tb[MT_XF + 10 * x + 8] = af; af += 4; tb[MT_XF + 10 * x + 9] = af; tb[MT_XL + 10 * x + 8] = al; tb[MT_XL + 10 * x + 9] = al;
        }
    }
    __syncthreads();
}
constexpr int MT_UL = 480;
template <int NTN>
DI void moe_unit_list(Frame& F, volatile LAS int* tb) {
    if (F.tid < 64) {
        const int i = F.tid, c = F.bid, G = F.G;
        int e = -1, mtile = 0, nt_ = 0, fl = 0;
        const int xg = c & 7, R = G >> 3, UF = tb[MT_XF + 79] * NTN, UL = tb[MT_XL + 79] * NTN;
        const int f0 = (int)(((long)UF * xg) >> 3), f1 = (int)(((long)UF * (xg + 1)) >> 3), l0 = (int)(((long)UL * xg) >> 3), l1 = (int)(((long)UL * (xg + 1)) >> 3);
        const int Q = i * R + (c >> 3);
        if (Q < f1 - f0) {
            const int P = f0 + Q;
            int x = 0;
#pragma unroll
            for (int q = 1; q < 8; ++q) x += (tb[MT_XF + 10 * q] * NTN <= P) ? 1 : 0;
            int k = 0;
#pragma unroll
            for (int q = 1; q < 9; ++q) k += (tb[MT_XF + 10 * x + q] * NTN <= P) ? 1 : 0;
            const int loc = P - tb[MT_XF + 10 * x + k] * NTN;
            if (k < 8) { e = x + 8 * k; const int m = tb[MT_NF + e]; mtile = loc % m; nt_ = loc / m; }
            else { e = 64; mtile = 4 * x + (loc & 3); nt_ = loc >> 2; }
        } else if (Q - (f1 - f0) < l1 - l0) {
            const int P = l0 + Q - (f1 - f0);
            int x = 0;
#pragma unroll
            for (int q = 1; q < 8; ++q) x += (tb[MT_XL + 10 * q] * NTN <= P) ? 1 : 0;
            int k = 0;
#pragma unroll
            for (int q = 1; q < 8; ++q) k += (tb[MT_XL + 10 * x + q] * NTN <= P) ? 1 : 0;
            e = x + 8 * k; mtile = tb[MT_NF + e]; nt_ = P - tb[MT_XL + 10 * x + k] * NTN; fl = 1;
        }
        tb[MT_UL + 4 * i] = e; tb[MT_UL + 4 * i + 1] = mtile; tb[MT_UL + 4 * i + 2] = nt_; tb[MT_UL + 4 * i + 3] = fl;
    }
    __syncthreads();
}
template <int NTN, int ES>
struct MoeOrder {
    const volatile LAS int* tb; const unsigned char* A; const unsigned char* Bt; const int* list; int K, G, c;
    DI bool next(int i, pg8::Unit& u) const {
        if (i >= 64) return false;
        const int e = __builtin_amdgcn_readfirstlane(tb[MT_UL + 4 * i]);
        if (e < 0) return false;
        const int mtile = __builtin_amdgcn_readfirstlane(tb[MT_UL + 4 * i + 1]), nt_ = __builtin_amdgcn_readfirstlane(tb[MT_UL + 4 * i + 2]), fl = __builtin_amdgcn_readfirstlane(tb[MT_UL + 4 * i + 3]);
        const int hb = __builtin_amdgcn_readfirstlane(tb[MT_HB + e]), cnt = __builtin_amdgcn_readfirstlane(tb[MT_CNT + e]);
        u.e = e; u.pn = nt_; u.pm = (hb >> 8) + mtile; u.nvalid = (cnt - mtile * 256) < 256 ? (cnt - mtile * 256) : 256;
        u.cb = 256 * nt_; u.flags = fl;
        u.b = (const char*)(Bt + (size_t)e * (NTN * 256) * K * ES + (size_t)nt_ * 256 * 128);
        if (NTN == 4) { u.a = (const char*)A; u.idx = list + (size_t)e * T + mtile * 256; }
        else { u.a = (const char*)(A + (size_t)(hb + mtile * 256) * K * ES); u.idx = nullptr; }
        return true;
    }
};

DI v4u pack8(const f32x4 v0, const f32x4 v1) { v4u w; w.x = pg8::cvt_pk_bf16(v0[0], v0[1]); w.y = pg8::cvt_pk_bf16(v0[2], v0[3]); w.z = pg8::cvt_pk_bf16(v1[0], v1[1]); w.w = pg8::cvt_pk_bf16(v1[2], v1[3]); return w; }
DI void unpack8(const v4u w, f32x4& v0, f32x4& v1) { v0 = (f32x4){bflo(w.x), bfhi(w.x), bflo(w.y), bfhi(w.y)}; v1 = (f32x4){bflo(w.z), bfhi(w.z), bflo(w.w), bfhi(w.w)}; }

struct EpiG1 {
    static constexpr bool PERM = true;
    unsigned char* ws;
    DI void operator()(const f32x4 (&acc)[2][2][4][2], const pg8::Unit& u, int wr, int wc, int fr, int fq) const {
        const int pn = u.cb >> 8; bf16_t* dst; int ld, c0, act;
        if (pn < 4) { dst = (bf16_t*)(ws + WS_U); ld = 1024; c0 = 256 * pn; act = 0; }
        else if (pn < 6) { dst = (bf16_t*)(ws + WS_KK); ld = 512; c0 = 256 * (pn - 4); act = 0; }
        else if (pn < 10) { dst = (bf16_t*)(ws + WS_V); ld = 1024; c0 = 256 * (pn - 6); act = 0; }
        else if (pn < 12) { dst = (bf16_t*)(ws + WS_Q); ld = 512; c0 = 256 * (pn - 10); act = 1; }
        else if (pn < 16) { dst = (bf16_t*)(ws + WS_GO); ld = 1024; c0 = 256 * (pn - 12); act = 2; }
        else if (pn < 24) { dst = (bf16_t*)(ws + WS_GS); ld = 2048; c0 = 256 * (pn - 16); act = 3; }
        else { dst = (bf16_t*)(ws + WS_GG); ld = 2048; c0 = 256 * (pn - 24); act = 3; }
        const int row0 = u.pm * 256 + wr * 64 + fr, col0 = c0 + (u.cb & 255) + wc * 32 + 8 * fq;
#pragma unroll
        for (int ai = 0; ai < 2; ++ai)
#pragma unroll
            for (int m = 0; m < 4; ++m) { bf16_t* rowp = dst + (size_t)(row0 + ai * 128 + m * 16) * ld + col0;
#pragma unroll
                for (int bj = 0; bj < 2; ++bj) { if (bj && (u.flags & 2)) continue; f32x4 v0 = acc[ai][bj][m][0], v1 = acc[ai][bj][m][1];
                    if (act == 1) { v0 *= 0.08838834764831845f; v1 *= 0.08838834764831845f; }
                    else if (act == 2) {
#pragma unroll
                        for (int j = 0; j < 4; ++j) { v0[j] = siluf_(v0[j]); v1[j] = siluf_(v1[j]); } }
                    else if (act == 3) {
#pragma unroll
                        for (int j = 0; j < 4; ++j) { v0[j] = sigmoidf_(v0[j]); v1[j] = sigmoidf_(v1[j]); } }
                    *(GAS v4u*)(rowp + bj * 128) = pack8(v0, v1); } }
    }
};
template <int MODE>
struct EpiEw {
    static constexpr bool PERM = true;
    bf16_t* O; const bf16_t* P1; int ld;
    DI void operator()(const f32x4 (&acc)[2][2][4][2], const pg8::Unit& u, int wr, int wc, int fr, int fq) const {
        const int rl0 = wr * 64 + fr, col0 = u.cb + wc * 32 + 8 * fq;
        const bool nb1 = (u.flags & 2) != 0;
#pragma unroll
        for (int ai = 0; ai < 2; ++ai) {
            v4u p1[4][2], po[4][2];
            if (MODE != 3) {
#pragma unroll
                for (int m = 0; m < 4; ++m)
#pragma unroll
                    for (int bj = 0; bj < 2; ++bj) { if (bj && nb1) continue; const size_t off = (size_t)(u.pm * 256 + rl0 + ai * 128 + m * 16) * ld + col0 + bj * 128;
                        p1[m][bj] = *(const GAS v4u*)(P1 + off); if (MODE == 2) po[m][bj] = *(const GAS v4u*)(O + off); }
            }
#pragma unroll
            for (int m = 0; m < 4; ++m) { const int rl = rl0 + ai * 128 + m * 16; const size_t off = (size_t)(u.pm * 256 + rl) * ld + col0;
                if (MODE == 3 && rl >= u.nvalid) continue;
#pragma unroll
                for (int bj = 0; bj < 2; ++bj) { if (bj && nb1) continue; f32x4 v0 = acc[ai][bj][m][0], v1 = acc[ai][bj][m][1];
                    if (MODE != 3) { f32x4 q0, q1; unpack8(p1[m][bj], q0, q1);
                        if (MODE == 0) {
#pragma unroll
                            for (int j = 0; j < 4; ++j) { v0[j] = q0[j] * sigmoidf_(v0[j]); v1[j] = q1[j] * sigmoidf_(v1[j]); } }
                        else { v0 *= q0; v1 *= q1; }
                        if (MODE == 2) { f32x4 o0, o1; unpack8(po[m][bj], o0, o1); v0 += o0; v1 += o1; } }
                    if (MODE == 3) { unsigned w0 = 0, w1 = 0;
                        w0 = __builtin_amdgcn_cvt_pk_fp8_f32(v0[0], v0[1], w0, false); w0 = __builtin_amdgcn_cvt_pk_fp8_f32(v0[2], v0[3], w0, true);
                        w1 = __builtin_amdgcn_cvt_pk_fp8_f32(v1[0], v1[1], w1, false); w1 = __builtin_amdgcn_cvt_pk_fp8_f32(v1[2], v1[3], w1, true);
                        *(GAS v2u*)((unsigned char*)O + off + bj * 128) = (v2u){w0, w1}; }
                    else if (MODE == 0) { unsigned w0 = 0, w1 = 0;
                        w0 = __builtin_amdgcn_cvt_pk_fp8_f32(v0[0], v0[1], w0, false); w0 = __builtin_amdgcn_cvt_pk_fp8_f32(v0[2], v0[3], w0, true);
                        w1 = __builtin_amdgcn_cvt_pk_fp8_f32(v1[0], v1[1], w1, false); w1 = __builtin_amdgcn_cvt_pk_fp8_f32(v1[2], v1[3], w1, true);
                        *(GAS v2u*)((unsigned char*)O + off + bj * 128) = (v2u){w0, w1}; }
                    else *(GAS v4u*)(O + off + bj * 128) = pack8(v0, v1); } }
            asm volatile("" ::: "memory");
        }
    }
};
struct EpiY8 {
    static constexpr bool PERM = true;
    unsigned char* O; int ld;
    DI void operator()(const f32x4 (&acc)[2][2][4][2], const pg8::Unit& u, int wr, int wc, int fr, int fq) const {
        const bool odd = (fr & 1) != 0;
        const int rl0 = wr * 64 + (fr & ~1), colb = u.cb + 64 * wc + 8 * fq + (odd ? 32 : 0);
#pragma unroll
        for (int ai = 0; ai < 2; ++ai) {
#pragma unroll
            for (int m = 0; m < 4; ++m) {
                unsigned w[2][2];
#pragma unroll
                for (int bj = 0; bj < 2; ++bj) { const f32x4 v0 = acc[ai][bj][m][0], v1 = acc[ai][bj][m][1]; unsigned w0 = 0, w1 = 0;
                    w0 = __builtin_amdgcn_cvt_pk_fp8_f32(v0[0], v0[1], w0, false); w0 = __builtin_amdgcn_cvt_pk_fp8_f32(v0[2], v0[3], w0, true);
                    w1 = __builtin_amdgcn_cvt_pk_fp8_f32(v1[0], v1[1], w1, false); w1 = __builtin_amdgcn_cvt_pk_fp8_f32(v1[2], v1[3], w1, true);
                    w[bj][0] = w0; w[bj][1] = w1; }
                const unsigned s0 = odd ? w[0][0] : w[1][0], s1 = odd ? w[0][1] : w[1][1];
                const unsigned r0 = (unsigned)__builtin_amdgcn_mov_dpp((int)s0, 0xB1, 0xf, 0xf, true), r1 = (unsigned)__builtin_amdgcn_mov_dpp((int)s1, 0xB1, 0xf, 0xf, true);
                const v2u d1 = odd ? (v2u){r0, r1} : (v2u){w[0][0], w[0][1]};
                const v2u d2 = odd ? (v2u){w[1][0], w[1][1]} : (v2u){r0, r1};
                const int rl = rl0 + ai * 128 + m * 16; const size_t off = (size_t)(u.pm * 256 + rl) * ld + colb;
                if (rl < u.nvalid) *(GAS v2u*)(O + off) = d1;
                if (rl + 1 < u.nvalid) *(GAS v2u*)(O + off + ld) = d2;
            }
            asm volatile("" ::: "memory");
        }
    }
};
struct MergeOrder {
    const unsigned char* A0; const unsigned char* B0; const unsigned char* A1; const unsigned char* B1; int G, c;
    DI bool next(int i, pg8::Unit& u) const {
        const int t = (i >> 1) * G + c, ty = i & 1; int pm, pn;
        if (!static_tile(t, 32, 8, pm, pn)) return false;
        u.a = (const char*)((ty ? A1 : A0) + (size_t)pm * 256 * 1024); u.b = (const char*)((ty ? B1 : B0) + (size_t)pn * 256 * 1024); u.idx = nullptr; u.nvalid = 256; u.pm = pm; u.pn = pn; u.e = ty;
        u.cb = 256 * pn; u.flags = 0; return true;
    }
};
struct EpiMerge {
    static constexpr bool PERM = true; static constexpr int NSTORES = 0;
    bf16_t* M; const bf16_t* GS; const bf16_t* GG;
    DI void operator()(const f32x4 (&acc)[2][2][4][2], const pg8::Unit& u, int wr, int wc, int fr, int fq) const {
        if (u.e == 0) { EpiEw<1> e{M, GS, 2048}; e(acc, u, wr, wc, fr, fq); }
        else { EpiEw<2> e{M, GG, 2048}; e(acc, u, wr, wc, fr, fq); }
    }
};
DI void p64_swap(bool odd, f32x4 (&x0)[2], f32x4 (&x1)[2]) {
#pragma unroll
    for (int n = 0; n < 2; ++n)
#pragma unroll
        for (int j = 0; j < 4; ++j) {
            const float a = x0[n][j], b = x1[n][j];
            const float snd = odd ? a : b;
            const float rcv = __int_as_float(__builtin_amdgcn_mov_dpp(__float_as_int(snd), 0xB1, 0xf, 0xf, true));
            x0[n][j] = odd ? rcv : a; x1[n][j] = odd ? b : rcv;
        }
}
struct EpiMerge64 {
    static constexpr bool PERM = true;
    bf16_t* M; const bf16_t* GS; const bf16_t* GG; unsigned char* M8;
    DI void operator()(const f32x4 (&acc)[2][2][4][2], const pg8::Unit& u, int wr, int wc, int fr, int fq) const {
        const bool odd = (fr & 1) != 0, second = (u.e != 0);
        const bf16_t* P1 = second ? GG : GS;
        const size_t base = (size_t)(u.pm * 256 + wr * 64 + (fr & ~1)) * 2048 + u.cb + 64 * wc + (odd ? 32 : 0) + 8 * fq;
#pragma unroll
        for (int ai = 0; ai < 2; ++ai) {
            v4u p1[4][2], po[4][2];
#pragma unroll
            for (int m = 0; m < 4; ++m)
#pragma unroll
                for (int k = 0; k < 2; ++k) { const size_t off = base + (size_t)(ai * 128 + m * 16 + k) * 2048;
                    p1[m][k] = *(const GAS v4u*)(P1 + off); if (second) po[m][k] = *(const GAS v4u*)(M + off); }
#pragma unroll
            for (int m = 0; m < 4; ++m) {
                f32x4 y0[2] = {acc[ai][0][m][0], acc[ai][0][m][1]}, y1[2] = {acc[ai][1][m][0], acc[ai][1][m][1]};
                p64_swap(odd, y0, y1);
#pragma unroll
                for (int k = 0; k < 2; ++k) { const size_t off = base + (size_t)(ai * 128 + m * 16 + k) * 2048;
                    f32x4 v0 = k ? y1[0] : y0[0], v1 = k ? y1[1] : y0[1], q0, q1; unpack8(p1[m][k], q0, q1);
                    v0 *= q0; v1 *= q1;
                    if (second) { f32x4 o0, o1; unpack8(po[m][k], o0, o1); v0 += o0; v1 += o1;
                        unsigned w0 = 0, w1 = 0;
                        w0 = __builtin_amdgcn_cvt_pk_fp8_f32(v0[0], v0[1], w0, false); w0 = __builtin_amdgcn_cvt_pk_fp8_f32(v0[2], v0[3], w0, true);
                        w1 = __builtin_amdgcn_cvt_pk_fp8_f32(v1[0], v1[1], w1, false); w1 = __builtin_amdgcn_cvt_pk_fp8_f32(v1[2], v1[3], w1, true);
                        *(GAS v2u*)(M8 + off) = (v2u){w0, w1}; }
                    else *(GAS v4u*)(M + off) = pack8(v0, v1); }
            }
            asm volatile("" ::: "memory");
        }
    }
};
struct EpiOut {
    static constexpr bool PERM = true;
    const float* x; const float* mod; bf16_t* X1;
    DI void operator()(const f32x4 (&acc)[2][2][4][2], const pg8::Unit& u, int wr, int wc, int fr, int fq) const {
        const int row0 = u.pm * 256 + wr * 64 + fr, col0 = u.cb + wc * 32 + 8 * fq;
        const float* g1 = mod + (size_t)(u.pm * 256 / SEQ) * (NMOD * D) + 2 * D;
        f32x4 gv[2][2];
#pragma unroll
        for (int bj = 0; bj < 2; ++bj)
#pragma unroll
            for (int n = 0; n < 2; ++n) gv[bj][n] = *(const GAS f32x4*)(g1 + col0 + bj * 128 + n * 4);
#pragma unroll
        for (int ai = 0; ai < 2; ++ai)
#pragma unroll
            for (int mh = 0; mh < 2; ++mh) {
                f32x4 xs[2][2][2];
#pragma unroll
                for (int mm = 0; mm < 2; ++mm)
#pragma unroll
                    for (int bj = 0; bj < 2; ++bj)
#pragma unroll
                        for (int n = 0; n < 2; ++n) xs[mm][bj][n] = __builtin_nontemporal_load((const GAS f32x4*)(x + (size_t)(row0 + ai * 128 + (2 * mh + mm) * 16) * D + col0 + bj * 128 + n * 4));
#pragma unroll
                for (int mm = 0; mm < 2; ++mm)
#pragma unroll
                    for (int bj = 0; bj < 2; ++bj) { const int m = 2 * mh + mm;
                        *(GAS v4u*)(X1 + (size_t)(row0 + ai * 128 + m * 16) * D + col0 + bj * 128) = pack8(xs[mm][bj][0] + gv[bj][0] * acc[ai][bj][m][0], xs[mm][bj][1] + gv[bj][1] * acc[ai][bj][m][1]); }
                asm volatile("" ::: "memory");
            }
    }
};
struct EpiGU {
    static constexpr bool PERM = true;
    unsigned char* HID;
    DI void operator()(const f32x4 (&acc)[2][2][4][2], const pg8::Unit& u, int wr, int wc, int fr, int fq) const {
        const int rl0 = wr * 64 + fr, col0 = u.pn * 128 + wc * 32 + 8 * fq;
#pragma unroll
        for (int ai = 0; ai < 2; ++ai)
#pragma unroll
            for (int m = 0; m < 4; ++m) { const int rl = rl0 + ai * 128 + m * 16; if (rl >= u.nvalid) continue;
                float v[8];
#pragma unroll
                for (int j = 0; j < 4; ++j) { v[j] = siluf_(acc[ai][0][m][0][j]) * acc[ai][1][m][0][j]; v[4 + j] = siluf_(acc[ai][0][m][1][j]) * acc[ai][1][m][1][j]; }
                unsigned w0 = 0, w1 = 0;
                w0 = __builtin_amdgcn_cvt_pk_fp8_f32(v[0], v[1], w0, false); w0 = __builtin_amdgcn_cvt_pk_fp8_f32(v[2], v[3], w0, true);
                w1 = __builtin_amdgcn_cvt_pk_fp8_f32(v[4], v[5], w1, false); w1 = __builtin_amdgcn_cvt_pk_fp8_f32(v[6], v[7], w1, true);
                *(GAS v2u*)(HID + (size_t)(u.pm * 256 + rl) * DEXP + col0) = (v2u){w0, w1}; }
    }
};

DI float gelu_tanh(float x) {
    const float u = 0.7978845608028654f * (x + 0.044715f * x * x * x);
    const float e = __expf(2.f * u);
    const float th = 1.f - 2.f * __builtin_amdgcn_rcpf(e + 1.f);
    return 0.5f * x * (1.f + th);
}
DI int chunk_rowbase(int b, int n) { return (n < NCHC) ? (T + b * CTX + n * GCH) : (b * SEQ + (n - NCHC) * GCH); }
DI float fma_s(float a, float b, float c) { float r; asm("v_fma_f32 %0, %1, %2, %3" : "=v"(r) : "v"(a), "v"(b), "v"(c)); return r; }
struct S5Cur { bf16x8 afr[2]; f32x2 s; };
template <bool READOUT, int DR>
DI void s5_dir(f32x4 (&yacc)[2][2], const S5Cur& o, f32x2& sout, const f32x2 lam, const bf16x8 (&bfr)[4], const bf16x8 (&cfr)[4], LAS unsigned char* hsb, int lane) {
    const int l15 = lane & 15, q4 = lane >> 4;
    const float lr = lam.x, li = lam.y, nli = -lam.y;
    float sr = o.s.x, si = o.s.y;
#pragma unroll
    for (int sbi = 0; sbi < 2; ++sbi) {
        const int sb = DR ? (1 - sbi) : sbi;
        f32x16 c[4];
#pragma unroll
        for (int j = 0; j < 4; ++j) {
#pragma unroll
            for (int r = 0; r < 16; ++r) c[j][r] = 0.f;
            c[j] = MFMA32(o.afr[sb], bfr[j], c[j]);
        }
        float xr[2][16], xi[2][16];
#pragma unroll
        for (int r = 0; r < 16; ++r) {
            const float c0 = c[0][r], c1 = c[1][r], c2 = c[2][r], c3 = c[3][r];
            auto pr = __builtin_amdgcn_permlane32_swap(__float_as_uint(c0), __float_as_uint(c2), false, false);
            auto pi = __builtin_amdgcn_permlane32_swap(__float_as_uint(c1), __float_as_uint(c3), false, false);
            const unsigned pr0 = pr[0], pr1 = pr[1], pi0 = pi[0], pi1 = pi[1];
            xr[0][r] = __uint_as_float(pr0); xr[1][r] = __uint_as_float(pr1);
            xi[0][r] = __uint_as_float(pi0); xi[1][r] = __uint_as_float(pi1);
        }
        if (READOUT) asm volatile("s_waitcnt lgkmcnt(0)" ::: "memory");
#pragma unroll
        for (int tt = 0; tt < 32; ++tt) {
            const int t = DR ? (31 - tt) : tt;
            const int half = (t >> 2) & 1, r = (t & 3) + 4 * (t >> 3);
            const float t1 = fma_s(nli, si, xr[half][r]), t2 = fma_s(li, sr, xi[half][r]);
            const float nr = fma_s(lr, sr, t1), ni = fma_s(lr, si, t2);
            sr = nr; si = ni;
            if (READOUT) *(LAS unsigned*)(hsb + t * 256 + ((((lane >> 2) ^ (t & 15))) << 4) + (lane & 3) * 4) = pk2(nr, ni);
        }
        if (READOUT) {
            asm volatile("s_waitcnt lgkmcnt(0)" ::: "memory");
#pragma unroll
            for (int mt = 0; mt < 2; ++mt)
#pragma unroll
                for (int ks = 0; ks < 4; ++ks) {
                    const int row = 16 * mt + l15, ch = 4 * ks + q4;
                    const bf16x8 a = *(const LAS bf16x8*)(hsb + row * 256 + ((ch ^ l15) << 4));
                    yacc[sb][mt] = MFMA16(a, cfr[ks], yacc[sb][mt]);
                }
        }
    }
    sout = (f32x2){sr, si};
}
template <bool READOUT>
DI void s5_phase(Frame& F) {
    constexpr int NC = READOUT ? NCHL : NCH, NIT = NB * NC * 16;
    const int lane = F.lane, l31 = lane & 31, hi = lane >> 5, l15 = lane & 15, q4 = lane >> 4;
    const int gq = F.wave & 3, dr = F.wave >> 2;
    LAS unsigned char* hsb = F.lds + F.wave * 8192;
    LAS float* ysh = (LAS float*)(F.lds + 65536) + gq * 1024;
    int itn = 0;
    const bf16_t* U = (const bf16_t*)(F.ws + WS_U);
    const bf16_t* BT = (const bf16_t*)(F.ws + WS_S5TAB + S5TAB_BT);
    const bf16_t* CT = (const bf16_t*)(F.ws + WS_S5TAB + S5TAB_CT);
    const f32x2* LAM = (const f32x2*)(F.ws + WS_S5TAB + S5TAB_LAM);
    f32x2* ST = (f32x2*)(F.ws + WS_S5ST);
    bf16_t* YS = (bf16_t*)(F.ws + WS_YS);
    bf16x8 bfr[4], cfr[4]; f32x2 lam = (f32x2){0.f, 0.f}; int cur_gb4 = -1;
    S5Cur cur, nxt;
#define S5_LOAD(dst, jj) do { const int gb4_ = (jj) & 15, rest_ = (jj) >> 4, n_ = (rest_ % NC) + (READOUT ? NCHC : 0), b_ = rest_ / NC, g_ = gb4_ * 4 + gq, base_ = chunk_rowbase(b_, n_); \
        _Pragma("unroll") for (int sb = 0; sb < 2; ++sb) (dst).afr[sb] = *(const GAS bf16x8*)(U + (size_t)(base_ + 32 * sb + l31) * S5W + g_ * 16 + 8 * hi); \
        (dst).s = READOUT ? ST[((size_t)((b_ * NCH + n_) * 2 + dr) * 64 + g_) * 64 + lane] : (f32x2){0.f, 0.f}; } while (0)
    if (F.bid < NIT) S5_LOAD(cur, F.bid);
    for (int j = F.bid; j < NIT; j += F.G) {
        const int gb4 = j & 15, rest = j >> 4, n = (rest % NC) + (READOUT ? NCHC : 0), b = rest / NC, g = gb4 * 4 + gq, base = chunk_rowbase(b, n), tg = dr * 64 + g;
        if (gb4 != cur_gb4) {
#pragma unroll
            for (int jj = 0; jj < 4; ++jj) bfr[jj] = *(const GAS bf16x8*)(BT + ((size_t)tg * 128 + 32 * jj + l31) * 16 + 8 * hi);
#pragma unroll
            for (int ks = 0; ks < 4; ++ks) cfr[ks] = READOUT ? *(const GAS bf16x8*)(CT + ((size_t)tg * 16 + l15) * 128 + 32 * ks + 8 * q4) : bfr[ks];
            lam = LAM[tg * 64 + lane]; cur_gb4 = gb4;
        }
        if (j + F.G < NIT) S5_LOAD(nxt, j + F.G);
        f32x4 yacc[2][2];
#pragma unroll
        for (int a = 0; a < 2; ++a)
#pragma unroll
            for (int c = 0; c < 2; ++c) yacc[a][c] = (f32x4){0.f, 0.f, 0.f, 0.f};
        float uskip[8];
        if (READOUT) {
#pragma unroll
            for (int mt = 0; mt < 2; ++mt)
#pragma unroll
                for (int i = 0; i < 4; ++i) uskip[mt * 4 + i] = bf2f(U[(size_t)(base + 32 * dr + 16 * mt + 4 * q4 + i) * S5W + g * 16 + l15]);
        }
        f32x2 sout;
        if (dr == 0) s5_dir<READOUT, 0>(yacc, cur, sout, lam, bfr, cfr, hsb, lane);
        else s5_dir<READOUT, 1>(yacc, cur, sout, lam, bfr, cfr, hsb, lane);
        if (!READOUT) ST[((size_t)((b * NCH + n) * 2 + dr) * 64 + g) * 64 + lane] = sout;
        if (READOUT) {
            LAS float* yx = ysh + (itn & 1) * 4096;
            const int ch = g * 16 + l15; const int osb = 1 - dr;
#pragma unroll
            for (int mt = 0; mt < 2; ++mt)
#pragma unroll
                for (int i = 0; i < 4; ++i) yx[osb * 512 + (16 * mt + 4 * q4 + i) * 16 + l15] = (osb == 0) ? yacc[0][mt][i] : yacc[1][mt][i];
            LDS_BAR();
            const float dsk = F.in[I_S5D][ch];
#pragma unroll
            for (int mt = 0; mt < 2; ++mt)
#pragma unroll
                for (int i = 0; i < 4; ++i) {
                    const int row = 32 * dr + 16 * mt + 4 * q4 + i; const size_t o = (size_t)(base + row) * S5W + ch;
                    const float mine = (dr == 0) ? yacc[0][mt][i] : yacc[1][mt][i];
                    YS[o] = (bf16_t)f2bf(gelu_tanh(mine + yx[dr * 512 + (16 * mt + 4 * q4 + i) * 16 + l15] + dsk * uskip[mt * 4 + i]));
                }
        }
        ++itn;
        cur = nxt;
    }
#undef S5_LOAD
}
DI int chunk_order(int dr, int step) { return dr == 0 ? step : (step < NCHC ? NCHC - 1 - step : NCH + NCHC - 1 - step); }
DI void s5_carry(Frame& F) {
    const int gid = F.bid * 512 + F.tid;
    if (gid >= NB * 2 * 4096) return;
    const int b = gid >> 13, dr = (gid >> 12) & 1, gp = gid & 4095;
    const f32x2 l64 = ((const f32x2*)(F.ws + WS_S5TAB + S5TAB_LAM64))[dr * 4096 + gp];
    f32x2* ST = (f32x2*)(F.ws + WS_S5ST);
    f32x2 e[NCH];
#pragma unroll
    for (int step = 0; step < NCH; ++step) e[step] = ST[(size_t)((b * NCH + chunk_order(dr, step)) * 2 + dr) * 4096 + gp];
    f32x2 h = (f32x2){0.f, 0.f};
#pragma unroll
    for (int step = 0; step < NCH; ++step) {
        ST[(size_t)((b * NCH + chunk_order(dr, step)) * 2 + dr) * 4096 + gp] = h;
        h = (f32x2){l64.x * h.x - l64.y * h.y + e[step].x, l64.x * h.y + l64.y * h.x + e[step].y};
    }
}

constexpr int KST = 72;
constexpr int QST = 136;
struct GlaPre { float up[16]; float bias; f32x4 gs; };
DI void gla_pre_load(Frame& F, int rowbase, int h, int dr, GlaPre& p) {
    const int c = F.tid & 127;
    const float* GKD = (const float*)(F.ws + WS_GKD);
#pragma unroll
    for (int r = 0; r < 16; ++r) p.up[r] = F.in[I_GKUP][(size_t)(dr * 16 + r) * GKW + h * GDK + c];
    p.bias = F.in[I_GKB][dr * GKW + h * GDK + c];
    p.gs = (F.tid < 256) ? *(const GAS f32x4*)(GKD + (size_t)(rowbase + (F.tid >> 2)) * 32 + 16 * dr + 4 * (F.tid & 3)) : (f32x4){0.f, 0.f, 0.f, 0.f};
}
DI float gla_decay(Frame& F, int dr, const GlaPre& p, LAS float* gsc, LAS float* tot, float (&bv)[16]) {
    const int c = F.tid & 127, tq = F.tid >> 7;
    if (F.tid < 256) *(LAS f32x4*)(gsc + (F.tid >> 2) * 16 + 4 * (F.tid & 3)) = p.gs;
    LDS_BAR();
    float gl[16];
#pragma unroll
    for (int tt = 0; tt < 16; ++tt) {
        const LAS f32x4* gr = (const LAS f32x4*)(gsc + (16 * tq + tt) * 16);
        float z = p.bias;
#pragma unroll
        for (int r4 = 0; r4 < 4; ++r4) { const f32x4 gv = gr[r4]; z += gv.x * p.up[4 * r4] + gv.y * p.up[4 * r4 + 1] + gv.z * p.up[4 * r4 + 2] + gv.w * p.up[4 * r4 + 3]; }
        gl[tt] = (fminf(z, 0.f) - __logf(1.f + __expf(-fabsf(z)))) * (1.f / 16.f);
    }
    float run = 0.f;
    if (dr == 0) {
#pragma unroll
        for (int tt = 0; tt < 16; ++tt) { run += gl[tt]; bv[tt] = run; }
    } else {
#pragma unroll
        for (int tt = 15; tt >= 0; --tt) { run += gl[tt]; bv[tt] = run; }
    }
    tot[tq * 128 + c] = run;
    LDS_BAR();
    const float t0 = tot[c], t1 = tot[128 + c], t2 = tot[256 + c], t3 = tot[384 + c];
    float off;
    if (dr == 0) off = (tq > 0 ? t0 : 0.f) + (tq > 1 ? t1 : 0.f) + (tq > 2 ? t2 : 0.f);
    else off = (tq < 1 ? t1 : 0.f) + (tq < 2 ? t2 : 0.f) + (tq < 3 ? t3 : 0.f);
#pragma unroll
    for (int tt = 0; tt < 16; ++tt) bv[tt] += off;
    return (t0 + t1) + (t2 + t3);
}
DI void gla_vT_load(Frame& F, int rowbase, int h, unsigned short (&e)[32]) {
    const bf16_t* V = (const bf16_t*)(F.ws + WS_V);
    const int dv = F.tid & 255, half = F.tid >> 8;
#pragma unroll
    for (int j = 0; j < 32; ++j) e[j] = V[(size_t)(rowbase + 32 * half + j) * GVW + h * GDV + dv];
}
DI void gla_vT_store(Frame& F, const unsigned short (&e)[32], LAS bf16_t* vT) {
    const int dv = F.tid & 255, half = F.tid >> 8;
#pragma unroll
    for (int t8 = 0; t8 < 4; ++t8) {
        v4u w; w.x = e[8 * t8] | ((unsigned)e[8 * t8 + 1] << 16); w.y = e[8 * t8 + 2] | ((unsigned)e[8 * t8 + 3] << 16); w.z = e[8 * t8 + 4] | ((unsigned)e[8 * t8 + 5] << 16); w.w = e[8 * t8 + 6] | ((unsigned)e[8 * t8 + 7] << 16);
        *(LAS v4u*)(vT + dv * KST + 32 * half + 8 * t8) = w;
    }
}
DI void gla_state_item(Frame& F, int b, int h, int n) {
    LAS float* gsc = (LAS float*)F.lds; LAS float* tot = (LAS float*)(F.lds + 4096);
    LAS bf16_t* kdT = (LAS bf16_t*)(F.lds + 6144); LAS bf16_t* vT = (LAS bf16_t*)(F.lds + 24576);
    const int rowbase = chunk_rowbase(b, n);
    const bf16_t* KK = (const bf16_t*)(F.ws + WS_KK);
    bf16_t* GST = (bf16_t*)(F.ws + WS_GST); float* GDEC = (float*)(F.ws + WS_GDEC);
    const int c = F.tid & 127, tq = F.tid >> 7, lane = F.lane, l31 = lane & 31, hi = lane >> 5, w = F.wave;
    GlaPre pre[2]; unsigned short ve[32]; float kf[16];
    gla_pre_load(F, rowbase, h, 0, pre[0]); gla_pre_load(F, rowbase, h, 1, pre[1]);
#pragma unroll
    for (int tt = 0; tt < 16; ++tt) kf[tt] = bf2f(KK[(size_t)(rowbase + 16 * tq + tt) * GKW + h * GDK + c]);
    gla_vT_load(F, rowbase, h, ve);
    gla_vT_store(F, ve, vT);
#pragma unroll
    for (int dr = 0; dr < 2; ++dr) {
        float bv[16];
        const float blast = gla_decay(F, dr, pre[dr], gsc, tot, bv);
        const size_t sbase = (size_t)(((b * GH + h) * NCH + n) * 2 + dr);
        unsigned pk[8];
#pragma unroll
        for (int t2 = 0; t2 < 8; ++t2) pk[t2] = pk2(kf[2 * t2] * __expf(blast - bv[2 * t2]), kf[2 * t2 + 1] * __expf(blast - bv[2 * t2 + 1]));
        *(LAS v4u*)(kdT + c * KST + 16 * tq) = (v4u){pk[0], pk[1], pk[2], pk[3]};
        *(LAS v4u*)(kdT + c * KST + 16 * tq + 8) = (v4u){pk[4], pk[5], pk[6], pk[7]};
        if (tq == 0) GDEC[sbase * GDK + c] = __expf(blast);
        LDS_BAR();
        f32x16 acc[4];
#pragma unroll
        for (int j = 0; j < 4; ++j)
#pragma unroll
            for (int r = 0; r < 16; ++r) acc[j][r] = 0.f;
#pragma unroll
        for (int ks = 0; ks < 4; ++ks) {
            const bf16x8 a = *(const LAS bf16x8*)(vT + (32 * w + l31) * KST + 16 * ks + 8 * hi);
#pragma unroll
            for (int j = 0; j < 4; ++j) { const bf16x8 bb = *(const LAS bf16x8*)(kdT + (32 * j + l31) * KST + 16 * ks + 8 * hi); acc[j] = MFMA32(a, bb, acc[j]); }
        }
#pragma unroll
        for (int j = 0; j < 4; ++j)
#pragma unroll
            for (int r = 0; r < 16; ++r) GST[(sbase * GDV + 32 * w + crow32(r, hi)) * GDK + 32 * j + l31] = (bf16_t)f2bf(acc[j][r]);
        LDS_BAR();
    }
}
DI void gla_carry(Frame& F) {
    bf16_t* GST = (bf16_t*)(F.ws + WS_GST); const float* GDEC = (const float*)(F.ws + WS_GDEC);
    for (int chain = F.bid * 512 + F.tid; chain < NB * GH * 2 * GDV * 16; chain += F.G * 512) {
        const int k8 = chain & 15, dv = (chain >> 4) & 255, dr = (chain >> 12) & 1, h = (chain >> 13) & 3, b = chain >> 15;
        float S[8];
#pragma unroll
        for (int j = 0; j < 8; ++j) S[j] = 0.f;
        constexpr int PF = 4;
        v4u dsw[PF]; f32x4 d0[PF], d1[PF];
#define GC_LOAD(slot, step_) do { const int n_ = chunk_order(dr, (step_)); const size_t sb_ = (size_t)(((b * GH + h) * NCH + n_) * 2 + dr); \
            dsw[slot] = __builtin_nontemporal_load((const GAS v4u*)(GST + (sb_ * GDV + dv) * GDK + 8 * k8)); d0[slot] = *(const GAS f32x4*)(GDEC + sb_ * GDK + 8 * k8); d1[slot] = *(const GAS f32x4*)(GDEC + sb_ * GDK + 8 * k8 + 4); } while (0)
#pragma unroll
        for (int q = 0; q < PF; ++q) GC_LOAD(q, q);
#pragma unroll
        for (int step0 = 0; step0 < NCH; step0 += PF) {
#pragma unroll
            for (int q = 0; q < PF; ++q) {
                const int step = step0 + q;
                const int n = chunk_order(dr, step);
                const size_t sbase = (size_t)(((b * GH + h) * NCH + n) * 2 + dr);
                const v4u w = dsw[q]; const f32x4 e0d = d0[q], e1d = d1[q];
                *(GAS v4u*)(GST + (sbase * GDV + dv) * GDK + 8 * k8) = (v4u){pk2(S[0], S[1]), pk2(S[2], S[3]), pk2(S[4], S[5]), pk2(S[6], S[7])};
                if (step + PF < NCH) GC_LOAD(q, step + PF);
                f32x4 e0, e1; unpack8(w, e0, e1);
#pragma unroll
                for (int j = 0; j < 4; ++j) { S[j] = e0d[j] * S[j] + e0[j]; S[4 + j] = e1d[j] * S[4 + j] + e1[j]; }
            }
        }
#undef GC_LOAD
    }
}
DI void gla_out_item(Frame& F, int b, int h, int nl) {
    LAS float* gsc = (LAS float*)F.lds; LAS float* tot = (LAS float*)(F.lds + 4096);
    LAS bf16_t* qb = (LAS bf16_t*)(F.lds + 6144); LAS bf16_t* kb = (LAS bf16_t*)(F.lds + 23552);
    LAS bf16_t* vT = (LAS bf16_t*)(F.lds + 40960); LAS bf16_t* P = (LAS bf16_t*)(F.lds + 77824);
    LAS float* ot = (LAS float*)F.lds;
    const int n = nl + NCHC, rowbase = b * SEQ + nl * GCH;
    const bf16_t* KK = (const bf16_t*)(F.ws + WS_KK); const bf16_t* Q = (const bf16_t*)(F.ws + WS_Q);
    const bf16_t* GST = (const bf16_t*)(F.ws + WS_GST);
    const int c = F.tid & 127, tq = F.tid >> 7, lane = F.lane, l31 = lane & 31, hi = lane >> 5, w = F.wave;
    f32x16 oacc[2];
#pragma unroll
    for (int mi = 0; mi < 2; ++mi)
#pragma unroll
        for (int r = 0; r < 16; ++r) oacc[mi][r] = 0.f;
    GlaPre pre[2]; unsigned short ve[32]; float kf[16], qf[16]; bf16x8 sfr[2][8];
    gla_pre_load(F, rowbase, h, 0, pre[0]); gla_pre_load(F, rowbase, h, 1, pre[1]);
#pragma unroll
    for (int tt = 0; tt < 16; ++tt) { kf[tt] = bf2f(KK[(size_t)(rowbase + 16 * tq + tt) * GKW + h * GDK + c]); qf[tt] = bf2f(Q[(size_t)(rowbase + 16 * tq + tt) * GKW + h * GDK + c]); }
    gla_vT_load(F, rowbase, h, ve);
#pragma unroll
    for (int dr = 0; dr < 2; ++dr)
#pragma unroll
        for (int ks = 0; ks < 8; ++ks) sfr[dr][ks] = *(const GAS bf16x8*)(GST + (((size_t)(((b * GH + h) * NCH + n) * 2 + dr)) * GDV + 32 * w + l31) * GDK + 16 * ks + 8 * hi);
    v4u gov[4];
    { const size_t o_ = (size_t)(rowbase + (F.tid >> 3)) * GVW + h * GDV + 32 * (F.tid & 7); const bf16_t* GO_ = (const bf16_t*)(F.ws + WS_GO);
#pragma unroll
      for (int j2 = 0; j2 < 4; ++j2) gov[j2] = *(const GAS v4u*)(GO_ + o_ + 8 * j2); }
    gla_vT_store(F, ve, vT);
#pragma unroll
    for (int dr = 0; dr < 2; ++dr) {
        float bv[16];
        (void)gla_decay(F, dr, pre[dr], gsc, tot, bv);
#pragma unroll
        for (int tt = 0; tt < 16; ++tt) {
            const int tau = 16 * tq + tt;
            qb[tau * QST + c] = (bf16_t)f2bf(qf[tt] * __expf(bv[tt]));
            kb[tau * QST + c] = (bf16_t)f2bf(kf[tt] * __expf(-bv[tt]));
        }
        LDS_BAR();
        if (w < 4) {
            const int mi = w >> 1, nj = w & 1;
            f32x16 sc;
#pragma unroll
            for (int r = 0; r < 16; ++r) sc[r] = 0.f;
#pragma unroll
            for (int ks = 0; ks < 8; ++ks) {
                const bf16x8 a = *(const LAS bf16x8*)(qb + (32 * mi + l31) * QST + 16 * ks + 8 * hi);
                const bf16x8 bb = *(const LAS bf16x8*)(kb + (32 * nj + l31) * QST + 16 * ks + 8 * hi);
                sc = MFMA32(a, bb, sc);
            }
#pragma unroll
            for (int r = 0; r < 16; ++r) { const int i = 32 * mi + crow32(r, hi), j = 32 * nj + l31;
                const bool keep = dr ? (j > i) : (j <= i);
                P[i * KST + j] = (bf16_t)f2bf(keep ? sc[r] : 0.f); }
        } else {
        }
#pragma unroll
        for (int ks = 0; ks < 8; ++ks) {
#pragma unroll
            for (int mi = 0; mi < 2; ++mi) { const bf16x8 a = *(const LAS bf16x8*)(qb + (32 * mi + l31) * QST + 16 * ks + 8 * hi); oacc[mi] = MFMA32(a, sfr[dr][ks], oacc[mi]); }
        }
        LDS_BAR();
#pragma unroll
        for (int mi = 0; mi < 2; ++mi) {
#pragma unroll
            for (int ks = 0; ks < 4; ++ks) {
                const bf16x8 a = *(const LAS bf16x8*)(P + (32 * mi + l31) * KST + 16 * ks + 8 * hi);
                const bf16x8 bb = *(const LAS bf16x8*)(vT + (32 * w + l31) * KST + 16 * ks + 8 * hi);
                oacc[mi] = MFMA32(a, bb, oacc[mi]);
            }
        }
        LDS_BAR();
    }
#pragma unroll
    for (int mi = 0; mi < 2; ++mi)
#pragma unroll
        for (int r = 0; r < 16; ++r) ot[(32 * mi + crow32(r, hi)) * 260 + 32 * w + l31] = oacc[mi][r];
    LDS_BAR();
    {
        const int i = F.tid >> 3, seg = F.tid & 7;
        const LAS f32x4* orow = (const LAS f32x4*)(ot + i * 260 + 32 * seg);
        f32x4 v[8]; float ss = 0.f;
#pragma unroll
        for (int j = 0; j < 8; ++j) { v[j] = orow[j]; ss += (v[j].x * v[j].x + v[j].y * v[j].y) + (v[j].z * v[j].z + v[j].w * v[j].w); }
        ss += __shfl_xor(ss, 1); ss += __shfl_xor(ss, 2); ss += __shfl_xor(ss, 4);
        const float rstd = rsqrtf(ss * (1.f / GDV) + EPS);
        const size_t o = (size_t)(rowbase + i) * GVW + h * GDV + 32 * seg;
        unsigned char* OG = F.ws + WS_OG;
        const float* gnw = F.in[I_GNW] + 32 * seg; f32x4 wv[8];
#pragma unroll
        for (int j2 = 0; j2 < 8; ++j2) wv[j2] = *(const GAS f32x4*)(gnw + 4 * j2);
#pragma unroll
        for (int j2 = 0; j2 < 4; ++j2) {
            f32x4 g0, g1; unpack8(gov[j2], g0, g1);
            const f32x4 a0 = v[2 * j2] * rstd * wv[2 * j2] * g0, a1 = v[2 * j2 + 1] * rstd * wv[2 * j2 + 1] * g1;
            unsigned w0 = 0, w1 = 0;
            w0 = __builtin_amdgcn_cvt_pk_fp8_f32(a0.x, a0.y, w0, false); w0 = __builtin_amdgcn_cvt_pk_fp8_f32(a0.z, a0.w, w0, true);
            w1 = __builtin_amdgcn_cvt_pk_fp8_f32(a1.x, a1.y, w1, false); w1 = __builtin_amdgcn_cvt_pk_fp8_f32(a1.z, a1.w, w1, true);
            *(GAS v2u*)(OG + o + 8 * j2) = (v2u){w0, w1};
        }
    }
    LDS_BAR();
}

DI void p9_route(Frame& F) {
    const float* MOD = (const float*)(F.ws + WS_MOD);
    const bf16_t* X1 = (const bf16_t*)(F.ws + WS_X1);
    bf16_t* T2 = (bf16_t*)(F.ws + WS_T2);
    const bf16_t* RT = (const bf16_t*)(F.ws + WS_ROUT_T);
    unsigned* cnt = (unsigned*)(F.ws + WS_CTL) + CW_CNT;
    int* list = (int*)(F.ws + WS_ROUTE + ROUTE_LIST);
    int* eidx = (int*)(F.ws + WS_ROUTE + ROUTE_EIDX); int* slot = (int*)(F.ws + WS_ROUTE + ROUTE_SLOT); float* wts = (float*)(F.ws + WS_ROUTE + ROUTE_WTS);
    LAS float* lg = (LAS float*)(F.lds + 65536);
    LAS unsigned* hist = (LAS unsigned*)(F.lds + 65536 + 8192);
    LAS unsigned* hbase = hist + 64;
    LAS float* wcv = (LAS float*)(F.lds + 132096); LAS float* shv = wcv + 2048;
    const int lane = F.lane;
    for (int tile = F.bid; tile < T / 32; tile += F.G) {
        bf16x8 bfA[16][1]; skinny_bload<1>(bfA, RT, F.wave, lane);
        {
            v4u ra[4], rb[4];
            auto load = [&](v4u (&r)[4], int lr) { const bf16_t* xr = X1 + (size_t)(tile * 32 + lr) * D + 8 * lane;
#pragma unroll
                for (int j = 0; j < 4; ++j) r[j] = *(const GAS v4u*)(xr + 512 * j); };
            auto finish = [&](const v4u (&r)[4], int lr) { const int row = tile * 32 + lr;
                f32x4 v[8]; float ss = 0.f;
#pragma unroll
                for (int j = 0; j < 4; ++j) { unpack8(r[j], v[2 * j], v[2 * j + 1]);
                    ss += (v[2 * j].x * v[2 * j].x + v[2 * j].y * v[2 * j].y) + (v[2 * j].z * v[2 * j].z + v[2 * j].w * v[2 * j].w) + (v[2 * j + 1].x * v[2 * j + 1].x + v[2 * j + 1].y * v[2 * j + 1].y) + (v[2 * j + 1].z * v[2 * j + 1].z + v[2 * j + 1].w * v[2 * j + 1].w); }
                const float rstd = rsqrtf(wave_sum(ss) * (1.f / 2048.f) + EPS);
#pragma unroll
                for (int j = 0; j < 4; ++j) { const int col = 8 * lane + 512 * j;
                    f32x4 y[2];
#pragma unroll
                    for (int q = 0; q < 2; ++q) { const f32x4 wc = *(const LAS f32x4*)(wcv + col + 4 * q), a = *(const LAS f32x4*)(shv + col + 4 * q);
                        y[q] = (v[2 * j + q] * rstd) * wc + a; }
                    unsigned w0 = 0, w1 = 0;
                    w0 = __builtin_amdgcn_cvt_pk_fp8_f32(y[0].x, y[0].y, w0, false); w0 = __builtin_amdgcn_cvt_pk_fp8_f32(y[0].z, y[0].w, w0, true);
                    w1 = __builtin_amdgcn_cvt_pk_fp8_f32(y[1].x, y[1].y, w1, false); w1 = __builtin_amdgcn_cvt_pk_fp8_f32(y[1].z, y[1].w, w1, true);
                    *(GAS v2u*)((unsigned char*)T2 + (size_t)row * D + col) = (v2u){w0, w1};
                    *(LAS v4u*)((LAS bf16_t*)F.lds + lr * AST + col) = (v4u){pk2(y[0].x, y[0].y), pk2(y[0].z, y[0].w), pk2(y[1].x, y[1].y), pk2(y[1].z, y[1].w)}; } };
            const int lr0 = 4 * F.wave;
            load(ra, lr0);
            load(rb, lr0 + 1);
            {
                const float* mr = MOD + (size_t)((tile * 32) / SEQ) * (NMOD * D); const int c4 = 4 * F.tid;
                const f32x4 w = *(const GAS f32x4*)(F.in[I_N2W] + c4), a = *(const GAS f32x4*)(mr + 3 * D + c4), c = *(const GAS f32x4*)(mr + 4 * D + c4);
                *(LAS f32x4*)(wcv + c4) = w * (c + 1.0f); *(LAS f32x4*)(shv + c4) = a;
                __syncthreads();
            }
            finish(ra, lr0);
            load(ra, lr0 + 2); finish(rb, lr0 + 1);
            load(rb, lr0 + 3); finish(ra, lr0 + 2);
            finish(rb, lr0 + 3);
        }
        __syncthreads();
        f32x16 acc[2];
#pragma unroll
        for (int j = 0; j < 2; ++j)
#pragma unroll
            for (int r = 0; r < 16; ++r) acc[j][r] = 0.f;
        { f32x16 a0[1] = {acc[0]}, a1[1] = {acc[1]};
          skinny_gemm<1>(F.lds, bfA, a0, F.wave, lane);
          asm volatile("" ::: "memory");
          skinny_bload<1>(bfA, RT + (size_t)32 * 2048, F.wave, lane);
          skinny_gemm<1>(F.lds, bfA, a1, F.wave, lane);
          acc[0] = a0[0]; acc[1] = a1[0]; }
        __syncthreads();
        LAS float* red = (LAS float*)F.lds;
        skinny_store_partial<2>(red, acc, F.wave, lane);
        if (F.tid < 64) hist[F.tid] = 0u;
        __syncthreads();
        for (int o = F.tid; o < 32 * 64; o += 512) { float s = 0.f;
#pragma unroll
            for (int w = 0; w < 8; ++w) s += red[w * 2048 + o];
            lg[o] = s; }
        __syncthreads();
        int loc[4]; int rk[4]; float sw[4];
        const float rb = F.in[I_RB][lane];
#pragma unroll
        for (int rr = 0; rr < 4; ++rr) {
            const int lr = 4 * F.wave + rr;
            const float s = 1.0f / (1.0f + expf(-lg[lr * 64 + lane]));
            const float ch = s + rb;
            float m1 = ch; m1 = fmaxf(m1, __shfl_xor(m1, 1)); m1 = fmaxf(m1, __shfl_xor(m1, 2)); m1 = fmaxf(m1, __shfl_xor(m1, 4));
            const unsigned long long eq = __ballot(ch == m1);
            const int gshift = lane & ~7;
            const int first = __builtin_ctzll((eq >> gshift) & 0xffull) + gshift;
            float m2 = (lane == first) ? -INFINITY : ch; m2 = fmaxf(m2, __shfl_xor(m2, 1)); m2 = fmaxf(m2, __shfl_xor(m2, 2)); m2 = fmaxf(m2, __shfl_xor(m2, 4));
            const float gs = m1 + m2; const int mygrp = lane >> 3;
            int grank = 0;
#pragma unroll
            for (int gg = 0; gg < 8; ++gg) { const float og = __int_as_float(__builtin_amdgcn_readlane(__float_as_int(gs), gg * 8)); grank += (og > gs || (og == gs && gg < mygrp)) ? 1 : 0; }
            const float cm = (grank < TOPKG) ? ch : -INFINITY;
            int erank = 0;
#pragma unroll
            for (int e2 = 0; e2 < 64; ++e2) { const float oc = __int_as_float(__builtin_amdgcn_readlane(__float_as_int(cm), e2)); erank += (oc > cm || (oc == cm && e2 < lane)) ? 1 : 0; }
            const bool sel = erank < TOPK;
            const float ssum = wave_sum(sel ? s : 0.f);
            rk[rr] = sel ? erank : -1;
            sw[rr] = s / ssum * 2.5f;
            loc[rr] = sel ? (int)__hip_atomic_fetch_add(&hist[lane], 1u, __ATOMIC_RELAXED, __HIP_MEMORY_SCOPE_WORKGROUP) : 0;
        }
        __syncthreads();
        if (F.tid < 64) hbase[F.tid] = atomicAdd(&cnt[16 * F.tid], hist[F.tid]);
        __syncthreads();
#pragma unroll
        for (int rr = 0; rr < 4; ++rr) {
            const int row = tile * 32 + 4 * F.wave + rr;
            if (rk[rr] >= 0) {
                const int pos = (int)hbase[lane] + loc[rr];
                list[(size_t)lane * T + pos] = row;
                eidx[row * 8 + rk[rr]] = lane; slot[row * 8 + rk[rr]] = pos; wts[row * 8 + rk[rr]] = sw[rr];
            }
            if (lane == 0) list[(size_t)64 * T + row] = row;
        }
        __syncthreads();
    }
}

DI void p12_combine(Frame& F, volatile LAS int* tbv) {
    const float* MOD = (const float*)(F.ws + WS_MOD);
    const bf16_t* X1 = (const bf16_t*)(F.ws + WS_X1);
    const unsigned char* YB8 = F.ws + WS_YBUF;
    const int* eidx = (const int*)(F.ws + WS_ROUTE + ROUTE_EIDX); const int* slot = (const int*)(F.ws + WS_ROUTE + ROUTE_SLOT); const float* wts = (const float*)(F.ws + WS_ROUTE + ROUTE_WTS);
    const float* fnw = F.in[I_FNW];
    const int lane = F.lane;
    const LAS int* tb = (const LAS int*)tbv;
    f32x4 fw[8];
#pragma unroll
    for (int j = 0; j < 4; ++j) { fw[2 * j] = *(const GAS f32x4*)(fnw + 8 * lane + 512 * j); fw[2 * j + 1] = *(const GAS f32x4*)(fnw + 8 * lane + 512 * j + 4); }
    const int hbsh = tb[MT_HB + 64];
    for (int row = F.bid * 8 + F.wave; row < T; row += F.G * 8) {
        const float* g2 = MOD + (size_t)(row / SEQ) * (NMOD * D) + 5 * D;
        int e = 64, sl = row; float w = 1.f;
        if (lane < 8) { e = eidx[row * 8 + lane]; sl = slot[row * 8 + lane]; w = wts[row * 8 + lane]; }
        const int yrow = tb[MT_HB + e] + sl;
        unsigned ro[9]; float wk[9];
#pragma unroll
        for (int k = 0; k < 9; ++k) { ro[k] = (unsigned)__builtin_amdgcn_readlane(yrow, k); wk[k] = __builtin_bit_cast(float, __builtin_amdgcn_readlane(__builtin_bit_cast(int, w), k)); }
        f32x4 x2[8]; float ss = 0.f;
#pragma unroll
        for (int jp = 0; jp < 2; ++jp) {
            v2u y[2][9]; v4u xw[2]; f32x4 xa[2], xb[2], ga[2], gb[2];
#pragma unroll
            for (int jj = 0; jj < 2; ++jj) {
                const int col = 8 * lane + 512 * (2 * jp + jj);
#pragma unroll
                for (int k = 0; k < 9; ++k) y[jj][k] = __builtin_nontemporal_load((const GAS v2u*)(YB8 + (size_t)ro[k] * D + col));
                xw[jj] = *(const GAS v4u*)(X1 + (size_t)row * D + col);
                ga[jj] = *(const GAS f32x4*)(g2 + col); gb[jj] = *(const GAS f32x4*)(g2 + col + 4);
            }
#pragma unroll
            for (int jj = 0; jj < 2; ++jj) {
                const int j = 2 * jp + jj;
                unpack8(xw[jj], xa[jj], xb[jj]);
                f32x4 a0 = (f32x4){0.f, 0.f, 0.f, 0.f}, a1 = a0;
#pragma unroll
                for (int k = 0; k < 9; ++k) {
                    const f32x2 p0 = __builtin_amdgcn_cvt_pk_f32_fp8(y[jj][k].x, false), p1 = __builtin_amdgcn_cvt_pk_f32_fp8(y[jj][k].x, true);
                    const f32x2 p2 = __builtin_amdgcn_cvt_pk_f32_fp8(y[jj][k].y, false), p3 = __builtin_amdgcn_cvt_pk_f32_fp8(y[jj][k].y, true);
                    a0 += (f32x4){p0.x, p0.y, p1.x, p1.y} * wk[k]; a1 += (f32x4){p2.x, p2.y, p3.x, p3.y} * wk[k]; }
                x2[2 * j] = xa[jj] + ga[jj] * a0; x2[2 * j + 1] = xb[jj] + gb[jj] * a1;
                ss += (x2[2 * j].x * x2[2 * j].x + x2[2 * j].y * x2[2 * j].y) + (x2[2 * j].z * x2[2 * j].z + x2[2 * j].w * x2[2 * j].w);
                ss += (x2[2 * j + 1].x * x2[2 * j + 1].x + x2[2 * j + 1].y * x2[2 * j + 1].y) + (x2[2 * j + 1].z * x2[2 * j + 1].z + x2[2 * j + 1].w * x2[2 * j + 1].w);
            }
            asm volatile("" ::: "memory");
        }
        const float rstd = rsqrtf(wave_sum(ss) * (1.f / D) + EPS);
#pragma unroll
        for (int j = 0; j < 4; ++j) {
            const int col = 8 * lane + 512 * j;
            __builtin_nontemporal_store(x2[2 * j] * rstd * fw[2 * j], (GAS f32x4*)(F.out + (size_t)row * D + col));
            __builtin_nontemporal_store(x2[2 * j + 1] * rstd * fw[2 * j + 1], (GAS f32x4*)(F.out + (size_t)row * D + col + 4));
        }
    }
}

constexpr int NPHASE = 13;
__global__ void __launch_bounds__(512, 2) hyb_fwd(Args args) {
    extern __shared__ __attribute__((aligned(16))) unsigned char lds[];
    Frame F;
    F.lds = (LAS unsigned char*)lds; F.ws = args.ws; F.in = args.in; F.out = args.out;
    F.tid = threadIdx.x; F.lane = F.tid & 63; F.wave = __builtin_amdgcn_readfirstlane(F.tid >> 6); F.G = gridDim.x; F.bid = blockIdx.x;
    volatile LAS unsigned* MISC = (volatile LAS unsigned*)(F.lds + MISC_OFF);
    volatile LAS int* mtb = (volatile LAS int*)(F.lds + MISC_OFF + 256);
    for (int u = F.tid; u < (LDS_BYTES - MISC_OFF) / 4; u += 512) MISC[u] = 0u;
    __syncthreads();
    unsigned char* ws = args.ws;
    unsigned* ctl = (unsigned*)(ws + WS_CTL);
    const int lo = args.ph_lo, hi = args.ph_hi;
    const bool multi = (hi - lo) > 1;
    XcdBarrier bar; bar.bar = ctl + CW_BAR; bar.x = 0; bar.st = nullptr;
    if (multi) bar = xcd_barrier_post(ctl + CW_BAR, MISC + 8);
#ifndef PHMASK
#define PHMASK 0x1fff
#endif
#define IN(k) ((((PHMASK) >> (k)) & 1) && lo <= (k) && (k) < hi)
#define SEAM(k) do { if (IN(k) && IN((k) + 1)) xcd_barrier(bar); } while (0)
#ifndef REPMASK
#define REPMASK 0
#endif
#ifndef REPPART
#define REPPART 3
#endif
#define REP(k) for (int rep_ = 0; rep_ < 1 + (((REPMASK) >> (k)) & 1); ++rep_, (rep_ < 1 + (((REPMASK) >> (k)) & 1) && multi) ? (xcd_barrier(bar), 0) : 0)

    if (IN(0)) REP(0) { p0_prologue(F); }
    SEAM(0);
    if (IN(1)) REP(1) { p1_norm1(F); }
    SEAM(1);
    if (IN(2)) REP(2) {
        if (F.bid & 1) p0_convert(F, 0, NP_EXPERT);
        { G1Order S{(const bf16_t*)(ws + WS_H), (const bf16_t*)(ws + WS_WIN_T), F.G, F.bid}; EpiG1 E{ws};
          pg8::gemm_phase<EpiG1, G1Order, false>(F.lds, D, S, E); }
        { G1Order8 S{ws + WS_H8, ws + WS_WIN8, F.G, F.bid}; EpiG1 E{ws};
          pg8::gemm_phase<EpiG1, G1Order8, false, 1>(F.lds, D, S, E); }
        if (!(F.bid & 1)) p0_convert(F, 0, NP_EXPERT);
    }
    SEAM(2);
    if (IN(3)) REP(3) {
        if (!rep_ || ((REPPART) & 1)) for (int it = F.bid; it < NB * GH * NCH; it += F.G) { const int n = it % NCH, h = (it / NCH) % GH, b = it / (NCH * GH); gla_state_item(F, b, h, n); }
        if (!rep_ || ((REPPART) & 2)) s5_phase<false>(F);
    }
    SEAM(3);
    if (IN(4)) REP(4) { s5_carry(F); gla_carry(F); }
    SEAM(4);
    if (IN(5)) REP(5) {
        if (!rep_ || ((REPPART) & 1)) for (int it = F.bid; it < NB * GH * NCHL; it += F.G) { const int nl = it % NCHL, h = (it / NCHL) % GH, b = it / (NCHL * GH); gla_out_item(F, b, h, nl); }
        if (!rep_ || ((REPPART) & 2)) s5_phase<true>(F);
    }
    SEAM(5);
    if (IN(6)) REP(6) {
        DenseOrder S{(const bf16_t*)(ws + WS_YS), (const bf16_t*)(ws + WS_GLU_T), 32, 4, 1024, F.G, F.bid, true};
        EpiEw<0> E{(bf16_t*)(ws + WS_S5G), (const bf16_t*)(ws + WS_YS), 1024};
        pg8::gemm_phase<EpiEw<0>, DenseOrder, false>(F.lds, 1024, S, E);
    }
    SEAM(6);
    if (IN(7)) REP(7) {
        MergeOrder S{ws + WS_S5G, ws + WS_S5P_T, ws + WS_OG, ws + WS_GLAP_T, F.G, F.bid};
        EpiMerge64 E{(bf16_t*)(ws + WS_M), (const bf16_t*)(ws + WS_GS), (const bf16_t*)(ws + WS_GG), ws + WS_M8};
        pg8::gemm_phase<EpiMerge64, MergeOrder, false, 1, true, true, 0, true>(F.lds, 1024, S, E);
    }
    SEAM(7);
    if (IN(8)) REP(8) {
        DenseOrder8 S{ws + WS_M8, ws + WS_WOUT_T, 32, 8, 2048, F.G, F.bid};
        EpiOut E{F.in[I_X], (const float*)(ws + WS_MOD), (bf16_t*)(ws + WS_X1)};
        pg8::gemm_phase<EpiOut, DenseOrder8, false, 1>(F.lds, 2048, S, E);
    }
    SEAM(8);
    if (IN(9)) REP(9) { p9_route(F); }
    SEAM(9);
    if (IN(10)) REP(10) {
        moe_tables(F, mtb); moe_unit_list<4>(F, mtb);
        MoeOrder<4, 1> S{mtb, ws + WS_T2, ws + WS_WGU_T, (const int*)(ws + WS_ROUTE + ROUTE_LIST), 2048, F.G, F.bid};
        EpiGU E{ws + WS_HID};
        pg8::gemm_phase<EpiGU, MoeOrder<4, 1>, true, 1, true, true, 1024>(F.lds, 2048, S, E);
    }
    SEAM(10);
    if (IN(11)) REP(11) {
        moe_tables(F, mtb); moe_unit_list<8>(F, mtb);
        MoeOrder<8, 1> S{mtb, ws + WS_HID, ws + WS_WD_T, nullptr, 512, F.G, F.bid};
        EpiY8 E{ws + WS_YBUF, 2048};
        pg8::gemm_phase<EpiY8, MoeOrder<8, 1>, false, 1, true, true, 2048, true>(F.lds, 512, S, E);
    }
    SEAM(11);
    if (IN(12)) REP(12) { moe_tables(F, mtb); p12_combine(F, mtb); }
#undef IN
#undef SEAM
}

extern "C" void kernel_launch(void* const* d_in, const int* in_sizes, int n_in, void* d_out, int out_size, void* d_ws, size_t ws_size, hipStream_t stream) {
    static int grid = 0;
    if (grid == 0) {
        if (n_in != NIN || out_size != T * D || ws_size < WS_END) { fprintf(stderr, "kernel_launch: unexpected shapes (n_in %d out %d ws %zu need %zu)\n", n_in, out_size, ws_size, (size_t)WS_END); grid = -1; return; }
        int dev = 0, cus = 0, per_cu = 0;
        if (hipGetDevice(&dev) != hipSuccess || hipDeviceGetAttribute(&cus, hipDeviceAttributeMultiprocessorCount, dev) != hipSuccess) { grid = -1; return; }
        if (hipFuncSetAttribute((const void*)hyb_fwd, hipFuncAttributeMaxDynamicSharedMemorySize, LDS_BYTES) != hipSuccess) { fprintf(stderr, "kernel_launch: hipFuncSetAttribute failed\n"); grid = -1; return; }
        if (hipOccupancyMaxActiveBlocksPerMultiprocessor(&per_cu, (const void*)hyb_fwd, 512, LDS_BYTES) != hipSuccess || per_cu < 1) { fprintf(stderr, "kernel_launch: occupancy query says %d\n", per_cu); }
        (void)hipGetLastError();
        grid = cus & ~15;
    }
    if (grid < 0) return;
    (void)hipMemsetAsync((char*)d_ws + WS_CTL, 0, CTL_ZERO_BYTES, stream);
    Args a{};
    for (int i = 0; i < NIN; ++i) a.in[i] = (const float*)d_in[i];
    a.out = (float*)d_out; a.ws = (unsigned char*)d_ws;
#if MK_N_LAUNCHES == 1
    a.ph_lo = 0; a.ph_hi = NPHASE;
    hipLaunchKernelGGL(hyb_fwd, dim3(grid), dim3(512), LDS_BYTES, stream, a);
#else
    for (int p = 0; p < NPHASE; ++p) { a.ph_lo = p; a.ph_hi = p + 1; hipLaunchKernelGGL(hyb_fwd, dim3(grid), dim3(512), LDS_BYTES, stream, a); }
#endif
}
```

```cpp
#include <hip/hip_runtime.h>
#include <cstdio>
#include <cstdint>

#ifndef MK_N_LAUNCHES
#define MK_N_LAUNCHES 1
#endif

constexpr int D = 2048, NB = 4, SEQ = 2048, CTX = 256;
constexpr int T = NB * SEQ;
constexpr int TC = NB * CTX;
constexpr int TA = T + TC;
constexpr int NMOD = 6;
constexpr int S5W = 1024, S5G_ = 16, S5NG = 64, S5P = 64;
constexpr int GH = 4, GKW = 512, GVW = 1024, GDK = 128, GDV = 256, GRANK = 16, GCH = 64;
constexpr int INW = 8224;
constexpr int NE = 64, TOPK = 8, NGRP = 8, TOPKG = 4, DEXP = 512;
constexpr float EPS = 1e-6f;
constexpr int NCH = (SEQ + CTX) / GCH;
constexpr int NCHC = CTX / GCH;
constexpr int NCHL = SEQ / GCH;
constexpr int HIDROWS = 90112;

constexpr size_t MiB = 1u << 20;
constexpr size_t WS_CTL = 0, CTL_ZERO_BYTES = 65536;
constexpr size_t WS_MOD = 1 * MiB;
constexpr size_t WS_S5TAB = 2 * MiB;
constexpr size_t S5TAB_LAM = 0, S5TAB_LAM64 = 65536, S5TAB_BT = 131072, S5TAB_CT = 131072 + 524288;
constexpr size_t WS_ROUT_T = 4 * MiB;
constexpr size_t WS_ROUTE = 5 * MiB;
constexpr size_t ROUTE_LIST = 0, ROUTE_EIDX = 3 * MiB, ROUTE_SLOT = 3 * MiB + 262144, ROUTE_WTS = 3 * MiB + 524288;
constexpr size_t WS_WGU_T = 9 * MiB;
constexpr size_t WS_WD_T = 269 * MiB;
constexpr size_t WS_X1 = 399 * MiB;
constexpr size_t WS_AB = 463 * MiB;
constexpr size_t WS_WIN_T = WS_AB + 0 * MiB;
constexpr size_t WS_WGKD_T = WS_AB + 32 * MiB;
constexpr size_t WS_GLU_T = WS_AB + 33 * MiB;
constexpr size_t WS_S5P_T = WS_AB + 35 * MiB;
constexpr size_t WS_GLAP_T = WS_AB + 39 * MiB;
constexpr size_t WS_WOUT_T = WS_AB + 43 * MiB;
constexpr size_t WS_H = WS_AB + 51 * MiB;
constexpr size_t WS_GKD = WS_AB + 87 * MiB;
constexpr size_t WS_U = WS_AB + 89 * MiB;
constexpr size_t WS_KK = WS_AB + 107 * MiB;
constexpr size_t WS_V = WS_AB + 116 * MiB;
constexpr size_t WS_Q = WS_AB + 134 * MiB;
constexpr size_t WS_GO = WS_AB + 142 * MiB;
constexpr size_t WS_GS = WS_AB + 158 * MiB;
constexpr size_t WS_GG = WS_AB + 190 * MiB;
constexpr size_t WS_S5ST = WS_AB + 222 * MiB;
constexpr size_t WS_GST = WS_AB + 232 * MiB;
constexpr size_t WS_GDEC = WS_AB + 304 * MiB;
constexpr size_t WS_YS = WS_AB + 305 * MiB;
constexpr size_t WS_OG = WS_AB + 321 * MiB;
constexpr size_t WS_YS8 = WS_AB + 329 * MiB;
constexpr size_t WS_S5G = WS_AB + 337 * MiB;
constexpr size_t WS_M = WS_AB + 353 * MiB;
constexpr size_t WS_M8 = WS_AB + 410 * MiB;
constexpr size_t WS_A_END = WS_AB + 385 * MiB;
constexpr size_t WS_T2 = WS_AB + 0 * MiB;
constexpr size_t WS_HID = WS_AB + 32 * MiB;
constexpr size_t WS_YBUF = WS_AB + 120 * MiB;
constexpr size_t WS_WIN8 = WS_WIN_T + 16 * MiB;
constexpr size_t WS_H8 = WS_AB + 390 * MiB;
constexpr size_t WS_END = WS_AB + 472 * MiB;
static_assert(WS_A_END <= WS_END, "ws map");

constexpr int CW_TMO = 0, CW_CODE = 1;
constexpr int CW_BAR = 4096;
constexpr int CW_CNT = 8192;

constexpr int SCR_BYTES = 155648;
constexpr int MISC_OFF = SCR_BYTES;
constexpr int LDS_BYTES = 163840;

#define GAS __attribute__((address_space(1)))
#define LAS __attribute__((address_space(3)))
typedef unsigned short bf16_t;
typedef unsigned v4u __attribute__((ext_vector_type(4)));
typedef unsigned v2u __attribute__((ext_vector_type(2)));
typedef float f32x2 __attribute__((ext_vector_type(2)));
typedef float f32x4 __attribute__((ext_vector_type(4)));
typedef float f32x16 __attribute__((ext_vector_type(16)));
typedef short bf16x8 __attribute__((ext_vector_type(8)));
typedef GAS unsigned gu32;

#define DI __device__ __forceinline__
#define LDS_WAIT() asm volatile("s_waitcnt lgkmcnt(0)" ::: "memory")
#define LDS_BAR() do { asm volatile("s_waitcnt lgkmcnt(0)" ::: "memory"); __builtin_amdgcn_s_barrier(); asm volatile("" ::: "memory"); } while (0)
#define VM_WAIT() asm volatile("s_waitcnt vmcnt(0)" ::: "memory")
#define RLX_AGENT __ATOMIC_RELAXED, __HIP_MEMORY_SCOPE_AGENT

typedef __bf16 bf16x2_hw __attribute__((ext_vector_type(2)));
DI unsigned pk2(float lo, float hi) { const f32x2 v = {lo, hi}; return __builtin_bit_cast(unsigned, __builtin_convertvector(v, bf16x2_hw)); }
DI unsigned f2bf(float f) { return pk2(f, 0.f) & 0xffffu; }
DI float bflo(unsigned w) { return __builtin_bit_cast(float, w << 16); }
DI float bfhi(unsigned w) { return __builtin_bit_cast(float, w & 0xffff0000u); }
DI float bf2f(bf16_t b) { return __builtin_bit_cast(float, ((unsigned)b) << 16); }
DI float sigmoidf_(float x) { return __builtin_amdgcn_rcpf(1.0f + __expf(-x)); }
DI float siluf_(float x) { return x * sigmoidf_(x); }
DI float wave_sum(float v) {
#pragma unroll
    for (int o = 1; o < 64; o <<= 1) v += __shfl_xor(v, o);
    return v;
}
DI int crow32(int r, int hi) { return (r & 3) + 8 * (r >> 2) + 4 * hi; }
#define MFMA32(a, b, c) __builtin_amdgcn_mfma_f32_32x32x16_bf16((a), (b), (c), 0, 0, 0)
#define MFMA16(a, b, c) __builtin_amdgcn_mfma_f32_16x16x32_bf16((a), (b), (c), 0, 0, 0)

namespace pg8 {
constexpr int BM = 256, BK = 64, HALF = 128, HTB = HALF * BK * 2, STAGE_BYTES = 8 * HTB;
DI int lds_byte(int r, int c) { const int st = (r >> 4) * 2 + (c >> 5), rr = r & 15, cc = c & 31, ob = rr * 64 + cc * 2; return st * 1024 + (ob ^ (((ob >> 9) & 1) << 5)); }
DI void stage_rc(int b, int& R, int& C) { const int st = b / 1024, sb = b % 1024, swz = sb ^ (((sb >> 9) & 1) << 5); R = (st >> 1) * 16 + swz / 64; C = (st & 1) * 32 + (swz % 64) / 2; }
DI int perm32(int rho) { const int n = rho >> 4, i = rho & 15; return 8 * (i >> 2) + 4 * n + (i & 3); }
DI unsigned cvt_pk_bf16(float lo, float hi) { unsigned r; asm volatile("v_cvt_pk_bf16_f32 %0, %1, %2" : "=v"(r) : "v"(lo), "v"(hi)); return r; }

typedef short v8i __attribute__((ext_vector_type(16)));
DI v8i ld32(const LAS unsigned char* p) { const bf16x8 lo = *(const LAS bf16x8*)p, hi = *(const LAS bf16x8*)(p + 16); return __builtin_shufflevector(lo, hi, 0, 1, 2, 3, 4, 5, 6, 7, 8, 9, 10, 11, 12, 13, 14, 15); }
constexpr int FP8_WSHIFT = 5;
constexpr int FP8_SCALE_W = 0x01010101 * (127 - FP8_WSHIFT);
constexpr int FP8_SCALE_A = 0x7f7f7f7f;
struct Unit {
    const char* a;
    const char* b;
    const int* idx;
    int nvalid;
    int pm, pn, e;
    int cb;
    int flags;
};

template <class Epi, class Sched, bool GATHER, int ES = 2, bool ALIGN_EPI = true, bool SP2 = true, int BKT = 0, bool P64 = false>
DI void gemm_phase(LAS unsigned char* lds, const int K, const Sched& S, const Epi& E) {
    const int tid = threadIdx.x, wid = __builtin_amdgcn_readfirstlane(tid >> 6), lane = tid & 63, wr = wid >> 2, wc = wid & 3, fr = lane & 15, fq = lane >> 4;
    const int nt = (K * ES) / 128;
    int Rr[2], Cc[2];
    unsigned voffB[2], vc[2][2], vn[2][2];
#pragma unroll
    for (int i = 0; i < 2; ++i) { int R, C; stage_rc(tid * 16 + i * 8192, R, C); const int Rb = P64 ? (2 * (R & ~31) + perm32(R & 31)) : (Epi::PERM ? ((R & ~31) + perm32(R & 31)) : R);
        Rr[i] = R; Cc[i] = C; voffB[i] = BKT ? ((unsigned)Rb * 128u + (unsigned)C * 2u) : ((unsigned)(Rb * K) * (unsigned)ES + (unsigned)C * 2u);
#pragma unroll
        for (int h = 0; h < 2; ++h) { vc[h][i] = (unsigned)((h * HALF + R) * K) * (unsigned)ES + (unsigned)C * 2u; vn[h][i] = vc[h][i]; } }
    const size_t kstep = (size_t)(BK * 2);
    const size_t hstep = (size_t)HALF * K * ES;
    const size_t kstepB = BKT ? (size_t)BKT * 128 : kstep, hstepB = (size_t)(P64 ? 32 : HALF) * (BKT ? (size_t)128 : (size_t)K * ES);
    const unsigned ldsw = (unsigned)wid * 1024u;
    const int aoff = lds_byte(wr * 64 + fr, (ES == 2 ? 8 : 16) * fq), boff = lds_byte(wc * 32 + fr, (ES == 2 ? 8 : 16) * fq);
#define PG8_SA(b, h) (((b) * 2 + (h)) * HTB)
#define PG8_SB(b, h) ((4 + (b) * 2 + (h)) * HTB)
#define PG8_STAGE_B(bufoff, gbase) do { _Pragma("unroll") for (int _i = 0; _i < 2; ++_i) \
        __builtin_amdgcn_global_load_lds((const unsigned*)((const char*)(gbase) + voffB[_i]), (LAS unsigned*)(lds + (bufoff) + ldsw + _i * 8192), 16, 0, 0); } while (0)
#define PG8_STAGE_A(bufoff, gbase, h, usen) do { _Pragma("unroll") for (int _i = 0; _i < 2; ++_i) \
        __builtin_amdgcn_global_load_lds((const unsigned*)((const char*)(gbase) + ((usen) ? vn[h][_i] : vc[h][_i])), (LAS unsigned*)(lds + (bufoff) + ldsw + _i * 8192), 16, 0, 0); } while (0)
#define PG8_LDA(dst, b, h) do { if constexpr (ES == 2) { _Pragma("unroll") for (int m = 0; m < 4; ++m) _Pragma("unroll") for (int k = 0; k < 2; ++k) dst[m][k] = *(const LAS bf16x8*)(lds + PG8_SA(b, h) + aoff + m * 2048 + k * 1024); } \
        else { _Pragma("unroll") for (int m = 0; m < 4; ++m) dst##8[m] = ld32(lds + PG8_SA(b, h) + aoff + m * 2048); } } while (0)
#define PG8_LDB(dst, b, h) do { if constexpr (ES == 2) { _Pragma("unroll") for (int n = 0; n < 2; ++n) _Pragma("unroll") for (int k = 0; k < 2; ++k) dst[n][k] = *(const LAS bf16x8*)(lds + PG8_SB(b, h) + boff + n * 2048 + k * 1024); } \
        else { _Pragma("unroll") for (int n = 0; n < 2; ++n) dst##8[n] = ld32(lds + PG8_SB(b, h) + boff + n * 2048); } } while (0)
#define PG8_MMA(ai, bj, At, Bt) do { __builtin_amdgcn_s_setprio(1); _Pragma("unroll") for (int m = 0; m < 4; ++m) _Pragma("unroll") for (int n = 0; n < 2; ++n) { \
        if constexpr (ES == 2) { _Pragma("unroll") for (int k = 0; k < 2; ++k) acc[ai][bj][m][n] = __builtin_amdgcn_mfma_f32_16x16x32_bf16(Bt[n][k], At[m][k], acc[ai][bj][m][n], 0, 0, 0); } \
        else { asm volatile("v_mfma_scale_f32_16x16x128_f8f6f4 %0, %1, %2, %0, %3, %4 op_sel_hi:[0,0,0]" : "+v"(acc[ai][bj][m][n]) : "v"(Bt##8[n]), "v"(At##8[m]), "v"(sc_w), "v"(sc_a)); } } \
        __builtin_amdgcn_s_setprio(0); } while (0)
#define PG8_WAIT_V(n) asm volatile("s_waitcnt vmcnt(" #n ")" ::: "memory")
#define PG8_WAIT_L(n) asm volatile("s_waitcnt lgkmcnt(" #n ")" ::: "memory")
#define PG8_BAR __builtin_amdgcn_s_barrier()
#define PG8_SCHED __builtin_amdgcn_sched_barrier(0)
    Unit cur, nxt; int ui = 0;
    if (!S.next(0, cur)) return;
    f32x4 acc[2][2][4][2];
#pragma unroll
    for (int a = 0; a < 2; ++a)
#pragma unroll
        for (int b = 0; b < 2; ++b)
#pragma unroll
            for (int m = 0; m < 4; ++m)
#pragma unroll
                for (int n = 0; n < 2; ++n) acc[a][b][m][n] = (f32x4){0.f, 0.f, 0.f, 0.f};
    bf16x8 At[4][2], B0[2][2], B1[2][2];
    v8i At8[4], B08[2], B18[2];
    int sc_w = FP8_SCALE_W, sc_a = FP8_SCALE_A;
    asm volatile("" : "+v"(sc_w), "+v"(sc_a));
    const char* cA = cur.a; const char* cB = cur.b;
    if constexpr (GATHER) {
#pragma unroll
        for (int h = 0; h < 2; ++h)
#pragma unroll
            for (int i = 0; i < 2; ++i) { const int r = h * HALF + Rr[i]; const int row = (r < cur.nvalid) ? cur.idx[r] : 0; vc[h][i] = (unsigned)(row * K) * (unsigned)ES + (unsigned)Cc[i] * 2u; }
    }
    if constexpr (SP2) {
        PG8_STAGE_B(PG8_SB(0, 0), cB); PG8_STAGE_B(PG8_SB(0, 1), cB + hstepB); PG8_STAGE_A(PG8_SA(0, 0), cA, 0, false); PG8_STAGE_A(PG8_SA(0, 1), cA, 1, false);
        if (wr == 1) PG8_BAR;
        PG8_WAIT_V(2); PG8_BAR;
        PG8_STAGE_B(PG8_SB(1, 0), cB + kstepB); PG8_STAGE_A(PG8_SA(1, 0), cA + kstep, 0, false); PG8_STAGE_B(PG8_SB(1, 1), cB + hstepB + kstepB);
        PG8_WAIT_V(6); PG8_BAR;
    } else {
        PG8_STAGE_B(PG8_SB(0, 0), cB); PG8_STAGE_A(PG8_SA(0, 0), cA, 0, false); PG8_STAGE_B(PG8_SB(0, 1), cB + hstepB); PG8_STAGE_A(PG8_SA(0, 1), cA, 1, false);
        if (wr == 1) PG8_BAR;
        PG8_WAIT_V(4); PG8_BAR;
        PG8_STAGE_B(PG8_SB(1, 0), cB + kstepB); PG8_STAGE_A(PG8_SA(1, 0), cA + kstep, 0, false); PG8_STAGE_B(PG8_SB(1, 1), cB + hstepB + kstepB);
        PG8_WAIT_V(6); PG8_BAR;
    }
    for (;;) {
        const bool has_next = S.next(ui + 1, nxt);
        const int fl = cur.flags;
        const char* nA = has_next ? nxt.a : cA; const char* nB = has_next ? nxt.b : cB;
        if constexpr (GATHER) {
            if (has_next) { if (wid == 0) __builtin_amdgcn_global_load_lds((const unsigned*)(nxt.idx + 4 * lane), (LAS unsigned*)(lds + STAGE_BYTES + ((ui + 1) & 1) * 1024), 16, 0, 0); }
            else {
#pragma unroll
                for (int h = 0; h < 2; ++h)
#pragma unroll
                    for (int i = 0; i < 2; ++i) vn[h][i] = vc[h][i];
            }
        }
        for (int t = 0; t < nt; t += 2) {
            const bool last = (t == nt - 2);
            const char* a1 = cA + (size_t)(t + 1) * kstep;
            const char* a2 = last ? nA : cA + (size_t)(t + 2) * kstep; const char* b2 = last ? nB : cB + (size_t)(t + 2) * kstepB;
            const char* a3 = a2 + kstep; const char* b3 = b2 + kstepB;
            const bool un = GATHER && last;
            if constexpr (GATHER) { if (last && has_next) {
                const LAS int* ib = (const LAS int*)(lds + STAGE_BYTES + ((ui + 1) & 1) * 1024);
#pragma unroll
                for (int h = 0; h < 2; ++h)
#pragma unroll
                    for (int i = 0; i < 2; ++i) { const int r = h * HALF + Rr[i]; const int row = (r < nxt.nvalid) ? ib[r] : 0; vn[h][i] = (unsigned)(row * K) * (unsigned)ES + (unsigned)Cc[i] * 2u; } } }
            if constexpr (SP2) {
            PG8_LDB(B0, 0, 0); PG8_LDB(B1, 0, 1); PG8_SCHED; PG8_LDA(At, 0, 0); PG8_STAGE_A(PG8_SA(1, 1), a1, 1, false);
            PG8_WAIT_V(8); PG8_WAIT_L(0); PG8_BAR; PG8_MMA(0, 0, At, B0); if (!(fl & 2)) PG8_MMA(0, 1, At, B1); PG8_BAR; PG8_SCHED;
            PG8_LDA(At, 0, 1); PG8_STAGE_B(PG8_SB(0, 0), b2); PG8_STAGE_B(PG8_SB(0, 1), b2 + hstepB); PG8_STAGE_A(PG8_SA(0, 0), a2, 0, un);
            PG8_WAIT_V(8); PG8_WAIT_L(0); PG8_BAR; if (!(fl & 1)) { PG8_MMA(1, 0, At, B0); if (!(fl & 2)) PG8_MMA(1, 1, At, B1); } PG8_BAR; PG8_SCHED;
            PG8_LDB(B0, 1, 0); PG8_LDB(B1, 1, 1); PG8_SCHED; PG8_LDA(At, 1, 0); PG8_STAGE_A(PG8_SA(0, 1), a2, 1, un);
            PG8_WAIT_V(8); PG8_WAIT_L(0); PG8_BAR; PG8_MMA(0, 0, At, B0); if (!(fl & 2)) PG8_MMA(0, 1, At, B1); PG8_BAR; PG8_SCHED;
            PG8_LDA(At, 1, 1); PG8_STAGE_B(PG8_SB(1, 0), b3); PG8_STAGE_B(PG8_SB(1, 1), b3 + hstepB); PG8_STAGE_A(PG8_SA(1, 0), a3, 0, un);
            PG8_WAIT_V(8); PG8_WAIT_L(0); PG8_BAR; if (!(fl & 1)) { PG8_MMA(1, 0, At, B0); if (!(fl & 2)) PG8_MMA(1, 1, At, B1); } PG8_BAR; PG8_SCHED;
            } else {
            PG8_LDB(B0, 0, 0); PG8_SCHED; PG8_LDA(At, 0, 0); PG8_STAGE_A(PG8_SA(1, 1), a1, 1, false);
            PG8_WAIT_L(8); PG8_BAR; PG8_WAIT_L(0); PG8_MMA(0, 0, At, B0); PG8_BAR; PG8_SCHED;
            PG8_LDB(B1, 0, 1); PG8_STAGE_B(PG8_SB(0, 0), b2);
            PG8_BAR; PG8_WAIT_L(0); PG8_MMA(0, 1, At, B1); PG8_BAR;
            PG8_LDA(At, 0, 1); PG8_STAGE_A(PG8_SA(0, 0), a2, 0, un);
            PG8_BAR; PG8_WAIT_L(0); PG8_MMA(1, 0, At, B0); PG8_BAR; PG8_SCHED;
            PG8_STAGE_B(PG8_SB(0, 1), b2 + hstepB);
            PG8_WAIT_V(6); PG8_BAR; PG8_MMA(1, 1, At, B1); PG8_BAR;
            PG8_LDB(B0, 1, 0); PG8_SCHED; PG8_LDA(At, 1, 0); PG8_STAGE_A(PG8_SA(0, 1), a2, 1, un);
            PG8_WAIT_L(8); PG8_BAR; PG8_WAIT_L(0); PG8_MMA(0, 0, At, B0); PG8_BAR; PG8_SCHED;
            PG8_LDB(B1, 1, 1); PG8_STAGE_B(PG8_SB(1, 0), b3);
            PG8_BAR; PG8_WAIT_L(0); PG8_MMA(0, 1, At, B1); PG8_BAR;
            PG8_LDA(At, 1, 1); PG8_STAGE_A(PG8_SA(1, 0), a3, 0, un);
            PG8_BAR; PG8_WAIT_L(0); PG8_MMA(1, 0, At, B0); PG8_BAR; PG8_SCHED;
            PG8_STAGE_B(PG8_SB(1, 1), b3 + hstepB);
            PG8_WAIT_V(6); PG8_BAR; PG8_MMA(1, 1, At, B1); PG8_BAR;
            }
        }
        if constexpr (ALIGN_EPI) { if (wr == 0) PG8_BAR; }
        if constexpr (ES == 1) asm volatile("s_nop 15\n\ts_nop 15" ::: "memory");
        E(acc, cur, wr, wc, fr, fq);
        if (!has_next) break;
#pragma unroll
        for (int a = 0; a < 2; ++a)
#pragma unroll
            for (int b = 0; b < 2; ++b)
#pragma unroll
                for (int m = 0; m < 4; ++m)
#pragma unroll
                    for (int n = 0; n < 2; ++n) acc[a][b][m][n] = (f32x4){0.f, 0.f, 0.f, 0.f};
        cur = nxt; cA = nA; cB = nB; ++ui;
        if constexpr (GATHER) {
#pragma unroll
            for (int h = 0; h < 2; ++h)
#pragma unroll
                for (int i = 0; i < 2; ++i) vc[h][i] = vn[h][i];
        }
        if constexpr (ALIGN_EPI) { if (wr == 1) PG8_BAR; }
    }
    PG8_WAIT_V(0);
    if constexpr (!ALIGN_EPI) { if (wr == 0) PG8_BAR; }
    PG8_BAR;
#undef PG8_SA
#undef PG8_SB
#undef PG8_STAGE_A
#undef PG8_STAGE_B
#undef PG8_LDA
#undef PG8_LDB
#undef PG8_MMA
#undef PG8_WAIT_V
#undef PG8_WAIT_L
#undef PG8_BAR
#undef PG8_SCHED
}
}

#define XB_TMO      128
#define XB_XCNT(j)  (256  + 64 * (j))
#define XB_XSUB(j)  (1280 + 64 * (j))
#define XB_XGEN(j)  (2304 + 64 * (j))
#define XB_TOP      3328
#define XB_TOPGEN   3392
#define XCD_BAR_WORDS 3456
#define XB_SPIN_CAP (1u << 18)
DI unsigned xb_ld(unsigned* p)              { return __hip_atomic_load(p, __ATOMIC_RELAXED, __HIP_MEMORY_SCOPE_AGENT); }
DI unsigned xb_add(unsigned* p, unsigned v) { return __hip_atomic_fetch_add(p, v, __ATOMIC_RELAXED, __HIP_MEMORY_SCOPE_AGENT); }
DI unsigned xb_xcc_id() { return (unsigned)__builtin_amdgcn_s_getreg((3 << 11) | 20) & 0xFu; }
#define XB_SPIN(cond, bar) do { unsigned _sp = 0; while (cond) { __builtin_amdgcn_s_sleep(1); \
    if ((++_sp & 255u) == 0u) { if (xb_ld(&(bar)[XB_TMO])) break; if (_sp > XB_SPIN_CAP) { atomicAdd(&(bar)[XB_TMO], 1u); break; } } } } while (0)
struct XcdBarrier { unsigned* bar; unsigned x; volatile LAS unsigned* st; };
DI XcdBarrier xcd_barrier_post(unsigned* bar, volatile LAS unsigned* st) {
    XcdBarrier b; b.bar = bar; b.x = xb_xcc_id(); b.st = st;
    if (threadIdx.x == 0) (void)xb_add(&bar[XB_XCNT(b.x)], 1u);
    return b;
}
DI void xcd_barrier_complete(unsigned* bar, unsigned x, unsigned& nloc, unsigned& nx) {
    const unsigned G = gridDim.x * gridDim.y * gridDim.z;
    unsigned sum, cnt, mine, sp = 0u;
    for (;;) {
        sum = 0u; cnt = 0u; mine = 0u;
#pragma unroll
        for (unsigned j = 0; j < 16; ++j) { const unsigned c = xb_ld(&bar[XB_XCNT(j)]); sum += c; cnt += (c > 0u) ? 1u : 0u; mine = (j == x) ? c : mine; }
        if (sum == G) break;
        __builtin_amdgcn_s_sleep(1);
        if ((++sp & 255u) == 0u) { if (xb_ld(&bar[XB_TMO])) break; if (sp > XB_SPIN_CAP) { atomicAdd(&bar[XB_TMO], 1u); break; } }
    }
    nloc = mine > 0u ? mine : 1u; nx = cnt > 0u ? cnt : 1u;
}
DI void xcd_barrier(const XcdBarrier& b) {
    asm volatile("s_waitcnt vmcnt(0)" ::: "memory");
    __syncthreads();
    if (threadIdx.x == 0) {
        unsigned* bar = b.bar;
        __builtin_amdgcn_s_waitcnt(0);
        unsigned nloc = b.st[0], nx = b.st[1];
        if (nloc == 0u) { xcd_barrier_complete(bar, b.x, nloc, nx); b.st[0] = nloc; b.st[1] = nx; }
        const unsigned old = xb_add(&bar[XB_XSUB(b.x)], 1u);
        const unsigned gen = old / nloc;
        if (old + 1u == (gen + 1u) * nloc) {
            __builtin_amdgcn_fence(__ATOMIC_RELEASE, "agent");
            asm volatile("s_waitcnt vmcnt(0)" ::: "memory");
            const unsigned og = xb_add(&bar[XB_TOP], 1u);
            const unsigned tg = og / nx;
            if (og + 1u == (tg + 1u) * nx) xb_add(&bar[XB_TOPGEN], 1u);
            else XB_SPIN(xb_ld(&bar[XB_TOPGEN]) == tg, bar);
            __builtin_amdgcn_fence(__ATOMIC_ACQUIRE, "agent");
            xb_add(&bar[XB_XGEN(b.x)], 1u);
            asm volatile("s_waitcnt vmcnt(0)" ::: "memory");
        } else {
            XB_SPIN(xb_ld(&bar[XB_XGEN(b.x)]) == gen, bar);
            __builtin_amdgcn_fence(__ATOMIC_ACQUIRE, "agent");
            asm volatile("s_waitcnt vmcnt(0)" ::: "memory");
        }
    }
    __syncthreads();
}

constexpr int NIN = 33;
struct Args { const float* in[NIN]; float* out; unsigned char* ws; int ph_lo, ph_hi; };
struct Frame {
    LAS unsigned char* lds;
    unsigned char* ws;
    const float* const* in;
    float* out;
    int tid, lane, wave, G, bid;
};
enum InIdx { I_X = 0, I_C, I_CTX, I_CCTX, I_ADAW, I_ADAB, I_N1W, I_N2W, I_WIN, I_LAMRE, I_LAMIM, I_LOGDT, I_BRE, I_BIM, I_CRE, I_CIM, I_S5D, I_GLUW, I_GKUP, I_GKB, I_GNW,
             I_WS5P, I_WGLAP, I_WOUT, I_RW, I_RB, I_EWG, I_EWU, I_EWD, I_SWG, I_SWU, I_SWD, I_FNW };

struct TrItem { const float* src; bf16_t* dst; int ldw, ldt; int fp8; };
DI void tr_load(const TrItem& it, f32x4 (&v)[8], int lane) {
    const int kk = lane >> 3, n4 = lane & 7;
    const float* src = it.src + (size_t)kk * it.ldw + 4 * n4;
#pragma unroll
    for (int i = 0; i < 8; ++i) v[i] = *(const GAS f32x4*)(src + (size_t)(8 * i) * it.ldw);
}
DI void tr_finish(const TrItem& it, const f32x4 (&v)[8], LAS float* scr, int lane) {
    const int kk = lane >> 3, n4 = lane & 7;
#pragma unroll
    for (int i = 0; i < 8; ++i) { LAS float* d = scr + (8 * i + kk) * 33 + 4 * n4; d[0] = v[i].x; d[1] = v[i].y; d[2] = v[i].z; d[3] = v[i].w; }
    LDS_WAIT(); asm volatile("" ::: "memory");
    const int c = lane & 7;
    if (it.fp8) {
        unsigned char* dst8 = (unsigned char*)it.dst; const float sc = (float)(1 << pg8::FP8_WSHIFT);
#pragma unroll
        for (int j = 0; j < 4; ++j) { const int n = (lane >> 3) + 8 * j; const LAS float* s = scr + (8 * c) * 33 + n;
            unsigned w0 = 0, w1 = 0;
            w0 = __builtin_amdgcn_cvt_pk_fp8_f32(s[0 * 33] * sc, s[1 * 33] * sc, w0, false); w0 = __builtin_amdgcn_cvt_pk_fp8_f32(s[2 * 33] * sc, s[3 * 33] * sc, w0, true);
            w1 = __builtin_amdgcn_cvt_pk_fp8_f32(s[4 * 33] * sc, s[5 * 33] * sc, w1, false); w1 = __builtin_amdgcn_cvt_pk_fp8_f32(s[6 * 33] * sc, s[7 * 33] * sc, w1, true);
            *(GAS v2u*)(dst8 + (size_t)n * it.ldt + 8 * c) = (v2u){w0, w1}; }
    } else {
#pragma unroll
        for (int j = 0; j < 4; ++j) { const int n = (lane >> 3) + 8 * j; const LAS float* s = scr + (8 * c) * 33 + n;
            v4u o; o.x = pk2(s[0 * 33], s[1 * 33]); o.y = pk2(s[2 * 33], s[3 * 33]); o.z = pk2(s[4 * 33], s[5 * 33]); o.w = pk2(s[6 * 33], s[7 * 33]);
            *(GAS v4u*)(it.dst + (size_t)n * it.ldt + 8 * c) = o; }
    }
    LDS_WAIT(); asm volatile("" ::: "memory");
}
DI TrItem tr_make(const float* W, int ldw, int k0, int col0, bf16_t* WT, int ldt, int row0) { TrItem t; t.src = W + (size_t)k0 * ldw + col0; t.dst = WT + (size_t)row0 * ldt + k0; t.ldw = ldw; t.ldt = ldt; t.fp8 = 0; return t; }
DI TrItem tr_dense(const float* W, int ldw, int col0, int ncols, bf16_t* WT, int ldt, int row0, int it) {
    const int nblk = ncols / 32, kb = it / nblk, nb = it % nblk;
    return tr_make(W, ldw, 64 * kb, col0 + 32 * nb, WT, ldt, row0 + 32 * nb);
}
constexpr int NP_EXPERT = 65 * 2 * 32 + 65 * 32, NP_CONV_ALL = NP_EXPERT + 16 * 32 + (16 * 4 + 16 * 8 + 16 * 8 + 32 * 8) / 2;
DI void p0_convert(Frame& F, const int qbeg, const int qend) {
    const float* const* in = F.in;
    {
        __syncthreads();
        LAS float* img = (LAS float*)F.lds;
        LAS unsigned char* obuf = F.lds + 66560;
        int tid = F.tid; asm volatile("" : "+v"(tid));
        constexpr int NP_GU = 65 * 2 * 32, NP_DN = 65 * 32, NP_WIN = 16 * 32, NT_GLU = 16 * 4, NT_S5P = 16 * 8, NT_GLAP = 16 * 8, NT_WOUT = 32 * 8;
        constexpr int NP_ALL = NP_GU + NP_DN + NP_WIN + (NT_GLU + NT_S5P + NT_GLAP + NT_WOUT) / 2;
        static_assert(NP_GU + NP_DN == NP_EXPERT && NP_ALL == NP_CONV_ALL, "item counts");
        struct Tile { const float* src; unsigned char* dst; int ldw, ldt, fp8, gu; };
        auto make = [&](int q, const int half) -> Tile {
            Tile t; t.fp8 = 1; t.gu = 0; t.ldt = 128;
            if (q < NP_GU) {
                const int blk = q >> 5, ii = q & 31, e = blk >> 1, gu = blk & 1, kt = ii >> 1, nb = ii & 1, kb = 2 * kt + half;
                const float* W = (e < 64) ? ((gu ? in[I_EWU] : in[I_EWG]) + (size_t)e * 2048 * 512) : (gu ? in[I_SWU] : in[I_SWG]);
                t.src = W + (size_t)(64 * kb) * 512 + 256 * nb; t.ldw = 512; t.gu = 1;
                t.dst = F.ws + WS_WGU_T + (size_t)e * 1024 * 2048 + (size_t)kt * (1024 * 128) + (size_t)(512 * nb + 128 * gu) * 128; return t; }
            q -= NP_GU;
            if (q < NP_DN) { const int e = q >> 5, ii = q & 31, kt = ii >> 3, nb = ii & 7, kb = 2 * kt + half;
                const float* W = (e < 64) ? (in[I_EWD] + (size_t)e * 512 * 2048) : in[I_SWD];
                t.src = W + (size_t)(64 * kb) * 2048 + 256 * nb; t.ldw = 2048;
                t.dst = F.ws + WS_WD_T + (size_t)e * 2048 * 512 + (size_t)kt * (2048 * 128) + (size_t)(256 * nb) * 128; return t; }
            q -= NP_DN;
            if (q < NP_WIN) { const int kbp = q >> 5, nb = q & 31, drow = 256 * nb, kb = 2 * kbp + half; int scol;
                if (drow < 1024) scol = drow; else if (drow < 1536) scol = 1536 + (drow - 1024); else if (drow < 2560) scol = 2048 + (drow - 1536); else if (drow < 3072) scol = 1024 + (drow - 2560);
                else if (drow < 4096) scol = 3072 + (drow - 3072); else if (drow < 6144) scol = 4128 + (drow - 4096); else scol = 6176 + (drow - 6144);
                t.src = in[I_WIN] + (size_t)(64 * kb) * INW + scol; t.ldw = INW;
                if (nb == 4 || nb == 5 || nb == 10 || nb == 11) { t.fp8 = 0; t.ldt = 2048 * 2; t.dst = F.ws + WS_WIN_T + ((size_t)drow * 2048 + 64 * kb) * 2; }
                else { t.ldt = 2048; t.dst = F.ws + WS_WIN8 + (size_t)drow * 2048 + 128 * kbp; }
                return t; }
            q -= NP_WIN;
            if (q < NT_WOUT / 2) { const int kbp = q >> 3, nb = q & 7, kb = 2 * kbp + half;
                t.src = in[I_WOUT] + (size_t)(64 * kb) * 2048 + 256 * nb; t.ldw = 2048; t.ldt = 2048; t.dst = F.ws + WS_WOUT_T + (size_t)(256 * nb) * 2048 + 128 * kbp; return t; }
            q -= NT_WOUT / 2;
            if (q < NT_S5P / 2 + NT_GLAP / 2) { const int which = q >= NT_S5P / 2, qq = which ? q - NT_S5P / 2 : q, kbp = qq >> 3, nb = qq & 7, kb = 2 * kbp + half;
                t.src = (which ? in[I_WGLAP] : in[I_WS5P]) + (size_t)(64 * kb) * 2048 + 256 * nb; t.ldw = 2048; t.ldt = 1024; t.dst = F.ws + (which ? WS_GLAP_T : WS_S5P_T) + (size_t)(256 * nb) * 1024 + 128 * kbp; return t; }
            q -= NT_S5P / 2 + NT_GLAP / 2;
            { const int kbp = q >> 2, nb = q & 3, kb = 2 * kbp + half;
              t.src = in[I_GLUW] + (size_t)(64 * kb) * 1024 + 256 * nb; t.ldw = 1024; t.ldt = 1024; t.dst = F.ws + WS_GLU_T + (size_t)(256 * nb) * 1024 + 128 * kbp; return t; }
            return t;
        };
        f32x4 va[8], vb[8]; Tile ta, tb;
        auto issue = [&](f32x4 (&v)[8], const Tile& t) {
            const float* p_ = t.src + (size_t)(tid >> 6) * t.ldw + 4 * (tid & 63);
#pragma unroll
            for (int i = 0; i < 8; ++i) v[i] = __builtin_nontemporal_load((const GAS f32x4*)(p_ + (size_t)(8 * i) * t.ldw));
        };
#define CV_WAIT(v, n) do { } while (0)
        auto stage = [&](const f32x4 (&v)[8]) {
#pragma unroll
            for (int i = 0; i < 8; ++i) *(LAS f32x4*)(img + (8 * i + (tid >> 6)) * 260 + 4 * (tid & 63)) = v[i];
        };
        auto convert = [&](const Tile& cur, const int half) {
            const int n = tid & 255, kh = tid >> 8;
            const LAS float* sp = img + (32 * kh) * 260 + n;
            LAS unsigned char* orow = obuf + n * 128; const int sw = n & 7;
            if (cur.fp8) {
                const float sc = (float)(1 << pg8::FP8_WSHIFT);
                unsigned w[8];
#pragma unroll
                for (int q = 0; q < 8; ++q) { unsigned x = 0;
                    x = __builtin_amdgcn_cvt_pk_fp8_f32(sp[(4 * q) * 260] * sc, sp[(4 * q + 1) * 260] * sc, x, false);
                    x = __builtin_amdgcn_cvt_pk_fp8_f32(sp[(4 * q + 2) * 260] * sc, sp[(4 * q + 3) * 260] * sc, x, true); w[q] = x; }
                const int c0 = 4 * half + 2 * kh;
                *(LAS v4u*)(orow + (((c0) ^ sw) << 4)) = (v4u){w[0], w[1], w[2], w[3]}; *(LAS v4u*)(orow + (((c0 + 1) ^ sw) << 4)) = (v4u){w[4], w[5], w[6], w[7]};
            } else {
                unsigned w[16];
#pragma unroll
                for (int q = 0; q < 16; ++q) w[q] = pk2(sp[(2 * q) * 260], sp[(2 * q + 1) * 260]);
#pragma unroll
                for (int q4 = 0; q4 < 4; ++q4) *(LAS v4u*)(orow + (((4 * kh + q4) ^ sw) << 4)) = (v4u){w[4 * q4], w[4 * q4 + 1], w[4 * q4 + 2], w[4 * q4 + 3]};
            }
        };
        auto flush = [&](const Tile& cur) {
#pragma unroll
            for (int i = 0; i < 4; ++i) { const int p = i * 512 + tid, n = p >> 3, c = p & 7;
                const v4u x = *(const LAS v4u*)(obuf + n * 128 + ((c ^ (n & 7)) << 4));
                const int drow = cur.gu ? (256 * (n >> 7) + (n & 127)) : n;
                *(GAS v4u*)(cur.dst + (size_t)drow * cur.ldt + 16 * c) = x; }
        };
        int q = qbeg + F.bid;
        if (q < qend) { ta = make(q, 0); issue(va, ta); tb = make(q, 1); issue(vb, tb); CV_WAIT(va, 8); }
        while (q < qend) {
            const bool hn = q + F.G < qend;
            CV_WAIT(va, 12);
            stage(va);
            LDS_BAR();
            const Tile ca = ta;
            if (hn) { ta = make(q + F.G, 0); issue(va, ta); }
            convert(ca, 0);
            LDS_BAR();
            if (!ca.fp8) flush(ca);
            if (hn) CV_WAIT(vb, 8); else CV_WAIT(vb, 0);
            stage(vb);
            LDS_BAR();
            const Tile cb = tb;
            if (hn) { tb = make(q + F.G, 1); issue(vb, tb); }
            convert(cb, 1 & cb.fp8);
            LDS_BAR();
            flush(cb);
            q += F.G;
        }
#undef CV_WAIT
        LDS_BAR();
    }
}
constexpr int IT_GKD = 32 * 1, IT_RW = 32 * 2;
DI void p0_prologue(Frame& F) {
    const float* const* in = F.in;
    {
        LAS float* sv = (LAS float*)F.lds;
        LAS float* red = (LAS float*)(F.lds + 40960);
        for (int i = F.tid; i < 5 * 2048; i += 512) { const int r = i >> 11, k = i & 2047; const float c = (r < 4) ? in[I_C][r * 2048 + k] : in[I_CCTX][k]; sv[i] = siluf_(c); }
        __syncthreads();
        const int NCOLB = 48;
        for (int cb = F.bid; cb < (NMOD * D) / NCOLB; cb += F.G) {
            const int n0 = cb * NCOLB;
            const int c4 = F.tid % 12, kr = F.tid / 12;
            f32x4 acc[5];
#pragma unroll
            for (int r = 0; r < 5; ++r) acc[r] = (f32x4){0.f, 0.f, 0.f, 0.f};
            if (kr < 42) {
                const float* wp = in[I_ADAW] + n0 + 4 * c4;
#pragma unroll 1
                for (int j0 = 0; j0 < 48; j0 += 8) {
                    f32x4 w[8];
#pragma unroll
                    for (int j = 0; j < 8; ++j) w[j] = __builtin_nontemporal_load((const GAS f32x4*)(wp + (size_t)(kr + 42 * (j0 + j)) * (NMOD * D)));
#pragma unroll
                    for (int j = 0; j < 8; ++j)
#pragma unroll
                        for (int r = 0; r < 5; ++r) acc[r] += w[j] * sv[r * 2048 + kr + 42 * (j0 + j)];
                }
                if (kr < 32) { const int k = kr + 42 * 48; const f32x4 w = __builtin_nontemporal_load((const GAS f32x4*)(wp + (size_t)k * (NMOD * D)));
#pragma unroll
                    for (int r = 0; r < 5; ++r) acc[r] += w * sv[r * 2048 + k]; }
#pragma unroll
                for (int r = 0; r < 5; ++r) *(LAS f32x4*)(red + (kr * 5 + r) * 48 + 4 * c4) = acc[r];
            }
            __syncthreads();
            if (F.tid < 240) { const int r = F.tid / 48, n = F.tid % 48; float s = 0.f;
                for (int k = 0; k < 42; ++k) s += red[(k * 5 + r) * 48 + n];
                ((float*)(F.ws + WS_MOD))[r * (NMOD * D) + n0 + n] = s + in[I_ADAB][n0 + n]; }
            __syncthreads();
        }
    }
    {
        for (int gid = (F.tid < 32) ? (F.bid * 32 + F.tid) : (2 * S5NG * S5P); gid < 2 * S5NG * S5P; gid += F.G * 32) {
            const int dr = gid >> 12, g = (gid >> 6) & 63, p = gid & 63;
            const float lre = in[I_LAMRE][gid], lim = in[I_LAMIM][gid];
            const float dt = expf(in[I_LOGDT][dr * 64 + g]);
            const float mag = expf(lre * dt), ph = lim * dt;
            const float lbr = mag * cosf(ph), lbi = mag * sinf(ph);
            const float mag64 = expf(lre * dt * 64.f), ph64 = ph * 64.f;
            f32x2* lam = (f32x2*)(F.ws + WS_S5TAB + S5TAB_LAM); f32x2* lam64 = (f32x2*)(F.ws + WS_S5TAB + S5TAB_LAM64);
            lam[gid] = (f32x2){lbr, lbi};
            lam64[gid] = (f32x2){mag64 * cosf(ph64), mag64 * sinf(ph64)};
            const float nr = lbr - 1.f, ni = lbi, den = lre * lre + lim * lim;
            const float cr = (nr * lre + ni * lim) / den, ci = (ni * lre - nr * lim) / den;
            bf16_t* BT = (bf16_t*)(F.ws + WS_S5TAB + S5TAB_BT) + (size_t)(dr * 64 + g) * 128 * 16;
            bf16_t* CT = (bf16_t*)(F.ws + WS_S5TAB + S5TAB_CT) + (size_t)(dr * 64 + g) * 16 * 128;
            const float* bre = in[I_BRE] + (size_t)gid * 16; const float* bim = in[I_BIM] + (size_t)gid * 16;
#pragma unroll
            for (int h = 0; h < 16; ++h) {
                const float br = bre[h], bi = bim[h];
                BT[(64 * (p >> 5) + (p & 31)) * 16 + h] = (bf16_t)f2bf(cr * br - ci * bi);
                BT[(64 * (p >> 5) + 32 + (p & 31)) * 16 + h] = (bf16_t)f2bf(cr * bi + ci * br);
                const size_t ci_idx = ((size_t)(dr * 64 + g) * 16 + h) * 64 + p;
                CT[h * 128 + 2 * p] = (bf16_t)f2bf(in[I_CRE][ci_idx]);
                CT[h * 128 + 2 * p + 1] = (bf16_t)f2bf(-in[I_CIM][ci_idx]);
            }
        }
    }
    p0_convert(F, NP_EXPERT, NP_CONV_ALL);
    {
        {
            LAS float* scr = (LAS float*)(F.lds + F.wave * 16384);
            const int gw = F.bid * 8 + F.wave, NGW = F.G * 8;
            f32x4 va[8];
            for (int it = gw; it < IT_GKD + IT_RW; it += NGW) {
                const TrItem ti = (it < IT_GKD) ? tr_make(in[I_WIN], INW, 64 * it, 4096, (bf16_t*)(F.ws + WS_WGKD_T), 2048, 0) : tr_dense(in[I_RW], 64, 0, 64, (bf16_t*)(F.ws + WS_ROUT_T), 2048, 0, it - IT_GKD);
                tr_load(ti, va, F.lane); tr_finish(ti, va, scr, F.lane);
            }
        }
    }
}

constexpr int AST = 2056;
DI void norm_row_load(f32x4 (&v)[8], const float* xrow, int lane) {
    const GAS f32x4* xr = (const GAS f32x4*)xrow + lane;
#pragma unroll
    for (int j = 0; j < 8; ++j) v[j] = __builtin_nontemporal_load(xr + 64 * j);
}
template <int FP8OUT>
DI void norm_row_finish(const f32x4 (&v)[8], const float* nw, const float* sh, const float* sc, bf16_t* grow, LAS bf16_t* lrow, int lane, unsigned char* grow8 = nullptr) {
    float s = 0.f;
#pragma unroll
    for (int j = 0; j < 8; ++j) s += (v[j].x * v[j].x + v[j].y * v[j].y) + (v[j].z * v[j].z + v[j].w * v[j].w);
    const float rstd = rsqrtf(wave_sum(s) * (1.f / 2048.f) + EPS);
#pragma unroll
    for (int j = 0; j < 8; ++j) {
        const int i4 = lane + 64 * j;
        const f32x4 w = ((const GAS f32x4*)nw)[i4], a = ((const GAS f32x4*)sh)[i4], c = ((const GAS f32x4*)sc)[i4];
        const f32x4 y = (v[j] * rstd) * w * (c + 1.0f) + a;
        v2u o; o.x = pk2(y.x, y.y); o.y = pk2(y.z, y.w);
        if (FP8OUT) { unsigned w8 = 0; w8 = __builtin_amdgcn_cvt_pk_fp8_f32(y.x, y.y, w8, false); w8 = __builtin_amdgcn_cvt_pk_fp8_f32(y.z, y.w, w8, true); *(GAS unsigned*)((FP8OUT == 2 ? grow8 : (unsigned char*)grow) + 4 * i4) = w8; }
        if (FP8OUT != 1) *(GAS v2u*)(grow + 4 * i4) = o;
        *(LAS v2u*)(lrow + 4 * i4) = o;
    }
}
template <int NT32>
DI void skinny_bload(bf16x8 (&bf)[16][NT32], const bf16_t* Bt, int wave, int lane) {
#pragma unroll
    for (int ks = 0; ks < 16; ++ks)
#pragma unroll
        for (int j = 0; j < NT32; ++j) bf[ks][j] = *(const GAS bf16x8*)(Bt + (size_t)(32 * j + (lane & 31)) * 2048 + 256 * wave + 16 * ks + 8 * (lane >> 5));
}
template <int NT32>
DI void skinny_gemm(LAS unsigned char* tile, const bf16x8 (&bf)[16][NT32], f32x16 (&acc)[NT32], int wave, int lane, int row0 = 0, int rowmax = 31) {
    const int arow = (row0 + (lane & 31)) < rowmax ? (row0 + (lane & 31)) : rowmax;
#pragma unroll
    for (int ks = 0; ks < 16; ++ks) {
        const int k = 256 * wave + 16 * ks + 8 * (lane >> 5);
        const bf16x8 a = *(const LAS bf16x8*)(tile + arow * (AST * 2) + k * 2);
#pragma unroll
        for (int j = 0; j < NT32; ++j) acc[j] = MFMA32(a, bf[ks][j], acc[j]);
        if ((ks & 3) == 3) asm volatile("" ::: "memory");
    }
}
template <int NT32>
DI void skinny_store_partial(LAS float* red, const f32x16 (&acc)[NT32], int wave, int lane) {
#pragma unroll
    for (int j = 0; j < NT32; ++j)
#pragma unroll
        for (int r = 0; r < 16; ++r) red[(wave * 32 + crow32(r, lane >> 5)) * (32 * NT32) + 32 * j + (lane & 31)] = acc[j][r];
}

DI void p1_norm1(Frame& F) {
    const float* MOD = (const float*)(F.ws + WS_MOD);
    bf16_t* H = (bf16_t*)(F.ws + WS_H);
    float* GKD = (float*)(F.ws + WS_GKD);
    const bf16_t* WG = (const bf16_t*)(F.ws + WS_WGKD_T);
    const float* n1w = F.in[I_N1W];
    constexpr int RPT = 36;
    for (int tile = F.bid; tile < TA / RPT; tile += F.G) {
        const int nr = (F.wave < 4) ? 5 : 4, r0 = (F.wave < 4) ? 5 * F.wave : 20 + 4 * (F.wave - 4);
        {
            f32x4 va[8], vb[8];
            auto rowsrc = [&](int lr) -> const float* { const int row = tile * RPT + lr; return (row < T) ? (F.in[I_X] + (size_t)row * D) : (F.in[I_CTX] + (size_t)(row - T) * D); };
            auto finish = [&](const f32x4 (&v)[8], int lr) { const int row = tile * RPT + lr; const float* mr = MOD + (size_t)((row < T) ? (row / SEQ) : 4) * (NMOD * D);
                norm_row_finish<2>(v, n1w, mr, mr + D, H + (size_t)row * D, (LAS bf16_t*)F.lds + lr * AST, F.lane, F.ws + WS_H8 + (size_t)row * D); };
            norm_row_load(va, rowsrc(r0), F.lane);
            norm_row_load(vb, rowsrc(r0 + 1), F.lane); finish(va, r0);
            norm_row_load(va, rowsrc(r0 + 2), F.lane); finish(vb, r0 + 1);
            norm_row_load(vb, rowsrc(r0 + 3), F.lane); finish(va, r0 + 2);
            if (nr == 5) { norm_row_load(va, rowsrc(r0 + 4), F.lane); finish(vb, r0 + 3); finish(va, r0 + 4); }
            else finish(vb, r0 + 3);
        }
        bf16x8 bfr[16][1]; skinny_bload<1>(bfr, WG, F.wave, F.lane);
        __syncthreads();
        f32x16 acc0[1], acc1[1];
#pragma unroll
        for (int r = 0; r < 16; ++r) { acc0[0][r] = 0.f; acc1[0][r] = 0.f; }
        skinny_gemm<1>(F.lds, bfr, acc0, F.wave, F.lane, 0, 31);
        skinny_gemm<1>(F.lds, bfr, acc1, F.wave, F.lane, 32, RPT - 1);
        __syncthreads();
        LAS float* red = (LAS float*)F.lds;
        skinny_store_partial<1>(red, acc0, F.wave, F.lane);
        skinny_store_partial<1>(red + 8192, acc1, F.wave, F.lane);
        __syncthreads();
        for (int o = F.tid; o < RPT * 32; o += 512) { const int lr = o >> 5, n = o & 31; const LAS float* rp = red + (lr >> 5) * 8192 + (lr & 31) * 32 + n; float s = 0.f;
#pragma unroll
            for (int w = 0; w < 8; ++w) s += rp[w * 1024];
            GKD[(size_t)(tile * RPT + lr) * 32 + n] = s; }
        __syncthreads();
    }
}

DI bool static_tile(int L, int nM, int nN, int& pm, int& pn) {
    const int nwg = nM * nN; if (L >= nwg) return false;
    int wgid = L; { const int q = nwg / 8, r = nwg % 8, xcd = wgid % 8, off = wgid / 8; wgid = (xcd < r ? xcd * (q + 1) : r * (q + 1) + (xcd - r) * q) + off; }
    const int nig = 8 * nN, gid = wgid / nig, fm = gid * 8, gsz = (nM - fm) < 8 ? (nM - fm) : 8;
    pm = fm + ((wgid % nig) % gsz); pn = (wgid % nig) / gsz; return true;
}
struct DenseOrder {
    const bf16_t* A; const bf16_t* Bt; int nM, nN, K, G, c; bool halfn;
    DI bool next(int i, pg8::Unit& u) const {
        int pm, pn; const int L = i * G + c;
        if (!static_tile(halfn ? (L >> 1) : L, nM, nN, pm, pn)) return false;
        const int half = halfn ? (L & 1) : 0;
        u.a = (const char*)(A + (size_t)pm * 256 * K); u.b = (const char*)(Bt + ((size_t)pn * 256 + 128 * half) * K); u.idx = nullptr; u.nvalid = 256; u.pm = pm; u.pn = pn; u.e = 0;
        u.cb = 256 * pn + 128 * half; u.flags = halfn ? 2 : 0; return true;
    }
};
struct DenseOrder8 {
    const unsigned char* A; const unsigned char* Bt; int nM, nN, K, G, c; bool halfn;
    DI bool next(int i, pg8::Unit& u) const {
        int pm, pn; const int L = i * G + c;
        if (!static_tile(halfn ? (L >> 1) : L, nM, nN, pm, pn)) return false;
        const int half = halfn ? (L & 1) : 0;
        u.a = (const char*)(A + (size_t)pm * 256 * K); u.b = (const char*)(Bt + ((size_t)pn * 256 + 128 * half) * K); u.idx = nullptr; u.nvalid = 256; u.pm = pm; u.pn = pn; u.e = 0;
        u.cb = 256 * pn + 128 * half; u.flags = halfn ? 2 : 0; return true;
    }
};
struct G1Order {
    const bf16_t* A; const bf16_t* Bt; int G, c;
    DI bool next(int i, pg8::Unit& u) const {
        const int L = i * G + c; int pm, pn;
        if (L < 128) { int j; static_tile(L, 32, 4, pm, j); pn = (j < 2) ? 4 + j : 8 + j; }
        else if (L < 136) { const int j = L - 128; pm = 32 + (j & 3); pn = 4 + (j >> 2); }
        else return false;
        u.a = (const char*)(A + (size_t)pm * 256 * D); u.b = (const char*)(Bt + (size_t)pn * 256 * D); u.idx = nullptr; u.nvalid = 256; u.pm = pm; u.pn = pn; u.e = 0;
        u.cb = 256 * pn; u.flags = 0; return true;
    }
};
struct G1Order8 {
    const unsigned char* A; const unsigned char* Bt; int G, c;
    DI bool next(int i, pg8::Unit& u) const {
        int L;
        if (G == 256) {
            if (i < 3) L = i * 256 + c;
            else { const int cc = c - 136; if (cc < 0) return false;
                if (i == 3) { if (cc >= 120) return false; L = 768 + cc; } else if (i == 4) { if (cc >= 40) return false; L = 888 + cc; } else return false; }
        } else { L = i * G + c; if (L >= 928) return false; }
        int pm, pn;
        if (L < 896) { int j; static_tile(L, 32, 28, pm, j); pn = (j < 4) ? j : ((j < 8) ? j + 2 : j + 4); }
        else { const int jj = L - 896, q = jj >> 2; pm = 32 + (jj & 3); pn = (q < 4) ? q : q + 2; }
        u.a = (const char*)(A + (size_t)pm * 256 * D); u.b = (const char*)(Bt + (size_t)pn * 256 * D); u.idx = nullptr; u.nvalid = 256; u.pm = pm; u.pn = pn; u.e = 0;
        u.cb = 256 * pn; u.flags = 0; return true;
    }
};
constexpr int MT_CNT = 0, MT_MT = 80, MT_NF = 160, MT_HB = 240, MT_XF = 320, MT_XL = 400, MT_WORDS = 480;
DI void moe_tables(Frame& F, volatile LAS int* tb) {
    if (F.tid < 65) {
        const unsigned* cnt = (const unsigned*)(F.ws + WS_CTL) + CW_CNT;
        tb[MT_CNT + F.tid] = (F.tid < 64) ? (int)__hip_atomic_load(cnt + 16 * F.tid, RLX_AGENT) : T;
    }
    __syncthreads();
    if (F.tid == 0) {
        int hb = 0;
        for (int e = 0; e <= 64; ++e) { const int c = tb[MT_CNT + e]; const int m = (c + 255) >> 8; tb[MT_MT + e] = m; tb[MT_NF + e] = (c + 127) >> 8; tb[MT_HB + e] = hb; hb += m * 256; }
        tb[MT_HB + 65] = hb;
        int af = 0, al = 0;
        for (int x = 0; x < 8; ++x) {
            for (int k = 0; k < 8; ++k) { const int e = x + 8 * k; tb[MT_XF + 10 * x + k] = af; tb[MT_XL + 10 * x + k] = al; af += tb[MT_NF + e]; al += tb[MT_MT + e] - tb[MT_NF + e]; }
            tb[MT_XF + 10 * x + 8] = af; af += 4; tb[MT_XF + 10 * x + 9] = af; tb[MT_XL + 10 * x + 8] = al; tb[MT_XL + 10 * x + 9] = al;
        }
    }
    __syncthreads();
}
constexpr int MT_UL = 480;
template <int NTN>
DI void moe_unit_list(Frame& F, volatile LAS int* tb) {
    if (F.tid < 64) {
        const int i = F.tid, c = F.bid, G = F.G;
        int e = -1, mtile = 0, nt_ = 0, fl = 0;
        const int xg = c & 7, R = G >> 3, UF = tb[MT_XF + 79] * NTN, UL = tb[MT_XL + 79] * NTN;
        const int f0 = (int)(((long)UF * xg) >> 3), f1 = (int)(((long)UF * (xg + 1)) >> 3), l0 = (int)(((long)UL * xg) >> 3), l1 = (int)(((long)UL * (xg + 1)) >> 3);
        const int Q = i * R + (c >> 3);
        if (Q < f1 - f0) {
            const int P = f0 + Q;
            int x = 0;
#pragma unroll
            for (int q = 1; q < 8; ++q) x += (tb[MT_XF + 10 * q] * NTN <= P) ? 1 : 0;
            int k = 0;
#pragma unroll
            for (int q = 1; q < 9; ++q) k += (tb[MT_XF + 10 * x + q] * NTN <= P) ? 1 : 0;
            const int loc = P - tb[MT_XF + 10 * x + k] * NTN;
            if (k < 8) { e = x + 8 * k; const int m = tb[MT_NF + e]; mtile = loc % m; nt_ = loc / m; }
            else { e = 64; mtile = 4 * x + (loc & 3); nt_ = loc >> 2; }
        } else if (Q - (f1 - f0) < l1 - l0) {
            const int P = l0 + Q - (f1 - f0);
            int x = 0;
#pragma unroll
            for (int q = 1; q < 8; ++q) x += (tb[MT_XL + 10 * q] * NTN <= P) ? 1 : 0;
            int k = 0;
#pragma unroll
            for (int q = 1; q < 8; ++q) k += (tb[MT_XL + 10 * x + q] * NTN <= P) ? 1 : 0;
            e = x + 8 * k; mtile = tb[MT_NF + e]; nt_ = P - tb[MT_XL + 10 * x + k] * NTN; fl = 1;
        }
        tb[MT_UL + 4 * i] = e; tb[MT_UL + 4 * i + 1] = mtile; tb[MT_UL + 4 * i + 2] = nt_; tb[MT_UL + 4 * i + 3] = fl;
    }
    __syncthreads();
}
template <int NTN, int ES>
struct MoeOrder {
    const volatile LAS int* tb; const unsigned char* A; const unsigned char* Bt; const int* list; int K, G, c;
    DI bool next(int i, pg8::Unit& u) const {
        if (i >= 64) return false;
        const int e = __builtin_amdgcn_readfirstlane(tb[MT_UL + 4 * i]);
        if (e < 0) return false;
        const int mtile = __builtin_amdgcn_readfirstlane(tb[MT_UL + 4 * i + 1]), nt_ = __builtin_amdgcn_readfirstlane(tb[MT_UL + 4 * i + 2]), fl = __builtin_amdgcn_readfirstlane(tb[MT_UL + 4 * i + 3]);
        const int hb = __builtin_amdgcn_readfirstlane(tb[MT_HB + e]), cnt = __builtin_amdgcn_readfirstlane(tb[MT_CNT + e]);
        u.e = e; u.pn = nt_; u.pm = (hb >> 8) + mtile; u.nvalid = (cnt - mtile * 256) < 256 ? (cnt - mtile * 256) : 256;
        u.cb = 256 * nt_; u.flags = fl;
        u.b = (const char*)(Bt + (size_t)e * (NTN * 256) * K * ES + (size_t)nt_ * 256 * 128);
        if (NTN == 4) { u.a = (const char*)A; u.idx = list + (size_t)e * T + mtile * 256; }
        else { u.a = (const char*)(A + (size_t)(hb + mtile * 256) * K * ES); u.idx = nullptr; }
        return true;
    }
};

DI v4u pack8(const f32x4 v0, const f32x4 v1) { v4u w; w.x = pg8::cvt_pk_bf16(v0[0], v0[1]); w.y = pg8::cvt_pk_bf16(v0[2], v0[3]); w.z = pg8::cvt_pk_bf16(v1[0], v1[1]); w.w = pg8::cvt_pk_bf16(v1[2], v1[3]); return w; }
DI void unpack8(const v4u w, f32x4& v0, f32x4& v1) { v0 = (f32x4){bflo(w.x), bfhi(w.x), bflo(w.y), bfhi(w.y)}; v1 = (f32x4){bflo(w.z), bfhi(w.z), bflo(w.w), bfhi(w.w)}; }

struct EpiG1 {
    static constexpr bool PERM = true;
    unsigned char* ws;
    DI void operator()(const f32x4 (&acc)[2][2][4][2], const pg8::Unit& u, int wr, int wc, int fr, int fq) const {
        const int pn = u.cb >> 8; bf16_t* dst; int ld, c0, act;
        if (pn < 4) { dst = (bf16_t*)(ws + WS_U); ld = 1024; c0 = 256 * pn; act = 0; }
        else if (pn < 6) { dst = (bf16_t*)(ws + WS_KK); ld = 512; c0 = 256 * (pn - 4); act = 0; }
        else if (pn < 10) { dst = (bf16_t*)(ws + WS_V); ld = 1024; c0 = 256 * (pn - 6); act = 0; }
        else if (pn < 12) { dst = (bf16_t*)(ws + WS_Q); ld = 512; c0 = 256 * (pn - 10); act = 1; }
        else if (pn < 16) { dst = (bf16_t*)(ws + WS_GO); ld = 1024; c0 = 256 * (pn - 12); act = 2; }
        else if (pn < 24) { dst = (bf16_t*)(ws + WS_GS); ld = 2048; c0 = 256 * (pn - 16); act = 3; }
        else { dst = (bf16_t*)(ws + WS_GG); ld = 2048; c0 = 256 * (pn - 24); act = 3; }
        const int row0 = u.pm * 256 + wr * 64 + fr, col0 = c0 + (u.cb & 255) + wc * 32 + 8 * fq;
#pragma unroll
        for (int ai = 0; ai < 2; ++ai)
#pragma unroll
            for (int m = 0; m < 4; ++m) { bf16_t* rowp = dst + (size_t)(row0 + ai * 128 + m * 16) * ld + col0;
#pragma unroll
                for (int bj = 0; bj < 2; ++bj) { if (bj && (u.flags & 2)) continue; f32x4 v0 = acc[ai][bj][m][0], v1 = acc[ai][bj][m][1];
                    if (act == 1) { v0 *= 0.08838834764831845f; v1 *= 0.08838834764831845f; }
                    else if (act == 2) {
#pragma unroll
                        for (int j = 0; j < 4; ++j) { v0[j] = siluf_(v0[j]); v1[j] = siluf_(v1[j]); } }
                    else if (act == 3) {
#pragma unroll
                        for (int j = 0; j < 4; ++j) { v0[j] = sigmoidf_(v0[j]); v1[j] = sigmoidf_(v1[j]); } }
                    *(GAS v4u*)(rowp + bj * 128) = pack8(v0, v1); } }
    }
};
template <int MODE>
struct EpiEw {
    static constexpr bool PERM = true;
    bf16_t* O; const bf16_t* P1; int ld;
    DI void operator()(const f32x4 (&acc)[2][2][4][2], const pg8::Unit& u, int wr, int wc, int fr, int fq) const {
        const int rl0 = wr * 64 + fr, col0 = u.cb + wc * 32 + 8 * fq;
        const bool nb1 = (u.flags & 2) != 0;
#pragma unroll
        for (int ai = 0; ai < 2; ++ai) {
            v4u p1[4][2], po[4][2];
            if (MODE != 3) {
#pragma unroll
                for (int m = 0; m < 4; ++m)
#pragma unroll
                    for (int bj = 0; bj < 2; ++bj) { if (bj && nb1) continue; const size_t off = (size_t)(u.pm * 256 + rl0 + ai * 128 + m * 16) * ld + col0 + bj * 128;
                        p1[m][bj] = *(const GAS v4u*)(P1 + off); if (MODE == 2) po[m][bj] = *(const GAS v4u*)(O + off); }
            }
#pragma unroll
            for (int m = 0; m < 4; ++m) { const int rl = rl0 + ai * 128 + m * 16; const size_t off = (size_t)(u.pm * 256 + rl) * ld + col0;
                if (MODE == 3 && rl >= u.nvalid) continue;
#pragma unroll
                for (int bj = 0; bj < 2; ++bj) { if (bj && nb1) continue; f32x4 v0 = acc[ai][bj][m][0], v1 = acc[ai][bj][m][1];
                    if (MODE != 3) { f32x4 q0, q1; unpack8(p1[m][bj], q0, q1);
                        if (MODE == 0) {
#pragma unroll
                            for (int j = 0; j < 4; ++j) { v0[j] = q0[j] * sigmoidf_(v0[j]); v1[j] = q1[j] * sigmoidf_(v1[j]); } }
                        else { v0 *= q0; v1 *= q1; }
                        if (MODE == 2) { f32x4 o0, o1; unpack8(po[m][bj], o0, o1); v0 += o0; v1 += o1; } }
                    if (MODE == 3) { unsigned w0 = 0, w1 = 0;
                        w0 = __builtin_amdgcn_cvt_pk_fp8_f32(v0[0], v0[1], w0, false); w0 = __builtin_amdgcn_cvt_pk_fp8_f32(v0[2], v0[3], w0, true);
                        w1 = __builtin_amdgcn_cvt_pk_fp8_f32(v1[0], v1[1], w1, false); w1 = __builtin_amdgcn_cvt_pk_fp8_f32(v1[2], v1[3], w1, true);
                        *(GAS v2u*)((unsigned char*)O + off + bj * 128) = (v2u){w0, w1}; }
                    else if (MODE == 0) { unsigned w0 = 0, w1 = 0;
                        w0 = __builtin_amdgcn_cvt_pk_fp8_f32(v0[0], v0[1], w0, false); w0 = __builtin_amdgcn_cvt_pk_fp8_f32(v0[2], v0[3], w0, true);
                        w1 = __builtin_amdgcn_cvt_pk_fp8_f32(v1[0], v1[1], w1, false); w1 = __builtin_amdgcn_cvt_pk_fp8_f32(v1[2], v1[3], w1, true);
                        *(GAS v2u*)((unsigned char*)O + off + bj * 128) = (v2u){w0, w1}; }
                    else *(GAS v4u*)(O + off + bj * 128) = pack8(v0, v1); } }
            asm volatile("" ::: "memory");
        }
    }
};
struct EpiY8 {
    static constexpr bool PERM = true;
    unsigned char* O; int ld;
    DI void operator()(const f32x4 (&acc)[2][2][4][2], const pg8::Unit& u, int wr, int wc, int fr, int fq) const {
        const bool odd = (fr & 1) != 0;
        const int rl0 = wr * 64 + (fr & ~1), colb = u.cb + 64 * wc + 8 * fq + (odd ? 32 : 0);
#pragma unroll
        for (int ai = 0; ai < 2; ++ai) {
#pragma unroll
            for (int m = 0; m < 4; ++m) {
                unsigned w[2][2];
#pragma unroll
                for (int bj = 0; bj < 2; ++bj) { const f32x4 v0 = acc[ai][bj][m][0], v1 = acc[ai][bj][m][1]; unsigned w0 = 0, w1 = 0;
                    w0 = __builtin_amdgcn_cvt_pk_fp8_f32(v0[0], v0[1], w0, false); w0 = __builtin_amdgcn_cvt_pk_fp8_f32(v0[2], v0[3], w0, true);
                    w1 = __builtin_amdgcn_cvt_pk_fp8_f32(v1[0], v1[1], w1, false); w1 = __builtin_amdgcn_cvt_pk_fp8_f32(v1[2], v1[3], w1, true);
                    w[bj][0] = w0; w[bj][1] = w1; }
                const unsigned s0 = odd ? w[0][0] : w[1][0], s1 = odd ? w[0][1] : w[1][1];
                const unsigned r0 = (unsigned)__builtin_amdgcn_mov_dpp((int)s0, 0xB1, 0xf, 0xf, true), r1 = (unsigned)__builtin_amdgcn_mov_dpp((int)s1, 0xB1, 0xf, 0xf, true);
                const v2u d1 = odd ? (v2u){r0, r1} : (v2u){w[0][0], w[0][1]};
                const v2u d2 = odd ? (v2u){w[1][0], w[1][1]} : (v2u){r0, r1};
                const int rl = rl0 + ai * 128 + m * 16; const size_t off = (size_t)(u.pm * 256 + rl) * ld + colb;
                if (rl < u.nvalid) *(GAS v2u*)(O + off) = d1;
                if (rl + 1 < u.nvalid) *(GAS v2u*)(O + off + ld) = d2;
            }
            asm volatile("" ::: "memory");
        }
    }
};
struct MergeOrder {
    const unsigned char* A0; const unsigned char* B0; const unsigned char* A1; const unsigned char* B1; int G, c;
    DI bool next(int i, pg8::Unit& u) const {
        const int t = (i >> 1) * G + c, ty = i & 1; int pm, pn;
        if (!static_tile(t, 32, 8, pm, pn)) return false;
        u.a = (const char*)((ty ? A1 : A0) + (size_t)pm * 256 * 1024); u.b = (const char*)((ty ? B1 : B0) + (size_t)pn * 256 * 1024); u.idx = nullptr; u.nvalid = 256; u.pm = pm; u.pn = pn; u.e = ty;
        u.cb = 256 * pn; u.flags = 0; return true;
    }
};
struct EpiMerge {
    static constexpr bool PERM = true; static constexpr int NSTORES = 0;
    bf16_t* M; const bf16_t* GS; const bf16_t* GG;
    DI void operator()(const f32x4 (&acc)[2][2][4][2], const pg8::Unit& u, int wr, int wc, int fr, int fq) const {
        if (u.e == 0) { EpiEw<1> e{M, GS, 2048}; e(acc, u, wr, wc, fr, fq); }
        else { EpiEw<2> e{M, GG, 2048}; e(acc, u, wr, wc, fr, fq); }
    }
};
DI void p64_swap(bool odd, f32x4 (&x0)[2], f32x4 (&x1)[2]) {
#pragma unroll
    for (int n = 0; n < 2; ++n)
#pragma unroll
        for (int j = 0; j < 4; ++j) {
            const float a = x0[n][j], b = x1[n][j];
            const float snd = odd ? a : b;
            const float rcv = __int_as_float(__builtin_amdgcn_mov_dpp(__float_as_int(snd), 0xB1, 0xf, 0xf, true));
            x0[n][j] = odd ? rcv : a; x1[n][j] = odd ? b : rcv;
        }
}
struct EpiMerge64 {
    static constexpr bool PERM = true;
    bf16_t* M; const bf16_t* GS; const bf16_t* GG; unsigned char* M8;
    DI void operator()(const f32x4 (&acc)[2][2][4][2], const pg8::Unit& u, int wr, int wc, int fr, int fq) const {
        const bool odd = (fr & 1) != 0, second = (u.e != 0);
        const bf16_t* P1 = second ? GG : GS;
        const size_t base = (size_t)(u.pm * 256 + wr * 64 + (fr & ~1)) * 2048 + u.cb + 64 * wc + (odd ? 32 : 0) + 8 * fq;
#pragma unroll
        for (int ai = 0; ai < 2; ++ai) {
            v4u p1[4][2], po[4][2];
#pragma unroll
            for (int m = 0; m < 4; ++m)
#pragma unroll
                for (int k = 0; k < 2; ++k) { const size_t off = base + (size_t)(ai * 128 + m * 16 + k) * 2048;
                    p1[m][k] = *(const GAS v4u*)(P1 + off); if (second) po[m][k] = *(const GAS v4u*)(M + off); }
#pragma unroll
            for (int m = 0; m < 4; ++m) {
                f32x4 y0[2] = {acc[ai][0][m][0], acc[ai][0][m][1]}, y1[2] = {acc[ai][1][m][0], acc[ai][1][m][1]};
                p64_swap(odd, y0, y1);
#pragma unroll
                for (int k = 0; k < 2; ++k) { const size_t off = base + (size_t)(ai * 128 + m * 16 + k) * 2048;
                    f32x4 v0 = k ? y1[0] : y0[0], v1 = k ? y1[1] : y0[1], q0, q1; unpack8(p1[m][k], q0, q1);
                    v0 *= q0; v1 *= q1;
                    if (second) { f32x4 o0, o1; unpack8(po[m][k], o0, o1); v0 += o0; v1 += o1;
                        unsigned w0 = 0, w1 = 0;
                        w0 = __builtin_amdgcn_cvt_pk_fp8_f32(v0[0], v0[1], w0, false); w0 = __builtin_amdgcn_cvt_pk_fp8_f32(v0[2], v0[3], w0, true);
                        w1 = __builtin_amdgcn_cvt_pk_fp8_f32(v1[0], v1[1], w1, false); w1 = __builtin_amdgcn_cvt_pk_fp8_f32(v1[2], v1[3], w1, true);
                        *(GAS v2u*)(M8 + off) = (v2u){w0, w1}; }
                    else *(GAS v4u*)(M + off) = pack8(v0, v1); }
            }
            asm volatile("" ::: "memory");
        }
    }
};
struct EpiOut {
    static constexpr bool PERM = true;
    const float* x; const float* mod; bf16_t* X1;
    DI void operator()(const f32x4 (&acc)[2][2][4][2], const pg8::Unit& u, int wr, int wc, int fr, int fq) const {
        const int row0 = u.pm * 256 + wr * 64 + fr, col0 = u.cb + wc * 32 + 8 * fq;
        const float* g1 = mod + (size_t)(u.pm * 256 / SEQ) * (NMOD * D) + 2 * D;
        f32x4 gv[2][2];
#pragma unroll
        for (int bj = 0; bj < 2; ++bj)
#pragma unroll
            for (int n = 0; n < 2; ++n) gv[bj][n] = *(const GAS f32x4*)(g1 + col0 + bj * 128 + n * 4);
#pragma unroll
        for (int ai = 0; ai < 2; ++ai)
#pragma unroll
            for (int mh = 0; mh < 2; ++mh) {
                f32x4 xs[2][2][2];
#pragma unroll
                for (int mm = 0; mm < 2; ++mm)
#pragma unroll
                    for (int bj = 0; bj < 2; ++bj)
#pragma unroll
                        for (int n = 0; n < 2; ++n) xs[mm][bj][n] = __builtin_nontemporal_load((const GAS f32x4*)(x + (size_t)(row0 + ai * 128 + (2 * mh + mm) * 16) * D + col0 + bj * 128 + n * 4));
#pragma unroll
                for (int mm = 0; mm < 2; ++mm)
#pragma unroll
                    for (int bj = 0; bj < 2; ++bj) { const int m = 2 * mh + mm;
                        *(GAS v4u*)(X1 + (size_t)(row0 + ai * 128 + m * 16) * D + col0 + bj * 128) = pack8(xs[mm][bj][0] + gv[bj][0] * acc[ai][bj][m][0], xs[mm][bj][1] + gv[bj][1] * acc[ai][bj][m][1]); }
                asm volatile("" ::: "memory");
            }
    }
};
struct EpiGU {
    static constexpr bool PERM = true;
    unsigned char* HID;
    DI void operator()(const f32x4 (&acc)[2][2][4][2], const pg8::Unit& u, int wr, int wc, int fr, int fq) const {
        const int rl0 = wr * 64 + fr, col0 = u.pn * 128 + wc * 32 + 8 * fq;
#pragma unroll
        for (int ai = 0; ai < 2; ++ai)
#pragma unroll
            for (int m = 0; m < 4; ++m) { const int rl = rl0 + ai * 128 + m * 16; if (rl >= u.nvalid) continue;
                float v[8];
#pragma unroll
                for (int j = 0; j < 4; ++j) { v[j] = siluf_(acc[ai][0][m][0][j]) * acc[ai][1][m][0][j]; v[4 + j] = siluf_(acc[ai][0][m][1][j]) * acc[ai][1][m][1][j]; }
                unsigned w0 = 0, w1 = 0;
                w0 = __builtin_amdgcn_cvt_pk_fp8_f32(v[0], v[1], w0, false); w0 = __builtin_amdgcn_cvt_pk_fp8_f32(v[2], v[3], w0, true);
                w1 = __builtin_amdgcn_cvt_pk_fp8_f32(v[4], v[5], w1, false); w1 = __builtin_amdgcn_cvt_pk_fp8_f32(v[6], v[7], w1, true);
                *(GAS v2u*)(HID + (size_t)(u.pm * 256 + rl) * DEXP + col0) = (v2u){w0, w1}; }
    }
};

DI float gelu_tanh(float x) {
    const float u = 0.7978845608028654f * (x + 0.044715f * x * x * x);
    const float e = __expf(2.f * u);
    const float th = 1.f - 2.f * __builtin_amdgcn_rcpf(e + 1.f);
    return 0.5f * x * (1.f + th);
}
DI int chunk_rowbase(int b, int n) { return (n < NCHC) ? (T + b * CTX + n * GCH) : (b * SEQ + (n - NCHC) * GCH); }
DI float fma_s(float a, float b, float c) { float r; asm("v_fma_f32 %0, %1, %2, %3" : "=v"(r) : "v"(a), "v"(b), "v"(c)); return r; }
struct S5Cur { bf16x8 afr[2]; f32x2 s; };
template <bool READOUT, int DR>
DI void s5_dir(f32x4 (&yacc)[2][2], const S5Cur& o, f32x2& sout, const f32x2 lam, const bf16x8 (&bfr)[4], const bf16x8 (&cfr)[4], LAS unsigned char* hsb, int lane) {
    const int l15 = lane & 15, q4 = lane >> 4;
    const float lr = lam.x, li = lam.y, nli = -lam.y;
    float sr = o.s.x, si = o.s.y;
#pragma unroll
    for (int sbi = 0; sbi < 2; ++sbi) {
        const int sb = DR ? (1 - sbi) : sbi;
        f32x16 c[4];
#pragma unroll
        for (int j = 0; j < 4; ++j) {
#pragma unroll
            for (int r = 0; r < 16; ++r) c[j][r] = 0.f;
            c[j] = MFMA32(o.afr[sb], bfr[j], c[j]);
        }
        float xr[2][16], xi[2][16];
#pragma unroll
        for (int r = 0; r < 16; ++r) {
            const float c0 = c[0][r], c1 = c[1][r], c2 = c[2][r], c3 = c[3][r];
            auto pr = __builtin_amdgcn_permlane32_swap(__float_as_uint(c0), __float_as_uint(c2), false, false);
            auto pi = __builtin_amdgcn_permlane32_swap(__float_as_uint(c1), __float_as_uint(c3), false, false);
            const unsigned pr0 = pr[0], pr1 = pr[1], pi0 = pi[0], pi1 = pi[1];
            xr[0][r] = __uint_as_float(pr0); xr[1][r] = __uint_as_float(pr1);
            xi[0][r] = __uint_as_float(pi0); xi[1][r] = __uint_as_float(pi1);
        }
        if (READOUT) asm volatile("s_waitcnt lgkmcnt(0)" ::: "memory");
#pragma unroll
        for (int tt = 0; tt < 32; ++tt) {
            const int t = DR ? (31 - tt) : tt;
            const int half = (t >> 2) & 1, r = (t & 3) + 4 * (t >> 3);
            const float t1 = fma_s(nli, si, xr[half][r]), t2 = fma_s(li, sr, xi[half][r]);
            const float nr = fma_s(lr, sr, t1), ni = fma_s(lr, si, t2);
            sr = nr; si = ni;
            if (READOUT) *(LAS unsigned*)(hsb + t * 256 + ((((lane >> 2) ^ (t & 15))) << 4) + (lane & 3) * 4) = pk2(nr, ni);
        }
        if (READOUT) {
            asm volatile("s_waitcnt lgkmcnt(0)" ::: "memory");
#pragma unroll
            for (int mt = 0; mt < 2; ++mt)
#pragma unroll
                for (int ks = 0; ks < 4; ++ks) {
                    const int row = 16 * mt + l15, ch = 4 * ks + q4;
                    const bf16x8 a = *(const LAS bf16x8*)(hsb + row * 256 + ((ch ^ l15) << 4));
                    yacc[sb][mt] = MFMA16(a, cfr[ks], yacc[sb][mt]);
                }
        }
    }
    sout = (f32x2){sr, si};
}
template <bool READOUT>
DI void s5_phase(Frame& F) {
    constexpr int NC = READOUT ? NCHL : NCH, NIT = NB * NC * 16;
    const int lane = F.lane, l31 = lane & 31, hi = lane >> 5, l15 = lane & 15, q4 = lane >> 4;
    const int gq = F.wave & 3, dr = F.wave >> 2;
    LAS unsigned char* hsb = F.lds + F.wave * 8192;
    LAS float* ysh = (LAS float*)(F.lds + 65536) + gq * 1024;
    int itn = 0;
    const bf16_t* U = (const bf16_t*)(F.ws + WS_U);
    const bf16_t* BT = (const bf16_t*)(F.ws + WS_S5TAB + S5TAB_BT);
    const bf16_t* CT = (const bf16_t*)(F.ws + WS_S5TAB + S5TAB_CT);
    const f32x2* LAM = (const f32x2*)(F.ws + WS_S5TAB + S5TAB_LAM);
    f32x2* ST = (f32x2*)(F.ws + WS_S5ST);
    bf16_t* YS = (bf16_t*)(F.ws + WS_YS); unsigned char* YS8 = F.ws + WS_YS8;
    bf16x8 bfr[4], cfr[4]; f32x2 lam = (f32x2){0.f, 0.f}; int cur_gb4 = -1;
    S5Cur cur, nxt;
#define S5_LOAD(dst, jj) do { const int gb4_ = (jj) & 15, rest_ = (jj) >> 4, n_ = (rest_ % NC) + (READOUT ? NCHC : 0), b_ = rest_ / NC, g_ = gb4_ * 4 + gq, base_ = chunk_rowbase(b_, n_); \
        _Pragma("unroll") for (int sb = 0; sb < 2; ++sb) (dst).afr[sb] = *(const GAS bf16x8*)(U + (size_t)(base_ + 32 * sb + l31) * S5W + g_ * 16 + 8 * hi); \
        (dst).s = READOUT ? ST[((size_t)((b_ * NCH + n_) * 2 + dr) * 64 + g_) * 64 + lane] : (f32x2){0.f, 0.f}; } while (0)
    if (F.bid < NIT) S5_LOAD(cur, F.bid);
    for (int j = F.bid; j < NIT; j += F.G) {
        const int gb4 = j & 15, rest = j >> 4, n = (rest % NC) + (READOUT ? NCHC : 0), b = rest / NC, g = gb4 * 4 + gq, base = chunk_rowbase(b, n), tg = dr * 64 + g;
        if (gb4 != cur_gb4) {
#pragma unroll
            for (int jj = 0; jj < 4; ++jj) bfr[jj] = *(const GAS bf16x8*)(BT + ((size_t)tg * 128 + 32 * jj + l31) * 16 + 8 * hi);
#pragma unroll
            for (int ks = 0; ks < 4; ++ks) cfr[ks] = READOUT ? *(const GAS bf16x8*)(CT + ((size_t)tg * 16 + l15) * 128 + 32 * ks + 8 * q4) : bfr[ks];
            lam = LAM[tg * 64 + lane]; cur_gb4 = gb4;
        }
        if (j + F.G < NIT) S5_LOAD(nxt, j + F.G);
        f32x4 yacc[2][2];
#pragma unroll
        for (int a = 0; a < 2; ++a)
#pragma unroll
            for (int c = 0; c < 2; ++c) yacc[a][c] = (f32x4){0.f, 0.f, 0.f, 0.f};
        float uskip[8];
        if (READOUT) {
#pragma unroll
            for (int mt = 0; mt < 2; ++mt)
#pragma unroll
                for (int i = 0; i < 4; ++i) uskip[mt * 4 + i] = bf2f(U[(size_t)(base + 32 * dr + 16 * mt + 4 * q4 + i) * S5W + g * 16 + l15]);
        }
        f32x2 sout;
        if (dr == 0) s5_dir<READOUT, 0>(yacc, cur, sout, lam, bfr, cfr, hsb, lane);
        else s5_dir<READOUT, 1>(yacc, cur, sout, lam, bfr, cfr, hsb, lane);
        if (!READOUT) ST[((size_t)((b * NCH + n) * 2 + dr) * 64 + g) * 64 + lane] = sout;
        if (READOUT) {
            LAS float* yx = ysh + (itn & 1) * 4096;
            const int ch = g * 16 + l15; const int osb = 1 - dr;
#pragma unroll
            for (int mt = 0; mt < 2; ++mt)
#pragma unroll
                for (int i = 0; i < 4; ++i) yx[osb * 512 + (16 * mt + 4 * q4 + i) * 16 + l15] = (osb == 0) ? yacc[0][mt][i] : yacc[1][mt][i];
            LDS_BAR();
            const float dsk = F.in[I_S5D][ch];
#pragma unroll
            for (int mt = 0; mt < 2; ++mt)
#pragma unroll
                for (int i = 0; i < 4; ++i) {
                    const int row = 32 * dr + 16 * mt + 4 * q4 + i; const size_t o = (size_t)(base + row) * S5W + ch;
                    const float mine = (dr == 0) ? yacc[0][mt][i] : yacc[1][mt][i];
                    const float yv = gelu_tanh(mine + yx[dr * 512 + (16 * mt + 4 * q4 + i) * 16 + l15] + dsk * uskip[mt * 4 + i]);
                    YS[o] = (bf16_t)f2bf(yv);
                    YS8[o] = (unsigned char)(__builtin_amdgcn_cvt_pk_fp8_f32(yv, 0.f, 0u, false) & 0xffu);
                }
        }
        ++itn;
        cur = nxt;
    }
#undef S5_LOAD
}
DI int chunk_order(int dr, int step) { return dr == 0 ? step : (step < NCHC ? NCHC - 1 - step : NCH + NCHC - 1 - step); }
DI void s5_carry(Frame& F) {
    const int gid = F.bid * 512 + F.tid;
    if (gid >= NB * 2 * 4096) return;
    const int b = gid >> 13, dr = (gid >> 12) & 1, gp = gid & 4095;
    const f32x2 l64 = ((const f32x2*)(F.ws + WS_S5TAB + S5TAB_LAM64))[dr * 4096 + gp];
    f32x2* ST = (f32x2*)(F.ws + WS_S5ST);
    f32x2 e[NCH];
#pragma unroll
    for (int step = 0; step < NCH; ++step) e[step] = ST[(size_t)((b * NCH + chunk_order(dr, step)) * 2 + dr) * 4096 + gp];
    f32x2 h = (f32x2){0.f, 0.f};
#pragma unroll
    for (int step = 0; step < NCH; ++step) {
        ST[(size_t)((b * NCH + chunk_order(dr, step)) * 2 + dr) * 4096 + gp] = h;
        h = (f32x2){l64.x * h.x - l64.y * h.y + e[step].x, l64.x * h.y + l64.y * h.x + e[step].y};
    }
}

constexpr int KST = 72;
constexpr int QST = 136;
struct GlaPre { float up[16]; float bias; f32x4 gs; };
DI void gla_pre_load(Frame& F, int rowbase, int h, int dr, GlaPre& p) {
    const int c = F.tid & 127;
    const float* GKD = (const float*)(F.ws + WS_GKD);
#pragma unroll
    for (int r = 0; r < 16; ++r) p.up[r] = F.in[I_GKUP][(size_t)(dr * 16 + r) * GKW + h * GDK + c];
    p.bias = F.in[I_GKB][dr * GKW + h * GDK + c];
    p.gs = (F.tid < 256) ? *(const GAS f32x4*)(GKD + (size_t)(rowbase + (F.tid >> 2)) * 32 + 16 * dr + 4 * (F.tid & 3)) : (f32x4){0.f, 0.f, 0.f, 0.f};
}
DI float gla_decay(Frame& F, int dr, const GlaPre& p, LAS float* gsc, LAS float* tot, float (&bv)[16]) {
    const int c = F.tid & 127, tq = F.tid >> 7;
    if (F.tid < 256) *(LAS f32x4*)(gsc + (F.tid >> 2) * 16 + 4 * (F.tid & 3)) = p.gs;
    LDS_BAR();
    float gl[16];
#pragma unroll
    for (int tt = 0; tt < 16; ++tt) {
        const LAS f32x4* gr = (const LAS f32x4*)(gsc + (16 * tq + tt) * 16);
        float z = p.bias;
#pragma unroll
        for (int r4 = 0; r4 < 4; ++r4) { const f32x4 gv = gr[r4]; z += gv.x * p.up[4 * r4] + gv.y * p.up[4 * r4 + 1] + gv.z * p.up[4 * r4 + 2] + gv.w * p.up[4 * r4 + 3]; }
        gl[tt] = (fminf(z, 0.f) - __logf(1.f + __expf(-fabsf(z)))) * (1.f / 16.f);
    }
    float run = 0.f;
    if (dr == 0) {
#pragma unroll
        for (int tt = 0; tt < 16; ++tt) { run += gl[tt]; bv[tt] = run; }
    } else {
#pragma unroll
        for (int tt = 15; tt >= 0; --tt) { run += gl[tt]; bv[tt] = run; }
    }
    tot[tq * 128 + c] = run;
    LDS_BAR();
    const float t0 = tot[c], t1 = tot[128 + c], t2 = tot[256 + c], t3 = tot[384 + c];
    float off;
    if (dr == 0) off = (tq > 0 ? t0 : 0.f) + (tq > 1 ? t1 : 0.f) + (tq > 2 ? t2 : 0.f);
    else off = (tq < 1 ? t1 : 0.f) + (tq < 2 ? t2 : 0.f) + (tq < 3 ? t3 : 0.f);
#pragma unroll
    for (int tt = 0; tt < 16; ++tt) bv[tt] += off;
    return (t0 + t1) + (t2 + t3);
}
DI void gla_vT_load(Frame& F, int rowbase, int h, unsigned short (&e)[32]) {
    const bf16_t* V = (const bf16_t*)(F.ws + WS_V);
    const int dv = F.tid & 255, half = F.tid >> 8;
#pragma unroll
    for (int j = 0; j < 32; ++j) e[j] = V[(size_t)(rowbase + 32 * half + j) * GVW + h * GDV + dv];
}
DI void gla_vT_store(Frame& F, const unsigned short (&e)[32], LAS bf16_t* vT) {
    const int dv = F.tid & 255, half = F.tid >> 8;
#pragma unroll
    for (int t8 = 0; t8 < 4; ++t8) {
        v4u w; w.x = e[8 * t8] | ((unsigned)e[8 * t8 + 1] << 16); w.y = e[8 * t8 + 2] | ((unsigned)e[8 * t8 + 3] << 16); w.z = e[8 * t8 + 4] | ((unsigned)e[8 * t8 + 5] << 16); w.w = e[8 * t8 + 6] | ((unsigned)e[8 * t8 + 7] << 16);
        *(LAS v4u*)(vT + dv * KST + 32 * half + 8 * t8) = w;
    }
}
DI void gla_state_item(Frame& F, int b, int h, int n) {
    LAS float* gsc = (LAS float*)F.lds; LAS float* tot = (LAS float*)(F.lds + 4096);
    LAS bf16_t* kdT = (LAS bf16_t*)(F.lds + 6144); LAS bf16_t* vT = (LAS bf16_t*)(F.lds + 24576);
    const int rowbase = chunk_rowbase(b, n);
    const bf16_t* KK = (const bf16_t*)(F.ws + WS_KK);
    bf16_t* GST = (bf16_t*)(F.ws + WS_GST); float* GDEC = (float*)(F.ws + WS_GDEC);
    const int c = F.tid & 127, tq = F.tid >> 7, lane = F.lane, l31 = lane & 31, hi = lane >> 5, w = F.wave;
    GlaPre pre[2]; unsigned short ve[32]; float kf[16];
    gla_pre_load(F, rowbase, h, 0, pre[0]); gla_pre_load(F, rowbase, h, 1, pre[1]);
#pragma unroll
    for (int tt = 0; tt < 16; ++tt) kf[tt] = bf2f(KK[(size_t)(rowbase + 16 * tq + tt) * GKW + h * GDK + c]);
    gla_vT_load(F, rowbase, h, ve);
    gla_vT_store(F, ve, vT);
#pragma unroll
    for (int dr = 0; dr < 2; ++dr) {
        float bv[16];
        const float blast = gla_decay(F, dr, pre[dr], gsc, tot, bv);
        const size_t sbase = (size_t)(((b * GH + h) * NCH + n) * 2 + dr);
        unsigned pk[8];
#pragma unroll
        for (int t2 = 0; t2 < 8; ++t2) pk[t2] = pk2(kf[2 * t2] * __expf(blast - bv[2 * t2]), kf[2 * t2 + 1] * __expf(blast - bv[2 * t2 + 1]));
        *(LAS v4u*)(kdT + c * KST + 16 * tq) = (v4u){pk[0], pk[1], pk[2], pk[3]};
        *(LAS v4u*)(kdT + c * KST + 16 * tq + 8) = (v4u){pk[4], pk[5], pk[6], pk[7]};
        if (tq == 0) GDEC[sbase * GDK + c] = __expf(blast);
        LDS_BAR();
        f32x16 acc[4];
#pragma unroll
        for (int j = 0; j < 4; ++j)
#pragma unroll
            for (int r = 0; r < 16; ++r) acc[j][r] = 0.f;
#pragma unroll
        for (int ks = 0; ks < 4; ++ks) {
            const bf16x8 a = *(const LAS bf16x8*)(vT + (32 * w + l31) * KST + 16 * ks + 8 * hi);
#pragma unroll
            for (int j = 0; j < 4; ++j) { const bf16x8 bb = *(const LAS bf16x8*)(kdT + (32 * j + l31) * KST + 16 * ks + 8 * hi); acc[j] = MFMA32(a, bb, acc[j]); }
        }
#pragma unroll
        for (int j = 0; j < 4; ++j)
#pragma unroll
            for (int r = 0; r < 16; ++r) GST[(sbase * GDV + 32 * w + crow32(r, hi)) * GDK + 32 * j + l31] = (bf16_t)f2bf(acc[j][r]);
        LDS_BAR();
    }
}
DI void gla_carry(Frame& F) {
    bf16_t* GST = (bf16_t*)(F.ws + WS_GST); const float* GDEC = (const float*)(F.ws + WS_GDEC);
    for (int chain = F.bid * 512 + F.tid; chain < NB * GH * 2 * GDV * 16; chain += F.G * 512) {
        const int k8 = chain & 15, dv = (chain >> 4) & 255, dr = (chain >> 12) & 1, h = (chain >> 13) & 3, b = chain >> 15;
        float S[8];
#pragma unroll
        for (int j = 0; j < 8; ++j) S[j] = 0.f;
        constexpr int PF = 4;
        v4u dsw[PF]; f32x4 d0[PF], d1[PF];
#define GC_LOAD(slot, step_) do { const int n_ = chunk_order(dr, (step_)); const size_t sb_ = (size_t)(((b * GH + h) * NCH + n_) * 2 + dr); \
            dsw[slot] = __builtin_nontemporal_load((const GAS v4u*)(GST + (sb_ * GDV + dv) * GDK + 8 * k8)); d0[slot] = *(const GAS f32x4*)(GDEC + sb_ * GDK + 8 * k8); d1[slot] = *(const GAS f32x4*)(GDEC + sb_ * GDK + 8 * k8 + 4); } while (0)
#pragma unroll
        for (int q = 0; q < PF; ++q) GC_LOAD(q, q);
#pragma unroll
        for (int step0 = 0; step0 < NCH; step0 += PF) {
#pragma unroll
            for (int q = 0; q < PF; ++q) {
                const int step = step0 + q;
                const int n = chunk_order(dr, step);
                const size_t sbase = (size_t)(((b * GH + h) * NCH + n) * 2 + dr);
                const v4u w = dsw[q]; const f32x4 e0d = d0[q], e1d = d1[q];
                *(GAS v4u*)(GST + (sbase * GDV + dv) * GDK + 8 * k8) = (v4u){pk2(S[0], S[1]), pk2(S[2], S[3]), pk2(S[4], S[5]), pk2(S[6], S[7])};
                if (step + PF < NCH) GC_LOAD(q, step + PF);
                f32x4 e0, e1; unpack8(w, e0, e1);
#pragma unroll
                for (int j = 0; j < 4; ++j) { S[j] = e0d[j] * S[j] + e0[j]; S[4 + j] = e1d[j] * S[4 + j] + e1[j]; }
            }
        }
#undef GC_LOAD
    }
}
DI void gla_out_item(Frame& F, int b, int h, int nl) {
    LAS float* gsc = (LAS float*)F.lds; LAS float* tot = (LAS float*)(F.lds + 4096);
    LAS bf16_t* qb = (LAS bf16_t*)(F.lds + 6144); LAS bf16_t* kb = (LAS bf16_t*)(F.lds + 23552);
    LAS bf16_t* vT = (LAS bf16_t*)(F.lds + 40960); LAS bf16_t* P = (LAS bf16_t*)(F.lds + 77824);
    LAS float* ot = (LAS float*)F.lds;
    const int n = nl + NCHC, rowbase = b * SEQ + nl * GCH;
    const bf16_t* KK = (const bf16_t*)(F.ws + WS_KK); const bf16_t* Q = (const bf16_t*)(F.ws + WS_Q);
    const bf16_t* GST = (const bf16_t*)(F.ws + WS_GST);
    const int c = F.tid & 127, tq = F.tid >> 7, lane = F.lane, l31 = lane & 31, hi = lane >> 5, w = F.wave;
    f32x16 oacc[2];
#pragma unroll
    for (int mi = 0; mi < 2; ++mi)
#pragma unroll
        for (int r = 0; r < 16; ++r) oacc[mi][r] = 0.f;
    GlaPre pre[2]; unsigned short ve[32]; float kf[16], qf[16]; bf16x8 sfr[2][8];
    gla_pre_load(F, rowbase, h, 0, pre[0]); gla_pre_load(F, rowbase, h, 1, pre[1]);
#pragma unroll
    for (int tt = 0; tt < 16; ++tt) { kf[tt] = bf2f(KK[(size_t)(rowbase + 16 * tq + tt) * GKW + h * GDK + c]); qf[tt] = bf2f(Q[(size_t)(rowbase + 16 * tq + tt) * GKW + h * GDK + c]); }
    gla_vT_load(F, rowbase, h, ve);
#pragma unroll
    for (int dr = 0; dr < 2; ++dr)
#pragma unroll
        for (int ks = 0; ks < 8; ++ks) sfr[dr][ks] = *(const GAS bf16x8*)(GST + (((size_t)(((b * GH + h) * NCH + n) * 2 + dr)) * GDV + 32 * w + l31) * GDK + 16 * ks + 8 * hi);
    v4u gov[4];
    { const size_t o_ = (size_t)(rowbase + (F.tid >> 3)) * GVW + h * GDV + 32 * (F.tid & 7); const bf16_t* GO_ = (const bf16_t*)(F.ws + WS_GO);
#pragma unroll
      for (int j2 = 0; j2 < 4; ++j2) gov[j2] = *(const GAS v4u*)(GO_ + o_ + 8 * j2); }
    gla_vT_store(F, ve, vT);
#pragma unroll
    for (int dr = 0; dr < 2; ++dr) {
        float bv[16];
        (void)gla_decay(F, dr, pre[dr], gsc, tot, bv);
#pragma unroll
        for (int tt = 0; tt < 16; ++tt) {
            const int tau = 16 * tq + tt;
            qb[tau * QST + c] = (bf16_t)f2bf(qf[tt] * __expf(bv[tt]));
            kb[tau * QST + c] = (bf16_t)f2bf(kf[tt] * __expf(-bv[tt]));
        }
        LDS_BAR();
        if (w < 4) {
            const int mi = w >> 1, nj = w & 1;
            f32x16 sc;
#pragma unroll
            for (int r = 0; r < 16; ++r) sc[r] = 0.f;
#pragma unroll
            for (int ks = 0; ks < 8; ++ks) {
                const bf16x8 a = *(const LAS bf16x8*)(qb + (32 * mi + l31) * QST + 16 * ks + 8 * hi);
                const bf16x8 bb = *(const LAS bf16x8*)(kb + (32 * nj + l31) * QST + 16 * ks + 8 * hi);
                sc = MFMA32(a, bb, sc);
            }
#pragma unroll
            for (int r = 0; r < 16; ++r) { const int i = 32 * mi + crow32(r, hi), j = 32 * nj + l31;
                const bool keep = dr ? (j > i) : (j <= i);
                P[i * KST + j] = (bf16_t)f2bf(keep ? sc[r] : 0.f); }
        } else {
        }
#pragma unroll
        for (int ks = 0; ks < 8; ++ks) {
#pragma unroll
            for (int mi = 0; mi < 2; ++mi) { const bf16x8 a = *(const LAS bf16x8*)(qb + (32 * mi + l31) * QST + 16 * ks + 8 * hi); oacc[mi] = MFMA32(a, sfr[dr][ks], oacc[mi]); }
        }
        LDS_BAR();
#pragma unroll
        for (int mi = 0; mi < 2; ++mi) {
#pragma unroll
            for (int ks = 0; ks < 4; ++ks) {
                const bf16x8 a = *(const LAS bf16x8*)(P + (32 * mi + l31) * KST + 16 * ks + 8 * hi);
                const bf16x8 bb = *(const LAS bf16x8*)(vT + (32 * w + l31) * KST + 16 * ks + 8 * hi);
                oacc[mi] = MFMA32(a, bb, oacc[mi]);
            }
        }
        LDS_BAR();
    }
#pragma unroll
    for (int mi = 0; mi < 2; ++mi)
#pragma unroll
        for (int r = 0; r < 16; ++r) ot[(32 * mi + crow32(r, hi)) * 260 + 32 * w + l31] = oacc[mi][r];
    LDS_BAR();
    {
        const int i = F.tid >> 3, seg = F.tid & 7;
        const LAS f32x4* orow = (const LAS f32x4*)(ot + i * 260 + 32 * seg);
        f32x4 v[8]; float ss = 0.f;
#pragma unroll
        for (int j = 0; j < 8; ++j) { v[j] = orow[j]; ss += (v[j].x * v[j].x + v[j].y * v[j].y) + (v[j].z * v[j].z + v[j].w * v[j].w); }
        ss += __shfl_xor(ss, 1); ss += __shfl_xor(ss, 2); ss += __shfl_xor(ss, 4);
        const float rstd = rsqrtf(ss * (1.f / GDV) + EPS);
        const size_t o = (size_t)(rowbase + i) * GVW + h * GDV + 32 * seg;
        unsigned char* OG = F.ws + WS_OG;
        const float* gnw = F.in[I_GNW] + 32 * seg; f32x4 wv[8];
#pragma unroll
        for (int j2 = 0; j2 < 8; ++j2) wv[j2] = *(const GAS f32x4*)(gnw + 4 * j2);
#pragma unroll
        for (int j2 = 0; j2 < 4; ++j2) {
            f32x4 g0, g1; unpack8(gov[j2], g0, g1);
            const f32x4 a0 = v[2 * j2] * rstd * wv[2 * j2] * g0, a1 = v[2 * j2 + 1] * rstd * wv[2 * j2 + 1] * g1;
            unsigned w0 = 0, w1 = 0;
            w0 = __builtin_amdgcn_cvt_pk_fp8_f32(a0.x, a0.y, w0, false); w0 = __builtin_amdgcn_cvt_pk_fp8_f32(a0.z, a0.w, w0, true);
            w1 = __builtin_amdgcn_cvt_pk_fp8_f32(a1.x, a1.y, w1, false); w1 = __builtin_amdgcn_cvt_pk_fp8_f32(a1.z, a1.w, w1, true);
            *(GAS v2u*)(OG + o + 8 * j2) = (v2u){w0, w1};
        }
    }
    LDS_BAR();
}

DI void p9_route(Frame& F) {
    const float* MOD = (const float*)(F.ws + WS_MOD);
    const bf16_t* X1 = (const bf16_t*)(F.ws + WS_X1);
    bf16_t* T2 = (bf16_t*)(F.ws + WS_T2);
    const bf16_t* RT = (const bf16_t*)(F.ws + WS_ROUT_T);
    unsigned* cnt = (unsigned*)(F.ws + WS_CTL) + CW_CNT;
    int* list = (int*)(F.ws + WS_ROUTE + ROUTE_LIST);
    int* eidx = (int*)(F.ws + WS_ROUTE + ROUTE_EIDX); int* slot = (int*)(F.ws + WS_ROUTE + ROUTE_SLOT); float* wts = (float*)(F.ws + WS_ROUTE + ROUTE_WTS);
    LAS float* lg = (LAS float*)(F.lds + 65536);
    LAS unsigned* hist = (LAS unsigned*)(F.lds + 65536 + 8192);
    LAS unsigned* hbase = hist + 64;
    LAS float* wcv = (LAS float*)(F.lds + 132096); LAS float* shv = wcv + 2048;
    const int lane = F.lane;
    for (int tile = F.bid; tile < T / 32; tile += F.G) {
        bf16x8 bfA[16][1]; skinny_bload<1>(bfA, RT, F.wave, lane);
        {
            v4u ra[4], rb[4];
            auto load = [&](v4u (&r)[4], int lr) { const bf16_t* xr = X1 + (size_t)(tile * 32 + lr) * D + 8 * lane;
#pragma unroll
                for (int j = 0; j < 4; ++j) r[j] = *(const GAS v4u*)(xr + 512 * j); };
            auto finish = [&](const v4u (&r)[4], int lr) { const int row = tile * 32 + lr;
                f32x4 v[8]; float ss = 0.f;
#pragma unroll
                for (int j = 0; j < 4; ++j) { unpack8(r[j], v[2 * j], v[2 * j + 1]);
                    ss += (v[2 * j].x * v[2 * j].x + v[2 * j].y * v[2 * j].y) + (v[2 * j].z * v[2 * j].z + v[2 * j].w * v[2 * j].w) + (v[2 * j + 1].x * v[2 * j + 1].x + v[2 * j + 1].y * v[2 * j + 1].y) + (v[2 * j + 1].z * v[2 * j + 1].z + v[2 * j + 1].w * v[2 * j + 1].w); }
                const float rstd = rsqrtf(wave_sum(ss) * (1.f / 2048.f) + EPS);
#pragma unroll
                for (int j = 0; j < 4; ++j) { const int col = 8 * lane + 512 * j;
                    f32x4 y[2];
#pragma unroll
                    for (int q = 0; q < 2; ++q) { const f32x4 wc = *(const LAS f32x4*)(wcv + col + 4 * q), a = *(const LAS f32x4*)(shv + col + 4 * q);
                        y[q] = (v[2 * j + q] * rstd) * wc + a; }
                    unsigned w0 = 0, w1 = 0;
                    w0 = __builtin_amdgcn_cvt_pk_fp8_f32(y[0].x, y[0].y, w0, false); w0 = __builtin_amdgcn_cvt_pk_fp8_f32(y[0].z, y[0].w, w0, true);
                    w1 = __builtin_amdgcn_cvt_pk_fp8_f32(y[1].x, y[1].y, w1, false); w1 = __builtin_amdgcn_cvt_pk_fp8_f32(y[1].z, y[1].w, w1, true);
                    *(GAS v2u*)((unsigned char*)T2 + (size_t)row * D + col) = (v2u){w0, w1};
                    *(LAS v4u*)((LAS bf16_t*)F.lds + lr * AST + col) = (v4u){pk2(y[0].x, y[0].y), pk2(y[0].z, y[0].w), pk2(y[1].x, y[1].y), pk2(y[1].z, y[1].w)}; } };
            const int lr0 = 4 * F.wave;
            load(ra, lr0);
            load(rb, lr0 + 1);
            {
                const float* mr = MOD + (size_t)((tile * 32) / SEQ) * (NMOD * D); const int c4 = 4 * F.tid;
                const f32x4 w = *(const GAS f32x4*)(F.in[I_N2W] + c4), a = *(const GAS f32x4*)(mr + 3 * D + c4), c = *(const GAS f32x4*)(mr + 4 * D + c4);
                *(LAS f32x4*)(wcv + c4) = w * (c + 1.0f); *(LAS f32x4*)(shv + c4) = a;
                __syncthreads();
            }
            finish(ra, lr0);
            load(ra, lr0 + 2); finish(rb, lr0 + 1);
            load(rb, lr0 + 3); finish(ra, lr0 + 2);
            finish(rb, lr0 + 3);
        }
        __syncthreads();
        f32x16 acc[2];
#pragma unroll
        for (int j = 0; j < 2; ++j)
#pragma unroll
            for (int r = 0; r < 16; ++r) acc[j][r] = 0.f;
        { f32x16 a0[1] = {acc[0]}, a1[1] = {acc[1]};
          skinny_gemm<1>(F.lds, bfA, a0, F.wave, lane);
          asm volatile("" ::: "memory");
          skinny_bload<1>(bfA, RT + (size_t)32 * 2048, F.wave, lane);
          skinny_gemm<1>(F.lds, bfA, a1, F.wave, lane);
          acc[0] = a0[0]; acc[1] = a1[0]; }
        __syncthreads();
        LAS float* red = (LAS float*)F.lds;
        skinny_store_partial<2>(red, acc, F.wave, lane);
        if (F.tid < 64) hist[F.tid] = 0u;
        __syncthreads();
        for (int o = F.tid; o < 32 * 64; o += 512) { float s = 0.f;
#pragma unroll
            for (int w = 0; w < 8; ++w) s += red[w * 2048 + o];
            lg[o] = s; }
        __syncthreads();
        int loc[4]; int rk[4]; float sw[4];
        const float rb = F.in[I_RB][lane];
#pragma unroll
        for (int rr = 0; rr < 4; ++rr) {
            const int lr = 4 * F.wave + rr;
            const float s = 1.0f / (1.0f + expf(-lg[lr * 64 + lane]));
            const float ch = s + rb;
            float m1 = ch; m1 = fmaxf(m1, __shfl_xor(m1, 1)); m1 = fmaxf(m1, __shfl_xor(m1, 2)); m1 = fmaxf(m1, __shfl_xor(m1, 4));
            const unsigned long long eq = __ballot(ch == m1);
            const int gshift = lane & ~7;
            const int first = __builtin_ctzll((eq >> gshift) & 0xffull) + gshift;
            float m2 = (lane == first) ? -INFINITY : ch; m2 = fmaxf(m2, __shfl_xor(m2, 1)); m2 = fmaxf(m2, __shfl_xor(m2, 2)); m2 = fmaxf(m2, __shfl_xor(m2, 4));
            const float gs = m1 + m2; const int mygrp = lane >> 3;
            int grank = 0;
#pragma unroll
            for (int gg = 0; gg < 8; ++gg) { const float og = __int_as_float(__builtin_amdgcn_readlane(__float_as_int(gs), gg * 8)); grank += (og > gs || (og == gs && gg < mygrp)) ? 1 : 0; }
            const float cm = (grank < TOPKG) ? ch : -INFINITY;
            int erank = 0;
#pragma unroll
            for (int e2 = 0; e2 < 64; ++e2) { const float oc = __int_as_float(__builtin_amdgcn_readlane(__float_as_int(cm), e2)); erank += (oc > cm || (oc == cm && e2 < lane)) ? 1 : 0; }
            const bool sel = erank < TOPK;
            const float ssum = wave_sum(sel ? s : 0.f);
            rk[rr] = sel ? erank : -1;
            sw[rr] = s / ssum * 2.5f;
            loc[rr] = sel ? (int)__hip_atomic_fetch_add(&hist[lane], 1u, __ATOMIC_RELAXED, __HIP_MEMORY_SCOPE_WORKGROUP) : 0;
        }
        __syncthreads();
        if (F.tid < 64) hbase[F.tid] = atomicAdd(&cnt[16 * F.tid], hist[F.tid]);
        __syncthreads();
#pragma unroll
        for (int rr = 0; rr < 4; ++rr) {
            const int row = tile * 32 + 4 * F.wave + rr;
            if (rk[rr] >= 0) {
                const int pos = (int)hbase[lane] + loc[rr];
                list[(size_t)lane * T + pos] = row;
                eidx[row * 8 + rk[rr]] = lane; slot[row * 8 + rk[rr]] = pos; wts[row * 8 + rk[rr]] = sw[rr];
            }
            if (lane == 0) list[(size_t)64 * T + row] = row;
        }
        __syncthreads();
    }
}

DI void p12_combine(Frame& F, volatile LAS int* tbv) {
    const float* MOD = (const float*)(F.ws + WS_MOD);
    const bf16_t* X1 = (const bf16_t*)(F.ws + WS_X1);
    const unsigned char* YB8 = F.ws + WS_YBUF;
    const int* eidx = (const int*)(F.ws + WS_ROUTE + ROUTE_EIDX); const int* slot = (const int*)(F.ws + WS_ROUTE + ROUTE_SLOT); const float* wts = (const float*)(F.ws + WS_ROUTE + ROUTE_WTS);
    const float* fnw = F.in[I_FNW];
    const int lane = F.lane;
    const LAS int* tb = (const LAS int*)tbv;
    f32x4 fw[8];
#pragma unroll
    for (int j = 0; j < 4; ++j) { fw[2 * j] = *(const GAS f32x4*)(fnw + 8 * lane + 512 * j); fw[2 * j + 1] = *(const GAS f32x4*)(fnw + 8 * lane + 512 * j + 4); }
    const int hbsh = tb[MT_HB + 64];
    for (int row = F.bid * 8 + F.wave; row < T; row += F.G * 8) {
        const float* g2 = MOD + (size_t)(row / SEQ) * (NMOD * D) + 5 * D;
        int e = 64, sl = row; float w = 1.f;
        if (lane < 8) { e = eidx[row * 8 + lane]; sl = slot[row * 8 + lane]; w = wts[row * 8 + lane]; }
        const int yrow = tb[MT_HB + e] + sl;
        unsigned ro[9]; float wk[9];
#pragma unroll
        for (int k = 0; k < 9; ++k) { ro[k] = (unsigned)__builtin_amdgcn_readlane(yrow, k); wk[k] = __builtin_bit_cast(float, __builtin_amdgcn_readlane(__builtin_bit_cast(int, w), k)); }
        f32x4 x2[8]; float ss = 0.f;
#pragma unroll
        for (int jp = 0; jp < 2; ++jp) {
            v2u y[2][9]; v4u xw[2]; f32x4 xa[2], xb[2], ga[2], gb[2];
#pragma unroll
            for (int jj = 0; jj < 2; ++jj) {
                const int col = 8 * lane + 512 * (2 * jp + jj);
#pragma unroll
                for (int k = 0; k < 9; ++k) y[jj][k] = __builtin_nontemporal_load((const GAS v2u*)(YB8 + (size_t)ro[k] * D + col));
                xw[jj] = *(const GAS v4u*)(X1 + (size_t)row * D + col);
                ga[jj] = *(const GAS f32x4*)(g2 + col); gb[jj] = *(const GAS f32x4*)(g2 + col + 4);
            }
#pragma unroll
            for (int jj = 0; jj < 2; ++jj) {
                const int j = 2 * jp + jj;
                unpack8(xw[jj], xa[jj], xb[jj]);
                f32x4 a0 = (f32x4){0.f, 0.f, 0.f, 0.f}, a1 = a0;
#pragma unroll
                for (int k = 0; k < 9; ++k) {
                    const f32x2 p0 = __builtin_amdgcn_cvt_pk_f32_fp8(y[jj][k].x, false), p1 = __builtin_amdgcn_cvt_pk_f32_fp8(y[jj][k].x, true);
                    const f32x2 p2 = __builtin_amdgcn_cvt_pk_f32_fp8(y[jj][k].y, false), p3 = __builtin_amdgcn_cvt_pk_f32_fp8(y[jj][k].y, true);
                    a0 += (f32x4){p0.x, p0.y, p1.x, p1.y} * wk[k]; a1 += (f32x4){p2.x, p2.y, p3.x, p3.y} * wk[k]; }
                x2[2 * j] = xa[jj] + ga[jj] * a0; x2[2 * j + 1] = xb[jj] + gb[jj] * a1;
                ss += (x2[2 * j].x * x2[2 * j].x + x2[2 * j].y * x2[2 * j].y) + (x2[2 * j].z * x2[2 * j].z + x2[2 * j].w * x2[2 * j].w);
                ss += (x2[2 * j + 1].x * x2[2 * j + 1].x + x2[2 * j + 1].y * x2[2 * j + 1].y) + (x2[2 * j + 1].z * x2[2 * j + 1].z + x2[2 * j + 1].w * x2[2 * j + 1].w);
            }
            asm volatile("" ::: "memory");
        }
        const float rstd = rsqrtf(wave_sum(ss) * (1.f / D) + EPS);
#pragma unroll
        for (int j = 0; j < 4; ++j) {
            const int col = 8 * lane + 512 * j;
            __builtin_nontemporal_store(x2[2 * j] * rstd * fw[2 * j], (GAS f32x4*)(F.out + (size_t)row * D + col));
            __builtin_nontemporal_store(x2[2 * j + 1] * rstd * fw[2 * j + 1], (GAS f32x4*)(F.out + (size_t)row * D + col + 4));
        }
    }
}

constexpr int NPHASE = 13;
__global__ void __launch_bounds__(512, 2) hyb_fwd(Args args) {
    extern __shared__ __attribute__((aligned(16))) unsigned char lds[];
    Frame F;
    F.lds = (LAS unsigned char*)lds; F.ws = args.ws; F.in = args.in; F.out = args.out;
    F.tid = threadIdx.x; F.lane = F.tid & 63; F.wave = __builtin_amdgcn_readfirstlane(F.tid >> 6); F.G = gridDim.x; F.bid = blockIdx.x;
    volatile LAS unsigned* MISC = (volatile LAS unsigned*)(F.lds + MISC_OFF);
    volatile LAS int* mtb = (volatile LAS int*)(F.lds + MISC_OFF + 256);
    for (int u = F.tid; u < (LDS_BYTES - MISC_OFF) / 4; u += 512) MISC[u] = 0u;
    __syncthreads();
    unsigned char* ws = args.ws;
    unsigned* ctl = (unsigned*)(ws + WS_CTL);
    const int lo = args.ph_lo, hi = args.ph_hi;
    const bool multi = (hi - lo) > 1;
    XcdBarrier bar; bar.bar = ctl + CW_BAR; bar.x = 0; bar.st = nullptr;
    if (multi) bar = xcd_barrier_post(ctl + CW_BAR, MISC + 8);
#ifndef PHMASK
#define PHMASK 0x1fff
#endif
#define IN(k) ((((PHMASK) >> (k)) & 1) && lo <= (k) && (k) < hi)
#define SEAM(k) do { if (IN(k) && IN((k) + 1)) xcd_barrier(bar); } while (0)
#ifndef REPMASK
#define REPMASK 0
#endif
#ifndef REPPART
#define REPPART 3
#endif
#define REP(k) for (int rep_ = 0; rep_ < 1 + (((REPMASK) >> (k)) & 1); ++rep_, (rep_ < 1 + (((REPMASK) >> (k)) & 1) && multi) ? (xcd_barrier(bar), 0) : 0)

    if (IN(0)) REP(0) { p0_prologue(F); }
    SEAM(0);
    if (IN(1)) REP(1) { p1_norm1(F); }
    SEAM(1);
    if (IN(2)) REP(2) {
        if (F.bid & 1) p0_convert(F, 0, NP_EXPERT);
        { G1Order S{(const bf16_t*)(ws + WS_H), (const bf16_t*)(ws + WS_WIN_T), F.G, F.bid}; EpiG1 E{ws};
          pg8::gemm_phase<EpiG1, G1Order, false>(F.lds, D, S, E); }
        { G1Order8 S{ws + WS_H8, ws + WS_WIN8, F.G, F.bid}; EpiG1 E{ws};
          pg8::gemm_phase<EpiG1, G1Order8, false, 1>(F.lds, D, S, E); }
        if (!(F.bid & 1)) p0_convert(F, 0, NP_EXPERT);
    }
    SEAM(2);
    if (IN(3)) REP(3) {
        if (!rep_ || ((REPPART) & 1)) for (int it = F.bid; it < NB * GH * NCH; it += F.G) { const int n = it % NCH, h = (it / NCH) % GH, b = it / (NCH * GH); gla_state_item(F, b, h, n); }
        if (!rep_ || ((REPPART) & 2)) s5_phase<false>(F);
    }
    SEAM(3);
    if (IN(4)) REP(4) { s5_carry(F); gla_carry(F); }
    SEAM(4);
    if (IN(5)) REP(5) {
        if (!rep_ || ((REPPART) & 1)) for (int it = F.bid; it < NB * GH * NCHL; it += F.G) { const int nl = it % NCHL, h = (it / NCHL) % GH, b = it / (NCHL * GH); gla_out_item(F, b, h, nl); }
        if (!rep_ || ((REPPART) & 2)) s5_phase<true>(F);
    }
    SEAM(5);
    if (IN(6)) REP(6) {
        DenseOrder8 S{ws + WS_YS8, ws + WS_GLU_T, 32, 4, 1024, F.G, F.bid, true};
        EpiEw<0> E{(bf16_t*)(ws + WS_S5G), (const bf16_t*)(ws + WS_YS), 1024};
        pg8::gemm_phase<EpiEw<0>, DenseOrder8, false, 1>(F.lds, 1024, S, E);
    }
    SEAM(6);
    if (IN(7)) REP(7) {
        MergeOrder S{ws + WS_S5G, ws + WS_S5P_T, ws + WS_OG, ws + WS_GLAP_T, F.G, F.bid};
        EpiMerge64 E{(bf16_t*)(ws + WS_M), (const bf16_t*)(ws + WS_GS), (const bf16_t*)(ws + WS_GG), ws + WS_M8};
        pg8::gemm_phase<EpiMerge64, MergeOrder, false, 1, true, true, 0, true>(F.lds, 1024, S, E);
    }
    SEAM(7);
    if (IN(8)) REP(8) {
        DenseOrder8 S{ws + WS_M8, ws + WS_WOUT_T, 32, 8, 2048, F.G, F.bid, false};
        EpiOut E{F.in[I_X], (const float*)(ws + WS_MOD), (bf16_t*)(ws + WS_X1)};
        pg8::gemm_phase<EpiOut, DenseOrder8, false, 1>(F.lds, 2048, S, E);
    }
    SEAM(8);
    if (IN(9)) REP(9) { p9_route(F); }
    SEAM(9);
    if (IN(10)) REP(10) {
        moe_tables(F, mtb); moe_unit_list<4>(F, mtb);
        MoeOrder<4, 1> S{mtb, ws + WS_T2, ws + WS_WGU_T, (const int*)(ws + WS_ROUTE + ROUTE_LIST), 2048, F.G, F.bid};
        EpiGU E{ws + WS_HID};
        pg8::gemm_phase<EpiGU, MoeOrder<4, 1>, true, 1, true, true, 1024>(F.lds, 2048, S, E);
    }
    SEAM(10);
    if (IN(11)) REP(11) {
        moe_tables(F, mtb); moe_unit_list<8>(F, mtb);
        MoeOrder<8, 1> S{mtb, ws + WS_HID, ws + WS_WD_T, nullptr, 512, F.G, F.bid};
        EpiY8 E{ws + WS_YBUF, 2048};
        pg8::gemm_phase<EpiY8, MoeOrder<8, 1>, false, 1, true, true, 2048, true>(F.lds, 512, S, E);
    }
    SEAM(11);
    if (IN(12)) REP(12) { moe_tables(F, mtb); p12_combine(F, mtb); }
#undef IN
#undef SEAM
}

extern "C" void kernel_launch(void* const* d_in, const int* in_sizes, int n_in, void* d_out, int out_size, void* d_ws, size_t ws_size, hipStream_t stream) {
    static int grid = 0;
    if (grid == 0) {
        if (n_in != NIN || out_size != T * D || ws_size < WS_END) { fprintf(stderr, "kernel_launch: unexpected shapes (n_in %d out %d ws %zu need %zu)\n", n_in, out_size, ws_size, (size_t)WS_END); grid = -1; return; }
        int dev = 0, cus = 0, per_cu = 0;
        if (hipGetDevice(&dev) != hipSuccess || hipDeviceGetAttribute(&cus, hipDeviceAttributeMultiprocessorCount, dev) != hipSuccess) { grid = -1; return; }
        if (hipFuncSetAttribute((const void*)hyb_fwd, hipFuncAttributeMaxDynamicSharedMemorySize, LDS_BYTES) != hipSuccess) { fprintf(stderr, "kernel_launch: hipFuncSetAttribute failed\n"); grid = -1; return; }
        if (hipOccupancyMaxActiveBlocksPerMultiprocessor(&per_cu, (const void*)hyb_fwd, 512, LDS_BYTES) != hipSuccess || per_cu < 1) { fprintf(stderr, "kernel_launch: occupancy query says %d\n", per_cu); }
        (void)hipGetLastError();
        grid = cus & ~15;
    }
    if (grid < 0) return;
    (void)hipMemsetAsync((char*)d_ws + WS_CTL, 0, CTL_ZERO_BYTES, stream);
    Args a{};
    for (int i = 0; i < NIN; ++i) a.in[i] = (const float*)d_in[i];
    a.out = (float*)d_out; a.ws = (unsigned char*)d_ws;
#if MK_N_LAUNCHES == 1
    a.ph_lo = 0; a.ph_hi = NPHASE;
    hipLaunchKernelGGL(hyb_fwd, dim3(grid), dim3(512), LDS_BYTES, stream, a);
#else
    for (int p = 0; p < NPHASE; ++p) { a.ph_lo = p; a.ph_hi = p + 1; hipLaunchKernelGGL(hyb_fwd, dim3(grid), dim3(512), LDS_BYTES, stream, a); }
#endif
}
```

```cpp
#include <hip/hip_runtime.h>
#include <cstdio>
#include <cstdint>

#ifndef MK_N_LAUNCHES
#define MK_N_LAUNCHES 1
#endif

constexpr int D = 2048, NB = 4, SEQ = 2048, CTX = 256;
constexpr int T = NB * SEQ;
constexpr int TC = NB * CTX;
constexpr int TA = T + TC;
constexpr int NMOD = 6;
constexpr int S5W = 1024, S5G_ = 16, S5NG = 64, S5P = 64;
constexpr int GH = 4, GKW = 512, GVW = 1024, GDK = 128, GDV = 256, GRANK = 16, GCH = 64;
constexpr int INW = 8224;
constexpr int NE = 64, TOPK = 8, NGRP = 8, TOPKG = 4, DEXP = 512;
constexpr float EPS = 1e-6f;
constexpr int NCH = (SEQ + CTX) / GCH;
constexpr int NCHC = CTX / GCH;
constexpr int NCHL = SEQ / GCH;
constexpr int HIDROWS = 90112;

constexpr size_t MiB = 1u << 20;
constexpr size_t WS_CTL = 0, CTL_ZERO_BYTES = 65536;
constexpr size_t WS_MOD = 1 * MiB;
constexpr size_t WS_S5TAB = 2 * MiB;
constexpr size_t S5TAB_LAM = 0, S5TAB_LAM64 = 65536, S5TAB_BT = 131072, S5TAB_CT = 131072 + 524288;
constexpr size_t WS_ROUT_T = 4 * MiB;
constexpr size_t WS_ROUTE = 5 * MiB;
constexpr size_t ROUTE_LIST = 0, ROUTE_EIDX = 3 * MiB, ROUTE_SLOT = 3 * MiB + 262144, ROUTE_WTS = 3 * MiB + 524288;
constexpr size_t WS_WGU_T = 9 * MiB;
constexpr size_t WS_WD_T = 269 * MiB;
constexpr size_t WS_X1 = 399 * MiB;
constexpr size_t WS_AB = 463 * MiB;
constexpr size_t WS_WIN_T = WS_AB + 0 * MiB;
constexpr size_t WS_WGKD_T = WS_AB + 32 * MiB;
constexpr size_t WS_GLU_T = WS_AB + 33 * MiB;
constexpr size_t WS_S5P_T = WS_AB + 35 * MiB;
constexpr size_t WS_GLAP_T = WS_AB + 39 * MiB;
constexpr size_t WS_WOUT_T = WS_AB + 43 * MiB;
constexpr size_t WS_H = WS_AB + 51 * MiB;
constexpr size_t WS_GKD = WS_AB + 87 * MiB;
constexpr size_t WS_U = WS_AB + 89 * MiB;
constexpr size_t WS_KK = WS_AB + 107 * MiB;
constexpr size_t WS_V = WS_AB + 116 * MiB;
constexpr size_t WS_Q = WS_AB + 134 * MiB;
constexpr size_t WS_GO = WS_AB + 142 * MiB;
constexpr size_t WS_GS = WS_AB + 158 * MiB;
constexpr size_t WS_GG = WS_AB + 190 * MiB;
constexpr size_t WS_S5ST = WS_AB + 222 * MiB;
constexpr size_t WS_GST = WS_AB + 232 * MiB;
constexpr size_t WS_GDEC = WS_AB + 304 * MiB;
constexpr size_t WS_YS = WS_AB + 305 * MiB;
constexpr size_t WS_OG = WS_AB + 321 * MiB;
constexpr size_t WS_YS8 = WS_AB + 329 * MiB;
constexpr size_t WS_S5G = WS_AB + 337 * MiB;
constexpr size_t WS_M = WS_AB + 353 * MiB;
constexpr size_t WS_M8 = WS_AB + 410 * MiB;
constexpr size_t WS_A_END = WS_AB + 385 * MiB;
constexpr size_t WS_T2 = WS_AB + 0 * MiB;
constexpr size_t WS_HID = WS_AB + 32 * MiB;
constexpr size_t WS_YBUF = WS_AB + 120 * MiB;
constexpr size_t WS_WIN8 = WS_WIN_T + 16 * MiB;
constexpr size_t WS_H8 = WS_AB + 390 * MiB;
constexpr size_t WS_END = WS_AB + 472 * MiB;
static_assert(WS_A_END <= WS_END, "ws map");

constexpr int CW_TMO = 0, CW_CODE = 1;
constexpr int CW_BAR = 4096;
constexpr int CW_CNT = 8192;

constexpr int SCR_BYTES = 155648;
constexpr int MISC_OFF = SCR_BYTES;
constexpr int LDS_BYTES = 163840;

#define GAS __attribute__((address_space(1)))
#define LAS __attribute__((address_space(3)))
typedef unsigned short bf16_t;
typedef unsigned v4u __attribute__((ext_vector_type(4)));
typedef unsigned v2u __attribute__((ext_vector_type(2)));
typedef float f32x2 __attribute__((ext_vector_type(2)));
typedef float f32x4 __attribute__((ext_vector_type(4)));
typedef float f32x16 __attribute__((ext_vector_type(16)));
typedef short bf16x8 __attribute__((ext_vector_type(8)));
typedef GAS unsigned gu32;

#define DI __device__ __forceinline__
#define LDS_WAIT() asm volatile("s_waitcnt lgkmcnt(0)" ::: "memory")
#define LDS_BAR() do { asm volatile("s_waitcnt lgkmcnt(0)" ::: "memory"); __builtin_amdgcn_s_barrier(); asm volatile("" ::: "memory"); } while (0)
#define VM_WAIT() asm volatile("s_waitcnt vmcnt(0)" ::: "memory")
#define RLX_AGENT __ATOMIC_RELAXED, __HIP_MEMORY_SCOPE_AGENT

typedef __bf16 bf16x2_hw __attribute__((ext_vector_type(2)));
DI unsigned pk2(float lo, float hi) { const f32x2 v = {lo, hi}; return __builtin_bit_cast(unsigned, __builtin_convertvector(v, bf16x2_hw)); }
DI unsigned f2bf(float f) { return pk2(f, 0.f) & 0xffffu; }
DI float bflo(unsigned w) { return __builtin_bit_cast(float, w << 16); }
DI float bfhi(unsigned w) { return __builtin_bit_cast(float, w & 0xffff0000u); }
DI float bf2f(bf16_t b) { return __builtin_bit_cast(float, ((unsigned)b) << 16); }
DI float sigmoidf_(float x) { return __builtin_amdgcn_rcpf(1.0f + __expf(-x)); }
DI float siluf_(float x) { return x * sigmoidf_(x); }
DI float wave_sum(float v) {
#pragma unroll
    for (int o = 1; o < 64; o <<= 1) v += __shfl_xor(v, o);
    return v;
}
DI int crow32(int r, int hi) { return (r & 3) + 8 * (r >> 2) + 4 * hi; }
#define MFMA32(a, b, c) __builtin_amdgcn_mfma_f32_32x32x16_bf16((a), (b), (c), 0, 0, 0)
#define MFMA16(a, b, c) __builtin_amdgcn_mfma_f32_16x16x32_bf16((a), (b), (c), 0, 0, 0)

namespace pg8 {
constexpr int BM = 256, BK = 64, HALF = 128, HTB = HALF * BK * 2, STAGE_BYTES = 8 * HTB;
DI int lds_byte(int r, int c) { const int st = (r >> 4) * 2 + (c >> 5), rr = r & 15, cc = c & 31, ob = rr * 64 + cc * 2; return st * 1024 + (ob ^ (((ob >> 9) & 1) << 5)); }
DI void stage_rc(int b, int& R, int& C) { const int st = b / 1024, sb = b % 1024, swz = sb ^ (((sb >> 9) & 1) << 5); R = (st >> 1) * 16 + swz / 64; C = (st & 1) * 32 + (swz % 64) / 2; }
DI int perm32(int rho) { const int n = rho >> 4, i = rho & 15; return 8 * (i >> 2) + 4 * n + (i & 3); }
DI unsigned cvt_pk_bf16(float lo, float hi) { unsigned r; asm volatile("v_cvt_pk_bf16_f32 %0, %1, %2" : "=v"(r) : "v"(lo), "v"(hi)); return r; }

typedef short v8i __attribute__((ext_vector_type(16)));
DI v8i ld32(const LAS unsigned char* p) { const bf16x8 lo = *(const LAS bf16x8*)p, hi = *(const LAS bf16x8*)(p + 16); return __builtin_shufflevector(lo, hi, 0, 1, 2, 3, 4, 5, 6, 7, 8, 9, 10, 11, 12, 13, 14, 15); }
constexpr int FP8_WSHIFT = 5;
constexpr int FP8_SCALE_W = 0x01010101 * (127 - FP8_WSHIFT);
constexpr int FP8_SCALE_A = 0x7f7f7f7f;
struct Unit {
    const char* a;
    const char* b;
    const int* idx;
    int nvalid;
    int pm, pn, e;
    int cb;
    int flags;
};

template <class Epi, class Sched, bool GATHER, int ES = 2, bool ALIGN_EPI = true, bool SP2 = true, int BKT = 0, bool P64 = false>
DI void gemm_phase(LAS unsigned char* lds, const int K, const Sched& S, const Epi& E) {
    const int tid = threadIdx.x, wid = __builtin_amdgcn_readfirstlane(tid >> 6), lane = tid & 63, wr = wid >> 2, wc = wid & 3, fr = lane & 15, fq = lane >> 4;
    const int nt = (K * ES) / 128;
    int Rr[2], Cc[2];
    unsigned voffB[2], vc[2][2], vn[2][2];
#pragma unroll
    for (int i = 0; i < 2; ++i) { int R, C; stage_rc(tid * 16 + i * 8192, R, C); const int Rb = P64 ? (2 * (R & ~31) + perm32(R & 31)) : (Epi::PERM ? ((R & ~31) + perm32(R & 31)) : R);
        Rr[i] = R; Cc[i] = C; voffB[i] = BKT ? ((unsigned)Rb * 128u + (unsigned)C * 2u) : ((unsigned)(Rb * K) * (unsigned)ES + (unsigned)C * 2u);
#pragma unroll
        for (int h = 0; h < 2; ++h) { vc[h][i] = (unsigned)((h * HALF + R) * K) * (unsigned)ES + (unsigned)C * 2u; vn[h][i] = vc[h][i]; } }
    const size_t kstep = (size_t)(BK * 2);
    const size_t hstep = (size_t)HALF * K * ES;
    const size_t kstepB = BKT ? (size_t)BKT * 128 : kstep, hstepB = (size_t)(P64 ? 32 : HALF) * (BKT ? (size_t)128 : (size_t)K * ES);
    const unsigned ldsw = (unsigned)wid * 1024u;
    const int aoff = lds_byte(wr * 64 + fr, (ES == 2 ? 8 : 16) * fq), boff = lds_byte(wc * 32 + fr, (ES == 2 ? 8 : 16) * fq);
#define PG8_SA(b, h) (((b) * 2 + (h)) * HTB)
#define PG8_SB(b, h) ((4 + (b) * 2 + (h)) * HTB)
#define PG8_STAGE_B(bufoff, gbase) do { _Pragma("unroll") for (int _i = 0; _i < 2; ++_i) \
        __builtin_amdgcn_global_load_lds((const unsigned*)((const char*)(gbase) + voffB[_i]), (LAS unsigned*)(lds + (bufoff) + ldsw + _i * 8192), 16, 0, 0); } while (0)
#define PG8_STAGE_A(bufoff, gbase, h, usen) do { _Pragma("unroll") for (int _i = 0; _i < 2; ++_i) \
        __builtin_amdgcn_global_load_lds((const unsigned*)((const char*)(gbase) + ((usen) ? vn[h][_i] : vc[h][_i])), (LAS unsigned*)(lds + (bufoff) + ldsw + _i * 8192), 16, 0, 0); } while (0)
#define PG8_LDA(dst, b, h) do { if constexpr (ES == 2) { _Pragma("unroll") for (int m = 0; m < 4; ++m) _Pragma("unroll") for (int k = 0; k < 2; ++k) dst[m][k] = *(const LAS bf16x8*)(lds + PG8_SA(b, h) + aoff + m * 2048 + k * 1024); } \
        else { _Pragma("unroll") for (int m = 0; m < 4; ++m) dst##8[m] = ld32(lds + PG8_SA(b, h) + aoff + m * 2048); } } while (0)
#define PG8_LDB(dst, b, h) do { if constexpr (ES == 2) { _Pragma("unroll") for (int n = 0; n < 2; ++n) _Pragma("unroll") for (int k = 0; k < 2; ++k) dst[n][k] = *(const LAS bf16x8*)(lds + PG8_SB(b, h) + boff + n * 2048 + k * 1024); } \
        else { _Pragma("unroll") for (int n = 0; n < 2; ++n) dst##8[n] = ld32(lds + PG8_SB(b, h) + boff + n * 2048); } } while (0)
#define PG8_MMA(ai, bj, At, Bt) do { __builtin_amdgcn_s_setprio(1); _Pragma("unroll") for (int m = 0; m < 4; ++m) _Pragma("unroll") for (int n = 0; n < 2; ++n) { \
        if constexpr (ES == 2) { _Pragma("unroll") for (int k = 0; k < 2; ++k) acc[ai][bj][m][n] = __builtin_amdgcn_mfma_f32_16x16x32_bf16(Bt[n][k], At[m][k], acc[ai][bj][m][n], 0, 0, 0); } \
        else { asm volatile("v_mfma_scale_f32_16x16x128_f8f6f4 %0, %1, %2, %0, %3, %4 op_sel_hi:[0,0,0]" : "+v"(acc[ai][bj][m][n]) : "v"(Bt##8[n]), "v"(At##8[m]), "v"(sc_w), "v"(sc_a)); } } \
        __builtin_amdgcn_s_setprio(0); } while (0)
#define PG8_WAIT_V(n) asm volatile("s_waitcnt vmcnt(" #n ")" ::: "memory")
#define PG8_WAIT_L(n) asm volatile("s_waitcnt lgkmcnt(" #n ")" ::: "memory")
#define PG8_BAR __builtin_amdgcn_s_barrier()
#define PG8_SCHED __builtin_amdgcn_sched_barrier(0)
    Unit cur, nxt; int ui = 0;
    if (!S.next(0, cur)) return;
    f32x4 acc[2][2][4][2];
#pragma unroll
    for (int a = 0; a < 2; ++a)
#pragma unroll
        for (int b = 0; b < 2; ++b)
#pragma unroll
            for (int m = 0; m < 4; ++m)
#pragma unroll
                for (int n = 0; n < 2; ++n) acc[a][b][m][n] = (f32x4){0.f, 0.f, 0.f, 0.f};
    bf16x8 At[4][2], B0[2][2], B1[2][2];
    v8i At8[4], B08[2], B18[2];
    int sc_w = FP8_SCALE_W, sc_a = FP8_SCALE_A;
    asm volatile("" : "+v"(sc_w), "+v"(sc_a));
    const char* cA = cur.a; const char* cB = cur.b;
    if constexpr (GATHER) {
#pragma unroll
        for (int h = 0; h < 2; ++h)
#pragma unroll
            for (int i = 0; i < 2; ++i) { const int r = h * HALF + Rr[i]; const int row = (r < cur.nvalid) ? cur.idx[r] : 0; vc[h][i] = (unsigned)(row * K) * (unsigned)ES + (unsigned)Cc[i] * 2u; }
    }
    if constexpr (SP2) {
        PG8_STAGE_B(PG8_SB(0, 0), cB); PG8_STAGE_B(PG8_SB(0, 1), cB + hstepB); PG8_STAGE_A(PG8_SA(0, 0), cA, 0, false); PG8_STAGE_A(PG8_SA(0, 1), cA, 1, false);
        if (wr == 1) PG8_BAR;
        PG8_WAIT_V(2); PG8_BAR;
        PG8_STAGE_B(PG8_SB(1, 0), cB + kstepB); PG8_STAGE_A(PG8_SA(1, 0), cA + kstep, 0, false); PG8_STAGE_B(PG8_SB(1, 1), cB + hstepB + kstepB);
        PG8_WAIT_V(6); PG8_BAR;
    } else {
        PG8_STAGE_B(PG8_SB(0, 0), cB); PG8_STAGE_A(PG8_SA(0, 0), cA, 0, false); PG8_STAGE_B(PG8_SB(0, 1), cB + hstepB); PG8_STAGE_A(PG8_SA(0, 1), cA, 1, false);
        if (wr == 1) PG8_BAR;
        PG8_WAIT_V(4); PG8_BAR;
        PG8_STAGE_B(PG8_SB(1, 0), cB + kstepB); PG8_STAGE_A(PG8_SA(1, 0), cA + kstep, 0, false); PG8_STAGE_B(PG8_SB(1, 1), cB + hstepB + kstepB);
        PG8_WAIT_V(6); PG8_BAR;
    }
    for (;;) {
        const bool has_next = S.next(ui + 1, nxt);
        const int fl = cur.flags;
        const char* nA = has_next ? nxt.a : cA; const char* nB = has_next ? nxt.b : cB;
        if constexpr (GATHER) {
            if (has_next) { if (wid == 0) __builtin_amdgcn_global_load_lds((const unsigned*)(nxt.idx + 4 * lane), (LAS unsigned*)(lds + STAGE_BYTES + ((ui + 1) & 1) * 1024), 16, 0, 0); }
            else {
#pragma unroll
                for (int h = 0; h < 2; ++h)
#pragma unroll
                    for (int i = 0; i < 2; ++i) vn[h][i] = vc[h][i];
            }
        }
        for (int t = 0; t < nt; t += 2) {
            const bool last = (t == nt - 2);
            const char* a1 = cA + (size_t)(t + 1) * kstep;
            const char* a2 = last ? nA : cA + (size_t)(t + 2) * kstep; const char* b2 = last ? nB : cB + (size_t)(t + 2) * kstepB;
            const char* a3 = a2 + kstep; const char* b3 = b2 + kstepB;
            const bool un = GATHER && last;
            if constexpr (GATHER) { if (last && has_next) {
                const LAS int* ib = (const LAS int*)(lds + STAGE_BYTES + ((ui + 1) & 1) * 1024);
#pragma unroll
                for (int h = 0; h < 2; ++h)
#pragma unroll
                    for (int i = 0; i < 2; ++i) { const int r = h * HALF + Rr[i]; const int row = (r < nxt.nvalid) ? ib[r] : 0; vn[h][i] = (unsigned)(row * K) * (unsigned)ES + (unsigned)Cc[i] * 2u; } } }
            if constexpr (SP2) {
            PG8_LDB(B0, 0, 0); PG8_LDB(B1, 0, 1); PG8_SCHED; PG8_LDA(At, 0, 0); PG8_STAGE_A(PG8_SA(1, 1), a1, 1, false);
            PG8_WAIT_V(8); PG8_WAIT_L(0); PG8_BAR; PG8_MMA(0, 0, At, B0); if (!(fl & 2)) PG8_MMA(0, 1, At, B1); PG8_BAR; PG8_SCHED;
            PG8_LDA(At, 0, 1); PG8_STAGE_B(PG8_SB(0, 0), b2); PG8_STAGE_B(PG8_SB(0, 1), b2 + hstepB); PG8_STAGE_A(PG8_SA(0, 0), a2, 0, un);
            PG8_WAIT_V(8); PG8_WAIT_L(0); PG8_BAR; if (!(fl & 1)) { PG8_MMA(1, 0, At, B0); if (!(fl & 2)) PG8_MMA(1, 1, At, B1); } PG8_BAR; PG8_SCHED;
            PG8_LDB(B0, 1, 0); PG8_LDB(B1, 1, 1); PG8_SCHED; PG8_LDA(At, 1, 0); PG8_STAGE_A(PG8_SA(0, 1), a2, 1, un);
            PG8_WAIT_V(8); PG8_WAIT_L(0); PG8_BAR; PG8_MMA(0, 0, At, B0); if (!(fl & 2)) PG8_MMA(0, 1, At, B1); PG8_BAR; PG8_SCHED;
            PG8_LDA(At, 1, 1); PG8_STAGE_B(PG8_SB(1, 0), b3); PG8_STAGE_B(PG8_SB(1, 1), b3 + hstepB); PG8_STAGE_A(PG8_SA(1, 0), a3, 0, un);
            PG8_WAIT_V(8); PG8_WAIT_L(0); PG8_BAR; if (!(fl & 1)) { PG8_MMA(1, 0, At, B0); if (!(fl & 2)) PG8_MMA(1, 1, At, B1); } PG8_BAR; PG8_SCHED;
            } else {
            PG8_LDB(B0, 0, 0); PG8_SCHED; PG8_LDA(At, 0, 0); PG8_STAGE_A(PG8_SA(1, 1), a1, 1, false);
            PG8_WAIT_L(8); PG8_BAR; PG8_WAIT_L(0); PG8_MMA(0, 0, At, B0); PG8_BAR; PG8_SCHED;
            PG8_LDB(B1, 0, 1); PG8_STAGE_B(PG8_SB(0, 0), b2);
            PG8_BAR; PG8_WAIT_L(0); PG8_MMA(0, 1, At, B1); PG8_BAR;
            PG8_LDA(At, 0, 1); PG8_STAGE_A(PG8_SA(0, 0), a2, 0, un);
            PG8_BAR; PG8_WAIT_L(0); PG8_MMA(1, 0, At, B0); PG8_BAR; PG8_SCHED;
            PG8_STAGE_B(PG8_SB(0, 1), b2 + hstepB);
            PG8_WAIT_V(6); PG8_BAR; PG8_MMA(1, 1, At, B1); PG8_BAR;
            PG8_LDB(B0, 1, 0); PG8_SCHED; PG8_LDA(At, 1, 0); PG8_STAGE_A(PG8_SA(0, 1), a2, 1, un);
            PG8_WAIT_L(8); PG8_BAR; PG8_WAIT_L(0); PG8_MMA(0, 0, At, B0); PG8_BAR; PG8_SCHED;
            PG8_LDB(B1, 1, 1); PG8_STAGE_B(PG8_SB(1, 0), b3);
            PG8_BAR; PG8_WAIT_L(0); PG8_MMA(0, 1, At, B1); PG8_BAR;
            PG8_LDA(At, 1, 1); PG8_STAGE_A(PG8_SA(1, 0), a3, 0, un);
            PG8_BAR; PG8_WAIT_L(0); PG8_MMA(1, 0, At, B0); PG8_BAR; PG8_SCHED;
            PG8_STAGE_B(PG8_SB(1, 1), b3 + hstepB);
            PG8_WAIT_V(6); PG8_BAR; PG8_MMA(1, 1, At, B1); PG8_BAR;
            }
        }
        if constexpr (ALIGN_EPI) { if (wr == 0) PG8_BAR; }
        if constexpr (ES == 1) asm volatile("s_nop 15\n\ts_nop 15" ::: "memory");
        E(acc, cur, wr, wc, fr, fq);
        if (!has_next) break;
#pragma unroll
        for (int a = 0; a < 2; ++a)
#pragma unroll
            for (int b = 0; b < 2; ++b)
#pragma unroll
                for (int m = 0; m < 4; ++m)
#pragma unroll
                    for (int n = 0; n < 2; ++n) acc[a][b][m][n] = (f32x4){0.f, 0.f, 0.f, 0.f};
        cur = nxt; cA = nA; cB = nB; ++ui;
        if constexpr (GATHER) {
#pragma unroll
            for (int h = 0; h < 2; ++h)
#pragma unroll
                for (int i = 0; i < 2; ++i) vc[h][i] = vn[h][i];
        }
        if constexpr (ALIGN_EPI) { if (wr == 1) PG8_BAR; }
    }
    PG8_WAIT_V(0);
    if constexpr (!ALIGN_EPI) { if (wr == 0) PG8_BAR; }
    PG8_BAR;
#undef PG8_SA
#undef PG8_SB
#undef PG8_STAGE_A
#undef PG8_STAGE_B
#undef PG8_LDA
#undef PG8_LDB
#undef PG8_MMA
#undef PG8_WAIT_V
#undef PG8_WAIT_L
#undef PG8_BAR
#undef PG8_SCHED
}
}

#define XB_TMO      128
#define XB_XCNT(j)  (256  + 64 * (j))
#define XB_XSUB(j)  (1280 + 64 * (j))
#define XB_XGEN(j)  (2304 + 64 * (j))
#define XB_TOP      3328
#define XB_TOPGEN   3392
#define XCD_BAR_WORDS 3456
#define XB_SPIN_CAP (1u << 18)
DI unsigned xb_ld(unsigned* p)              { return __hip_atomic_load(p, __ATOMIC_RELAXED, __HIP_MEMORY_SCOPE_AGENT); }
DI unsigned xb_add(unsigned* p, unsigned v) { return __hip_atomic_fetch_add(p, v, __ATOMIC_RELAXED, __HIP_MEMORY_SCOPE_AGENT); }
DI unsigned xb_xcc_id() { return (unsigned)__builtin_amdgcn_s_getreg((3 << 11) | 20) & 0xFu; }
#define XB_SPIN(cond, bar) do { unsigned _sp = 0; while (cond) { __builtin_amdgcn_s_sleep(1); \
    if ((++_sp & 255u) == 0u) { if (xb_ld(&(bar)[XB_TMO])) break; if (_sp > XB_SPIN_CAP) { atomicAdd(&(bar)[XB_TMO], 1u); break; } } } } while (0)
struct XcdBarrier { unsigned* bar; unsigned x; volatile LAS unsigned* st; };
DI XcdBarrier xcd_barrier_post(unsigned* bar, volatile LAS unsigned* st) {
    XcdBarrier b; b.bar = bar; b.x = xb_xcc_id(); b.st = st;
    if (threadIdx.x == 0) (void)xb_add(&bar[XB_XCNT(b.x)], 1u);
    return b;
}
DI void xcd_barrier_complete(unsigned* bar, unsigned x, unsigned& nloc, unsigned& nx) {
    const unsigned G = gridDim.x * gridDim.y * gridDim.z;
    unsigned sum, cnt, mine, sp = 0u;
    for (;;) {
        sum = 0u; cnt = 0u; mine = 0u;
#pragma unroll
        for (unsigned j = 0; j < 16; ++j) { const unsigned c = xb_ld(&bar[XB_XCNT(j)]); sum += c; cnt += (c > 0u) ? 1u : 0u; mine = (j == x) ? c : mine; }
        if (sum == G) break;
        __builtin_amdgcn_s_sleep(1);
        if ((++sp & 255u) == 0u) { if (xb_ld(&bar[XB_TMO])) break; if (sp > XB_SPIN_CAP) { atomicAdd(&bar[XB_TMO], 1u); break; } }
    }
    nloc = mine > 0u ? mine : 1u; nx = cnt > 0u ? cnt : 1u;
}
DI void xcd_barrier(const XcdBarrier& b) {
    asm volatile("s_waitcnt vmcnt(0)" ::: "memory");
    __syncthreads();
    if (threadIdx.x == 0) {
        unsigned* bar = b.bar;
        __builtin_amdgcn_s_waitcnt(0);
        unsigned nloc = b.st[0], nx = b.st[1];
        if (nloc == 0u) { xcd_barrier_complete(bar, b.x, nloc, nx); b.st[0] = nloc; b.st[1] = nx; }
        const unsigned old = xb_add(&bar[XB_XSUB(b.x)], 1u);
        const unsigned gen = old / nloc;
        if (old + 1u == (gen + 1u) * nloc) {
            __builtin_amdgcn_fence(__ATOMIC_RELEASE, "agent");
            asm volatile("s_waitcnt vmcnt(0)" ::: "memory");
            const unsigned og = xb_add(&bar[XB_TOP], 1u);
            const unsigned tg = og / nx;
            if (og + 1u == (tg + 1u) * nx) xb_add(&bar[XB_TOPGEN], 1u);
            else XB_SPIN(xb_ld(&bar[XB_TOPGEN]) == tg, bar);
            __builtin_amdgcn_fence(__ATOMIC_ACQUIRE, "agent");
            xb_add(&bar[XB_XGEN(b.x)], 1u);
            asm volatile("s_waitcnt vmcnt(0)" ::: "memory");
        } else {
            XB_SPIN(xb_ld(&bar[XB_XGEN(b.x)]) == gen, bar);
            __builtin_amdgcn_fence(__ATOMIC_ACQUIRE, "agent");
            asm volatile("s_waitcnt vmcnt(0)" ::: "memory");
        }
    }
    __syncthreads();
}

constexpr int NIN = 33;
struct Args { const float* in[NIN]; float* out; unsigned char* ws; int ph_lo, ph_hi; };
struct Frame {
    LAS unsigned char* lds;
    unsigned char* ws;
    const float* const* in;
    float* out;
    int tid, lane, wave, G, bid;
};
enum InIdx { I_X = 0, I_C, I_CTX, I_CCTX, I_ADAW, I_ADAB, I_N1W, I_N2W, I_WIN, I_LAMRE, I_LAMIM, I_LOGDT, I_BRE, I_BIM, I_CRE, I_CIM, I_S5D, I_GLUW, I_GKUP, I_GKB, I_GNW,
             I_WS5P, I_WGLAP, I_WOUT, I_RW, I_RB, I_EWG, I_EWU, I_EWD, I_SWG, I_SWU, I_SWD, I_FNW };

struct TrItem { const float* src; bf16_t* dst; int ldw, ldt; int fp8; };
DI void tr_load(const TrItem& it, f32x4 (&v)[8], int lane) {
    const int kk = lane >> 3, n4 = lane & 7;
    const float* src = it.src + (size_t)kk * it.ldw + 4 * n4;
#pragma unroll
    for (int i = 0; i < 8; ++i) v[i] = *(const GAS f32x4*)(src + (size_t)(8 * i) * it.ldw);
}
DI void tr_finish(const TrItem& it, const f32x4 (&v)[8], LAS float* scr, int lane) {
    const int kk = lane >> 3, n4 = lane & 7;
#pragma unroll
    for (int i = 0; i < 8; ++i) { LAS float* d = scr + (8 * i + kk) * 33 + 4 * n4; d[0] = v[i].x; d[1] = v[i].y; d[2] = v[i].z; d[3] = v[i].w; }
    LDS_WAIT(); asm volatile("" ::: "memory");
    const int c = lane & 7;
    if (it.fp8) {
        unsigned char* dst8 = (unsigned char*)it.dst; const float sc = (float)(1 << pg8::FP8_WSHIFT);
#pragma unroll
        for (int j = 0; j < 4; ++j) { const int n = (lane >> 3) + 8 * j; const LAS float* s = scr + (8 * c) * 33 + n;
            unsigned w0 = 0, w1 = 0;
            w0 = __builtin_amdgcn_cvt_pk_fp8_f32(s[0 * 33] * sc, s[1 * 33] * sc, w0, false); w0 = __builtin_amdgcn_cvt_pk_fp8_f32(s[2 * 33] * sc, s[3 * 33] * sc, w0, true);
            w1 = __builtin_amdgcn_cvt_pk_fp8_f32(s[4 * 33] * sc, s[5 * 33] * sc, w1, false); w1 = __builtin_amdgcn_cvt_pk_fp8_f32(s[6 * 33] * sc, s[7 * 33] * sc, w1, true);
            *(GAS v2u*)(dst8 + (size_t)n * it.ldt + 8 * c) = (v2u){w0, w1}; }
    } else {
#pragma unroll
        for (int j = 0; j < 4; ++j) { const int n = (lane >> 3) + 8 * j; const LAS float* s = scr + (8 * c) * 33 + n;
            v4u o; o.x = pk2(s[0 * 33], s[1 * 33]); o.y = pk2(s[2 * 33], s[3 * 33]); o.z = pk2(s[4 * 33], s[5 * 33]); o.w = pk2(s[6 * 33], s[7 * 33]);
            *(GAS v4u*)(it.dst + (size_t)n * it.ldt + 8 * c) = o; }
    }
    LDS_WAIT(); asm volatile("" ::: "memory");
}
DI TrItem tr_make(const float* W, int ldw, int k0, int col0, bf16_t* WT, int ldt, int row0) { TrItem t; t.src = W + (size_t)k0 * ldw + col0; t.dst = WT + (size_t)row0 * ldt + k0; t.ldw = ldw; t.ldt = ldt; t.fp8 = 0; return t; }
DI TrItem tr_dense(const float* W, int ldw, int col0, int ncols, bf16_t* WT, int ldt, int row0, int it) {
    const int nblk = ncols / 32, kb = it / nblk, nb = it % nblk;
    return tr_make(W, ldw, 64 * kb, col0 + 32 * nb, WT, ldt, row0 + 32 * nb);
}
constexpr int NP_EXPERT = 65 * 2 * 32 + 65 * 32, NP_CONV_ALL = NP_EXPERT + 16 * 32 + (16 * 4 + 16 * 8 + 16 * 8 + 32 * 8) / 2;
DI void p0_convert(Frame& F, const int qbeg, const int qend) {
    const float* const* in = F.in;
    {
        __syncthreads();
        LAS float* img = (LAS float*)F.lds;
        LAS unsigned char* obuf = F.lds + 66560;
        int tid = F.tid; asm volatile("" : "+v"(tid));
        constexpr int NP_GU = 65 * 2 * 32, NP_DN = 65 * 32, NP_WIN = 16 * 32, NT_GLU = 16 * 4, NT_S5P = 16 * 8, NT_GLAP = 16 * 8, NT_WOUT = 32 * 8;
        constexpr int NP_ALL = NP_GU + NP_DN + NP_WIN + (NT_GLU + NT_S5P + NT_GLAP + NT_WOUT) / 2;
        static_assert(NP_GU + NP_DN == NP_EXPERT && NP_ALL == NP_CONV_ALL, "item counts");
        struct Tile { const float* src; unsigned char* dst; int ldw, ldt, fp8, gu; };
        auto make = [&](int q, const int half) -> Tile {
            Tile t; t.fp8 = 1; t.gu = 0; t.ldt = 128;
            if (q < NP_GU) {
                const int blk = q >> 5, ii = q & 31, e = blk >> 1, gu = blk & 1, kt = ii >> 1, nb = ii & 1, kb = 2 * kt + half;
                const float* W = (e < 64) ? ((gu ? in[I_EWU] : in[I_EWG]) + (size_t)e * 2048 * 512) : (gu ? in[I_SWU] : in[I_SWG]);
                t.src = W + (size_t)(64 * kb) * 512 + 256 * nb; t.ldw = 512; t.gu = 1;
                t.dst = F.ws + WS_WGU_T + (size_t)e * 1024 * 2048 + (size_t)kt * (1024 * 128) + (size_t)(512 * nb + 128 * gu) * 128; return t; }
            q -= NP_GU;
            if (q < NP_DN) { const int e = q >> 5, ii = q & 31, kt = ii >> 3, nb = ii & 7, kb = 2 * kt + half;
                const float* W = (e < 64) ? (in[I_EWD] + (size_t)e * 512 * 2048) : in[I_SWD];
                t.src = W + (size_t)(64 * kb) * 2048 + 256 * nb; t.ldw = 2048;
                t.dst = F.ws + WS_WD_T + (size_t)e * 2048 * 512 + (size_t)kt * (2048 * 128) + (size_t)(256 * nb) * 128; return t; }
            q -= NP_DN;
            if (q < NP_WIN) { const int kbp = q >> 5, nb = q & 31, drow = 256 * nb, kb = 2 * kbp + half; int scol;
                if (drow < 1024) scol = drow; else if (drow < 1536) scol = 1536 + (drow - 1024); else if (drow < 2560) scol = 2048 + (drow - 1536); else if (drow < 3072) scol = 1024 + (drow - 2560);
                else if (drow < 4096) scol = 3072 + (drow - 3072); else if (drow < 6144) scol = 4128 + (drow - 4096); else scol = 6176 + (drow - 6144);
                t.src = in[I_WIN] + (size_t)(64 * kb) * INW + scol; t.ldw = INW;
                if (nb == 4 || nb == 5 || nb == 10 || nb == 11) { t.fp8 = 0; t.ldt = 2048 * 2; t.dst = F.ws + WS_WIN_T + ((size_t)drow * 2048 + 64 * kb) * 2; }
                else { t.ldt = 2048; t.dst = F.ws + WS_WIN8 + (size_t)drow * 2048 + 128 * kbp; }
                return t; }
            q -= NP_WIN;
            if (q < NT_WOUT / 2) { const int kbp = q >> 3, nb = q & 7, kb = 2 * kbp + half;
                t.src = in[I_WOUT] + (size_t)(64 * kb) * 2048 + 256 * nb; t.ldw = 2048; t.ldt = 2048; t.dst = F.ws + WS_WOUT_T + (size_t)(256 * nb) * 2048 + 128 * kbp; return t; }
            q -= NT_WOUT / 2;
            if (q < NT_S5P / 2 + NT_GLAP / 2) { const int which = q >= NT_S5P / 2, qq = which ? q - NT_S5P / 2 : q, kbp = qq >> 3, nb = qq & 7, kb = 2 * kbp + half;
                t.src = (which ? in[I_WGLAP] : in[I_WS5P]) + (size_t)(64 * kb) * 2048 + 256 * nb; t.ldw = 2048; t.ldt = 1024; t.dst = F.ws + (which ? WS_GLAP_T : WS_S5P_T) + (size_t)(256 * nb) * 1024 + 128 * kbp; return t; }
            q -= NT_S5P / 2 + NT_GLAP / 2;
            { const int kbp = q >> 2, nb = q & 3, kb = 2 * kbp + half;
              t.src = in[I_GLUW] + (size_t)(64 * kb) * 1024 + 256 * nb; t.ldw = 1024; t.ldt = 1024; t.dst = F.ws + WS_GLU_T + (size_t)(256 * nb) * 1024 + 128 * kbp; return t; }
            return t;
        };
        f32x4 va[8], vb[8]; Tile ta, tb;
        auto issue = [&](f32x4 (&v)[8], const Tile& t) {
            const float* p_ = t.src + (size_t)(tid >> 6) * t.ldw + 4 * (tid & 63);
#pragma unroll
            for (int i = 0; i < 8; ++i) v[i] = __builtin_nontemporal_load((const GAS f32x4*)(p_ + (size_t)(8 * i) * t.ldw));
        };
#define CV_WAIT(v, n) do { } while (0)
        auto stage = [&](const f32x4 (&v)[8]) {
#pragma unroll
            for (int i = 0; i < 8; ++i) *(LAS f32x4*)(img + (8 * i + (tid >> 6)) * 260 + 4 * (tid & 63)) = v[i];
        };
        auto convert = [&](const Tile& cur, const int half) {
            const int n = tid & 255, kh = tid >> 8;
            const LAS float* sp = img + (32 * kh) * 260 + n;
            LAS unsigned char* orow = obuf + n * 128; const int sw = n & 7;
            if (cur.fp8) {
                const float sc = (float)(1 << pg8::FP8_WSHIFT);
                unsigned w[8];
#pragma unroll
                for (int q = 0; q < 8; ++q) { unsigned x = 0;
                    x = __builtin_amdgcn_cvt_pk_fp8_f32(sp[(4 * q) * 260] * sc, sp[(4 * q + 1) * 260] * sc, x, false);
                    x = __builtin_amdgcn_cvt_pk_fp8_f32(sp[(4 * q + 2) * 260] * sc, sp[(4 * q + 3) * 260] * sc, x, true); w[q] = x; }
                const int c0 = 4 * half + 2 * kh;
                *(LAS v4u*)(orow + (((c0) ^ sw) << 4)) = (v4u){w[0], w[1], w[2], w[3]}; *(LAS v4u*)(orow + (((c0 + 1) ^ sw) << 4)) = (v4u){w[4], w[5], w[6], w[7]};
            } else {
                unsigned w[16];
#pragma unroll
                for (int q = 0; q < 16; ++q) w[q] = pk2(sp[(2 * q) * 260], sp[(2 * q + 1) * 260]);
#pragma unroll
                for (int q4 = 0; q4 < 4; ++q4) *(LAS v4u*)(orow + (((4 * kh + q4) ^ sw) << 4)) = (v4u){w[4 * q4], w[4 * q4 + 1], w[4 * q4 + 2], w[4 * q4 + 3]};
            }
        };
        auto flush = [&](const Tile& cur) {
#pragma unroll
            for (int i = 0; i < 4; ++i) { const int p = i * 512 + tid, n = p >> 3, c = p & 7;
                const v4u x = *(const LAS v4u*)(obuf + n * 128 + ((c ^ (n & 7)) << 4));
                const int drow = cur.gu ? (256 * (n >> 7) + (n & 127)) : n;
                *(GAS v4u*)(cur.dst + (size_t)drow * cur.ldt + 16 * c) = x; }
        };
        int q = qbeg + F.bid;
        if (q < qend) { ta = make(q, 0); issue(va, ta); tb = make(q, 1); issue(vb, tb); CV_WAIT(va, 8); }
        while (q < qend) {
            const bool hn = q + F.G < qend;
            CV_WAIT(va, 12);
            stage(va);
            LDS_BAR();
            const Tile ca = ta;
            if (hn) { ta = make(q + F.G, 0); issue(va, ta); }
            convert(ca, 0);
            LDS_BAR();
            if (!ca.fp8) flush(ca);
            if (hn) CV_WAIT(vb, 8); else CV_WAIT(vb, 0);
            stage(vb);
            LDS_BAR();
            const Tile cb = tb;
            if (hn) { tb = make(q + F.G, 1); issue(vb, tb); }
            convert(cb, 1 & cb.fp8);
            LDS_BAR();
            flush(cb);
            q += F.G;
        }
#undef CV_WAIT
        LDS_BAR();
    }
}
constexpr int IT_GKD = 32 * 1, IT_RW = 32 * 2;
DI void p0_prologue(Frame& F) {
    const float* const* in = F.in;
    {
        LAS float* sv = (LAS float*)F.lds;
        LAS float* red = (LAS float*)(F.lds + 40960);
        for (int i = F.tid; i < 5 * 2048; i += 512) { const int r = i >> 11, k = i & 2047; const float c = (r < 4) ? in[I_C][r * 2048 + k] : in[I_CCTX][k]; sv[i] = siluf_(c); }
        __syncthreads();
        const int NCOLB = 48;
        for (int cb = F.bid; cb < (NMOD * D) / NCOLB; cb += F.G) {
            const int n0 = cb * NCOLB;
            const int c4 = F.tid % 12, kr = F.tid / 12;
            f32x4 acc[5];
#pragma unroll
            for (int r = 0; r < 5; ++r) acc[r] = (f32x4){0.f, 0.f, 0.f, 0.f};
            if (kr < 42) {
                const float* wp = in[I_ADAW] + n0 + 4 * c4;
#pragma unroll 1
                for (int j0 = 0; j0 < 48; j0 += 8) {
                    f32x4 w[8];
#pragma unroll
                    for (int j = 0; j < 8; ++j) w[j] = __builtin_nontemporal_load((const GAS f32x4*)(wp + (size_t)(kr + 42 * (j0 + j)) * (NMOD * D)));
#pragma unroll
                    for (int j = 0; j < 8; ++j)
#pragma unroll
                        for (int r = 0; r < 5; ++r) acc[r] += w[j] * sv[r * 2048 + kr + 42 * (j0 + j)];
                }
                if (kr < 32) { const int k = kr + 42 * 48; const f32x4 w = __builtin_nontemporal_load((const GAS f32x4*)(wp + (size_t)k * (NMOD * D)));
#pragma unroll
                    for (int r = 0; r < 5; ++r) acc[r] += w * sv[r * 2048 + k]; }
#pragma unroll
                for (int r = 0; r < 5; ++r) *(LAS f32x4*)(red + (kr * 5 + r) * 48 + 4 * c4) = acc[r];
            }
            __syncthreads();
            if (F.tid < 240) { const int r = F.tid / 48, n = F.tid % 48; float s = 0.f;
                for (int k = 0; k < 42; ++k) s += red[(k * 5 + r) * 48 + n];
                ((float*)(F.ws + WS_MOD))[r * (NMOD * D) + n0 + n] = s + in[I_ADAB][n0 + n]; }
            __syncthreads();
        }
    }
    {
        for (int gid = (F.tid < 32) ? (F.bid * 32 + F.tid) : (2 * S5NG * S5P); gid < 2 * S5NG * S5P; gid += F.G * 32) {
            const int dr = gid >> 12, g = (gid >> 6) & 63, p = gid & 63;
            const float lre = in[I_LAMRE][gid], lim = in[I_LAMIM][gid];
            const float dt = expf(in[I_LOGDT][dr * 64 + g]);
            const float mag = expf(lre * dt), ph = lim * dt;
            const float lbr = mag * cosf(ph), lbi = mag * sinf(ph);
            const float mag64 = expf(lre * dt * 64.f), ph64 = ph * 64.f;
            f32x2* lam = (f32x2*)(F.ws + WS_S5TAB + S5TAB_LAM); f32x2* lam64 = (f32x2*)(F.ws + WS_S5TAB + S5TAB_LAM64);
            lam[gid] = (f32x2){lbr, lbi};
            lam64[gid] = (f32x2){mag64 * cosf(ph64), mag64 * sinf(ph64)};
            const float nr = lbr - 1.f, ni = lbi, den = lre * lre + lim * lim;
            const float cr = (nr * lre + ni * lim) / den, ci = (ni * lre - nr * lim) / den;
            bf16_t* BT = (bf16_t*)(F.ws + WS_S5TAB + S5TAB_BT) + (size_t)(dr * 64 + g) * 128 * 16;
            bf16_t* CT = (bf16_t*)(F.ws + WS_S5TAB + S5TAB_CT) + (size_t)(dr * 64 + g) * 16 * 128;
            const float* bre = in[I_BRE] + (size_t)gid * 16; const float* bim = in[I_BIM] + (size_t)gid * 16;
#pragma unroll
            for (int h = 0; h < 16; ++h) {
                const float br = bre[h], bi = bim[h];
                BT[(64 * (p >> 5) + (p & 31)) * 16 + h] = (bf16_t)f2bf(cr * br - ci * bi);
                BT[(64 * (p >> 5) + 32 + (p & 31)) * 16 + h] = (bf16_t)f2bf(cr * bi + ci * br);
                const size_t ci_idx = ((size_t)(dr * 64 + g) * 16 + h) * 64 + p;
                CT[h * 128 + 2 * p] = (bf16_t)f2bf(in[I_CRE][ci_idx]);
                CT[h * 128 + 2 * p + 1] = (bf16_t)f2bf(-in[I_CIM][ci_idx]);
            }
        }
    }
    p0_convert(F, NP_EXPERT, NP_CONV_ALL);
    {
        {
            LAS float* scr = (LAS float*)(F.lds + F.wave * 16384);
            const int gw = F.bid * 8 + F.wave, NGW = F.G * 8;
            f32x4 va[8];
            for (int it = gw; it < IT_GKD + IT_RW; it += NGW) {
                const TrItem ti = (it < IT_GKD) ? tr_make(in[I_WIN], INW, 64 * it, 4096, (bf16_t*)(F.ws + WS_WGKD_T), 2048, 0) : tr_dense(in[I_RW], 64, 0, 64, (bf16_t*)(F.ws + WS_ROUT_T), 2048, 0, it - IT_GKD);
                tr_load(ti, va, F.lane); tr_finish(ti, va, scr, F.lane);
            }
        }
    }
}

constexpr int AST = 2056;
DI void norm_row_load(f32x4 (&v)[8], const float* xrow, int lane) {
    const GAS f32x4* xr = (const GAS f32x4*)xrow + lane;
#pragma unroll
    for (int j = 0; j < 8; ++j) v[j] = __builtin_nontemporal_load(xr + 64 * j);
}
template <int FP8OUT>
DI void norm_row_finish(const f32x4 (&v)[8], const float* nw, const float* sh, const float* sc, bf16_t* grow, LAS bf16_t* lrow, int lane, unsigned char* grow8 = nullptr) {
    float s = 0.f;
#pragma unroll
    for (int j = 0; j < 8; ++j) s += (v[j].x * v[j].x + v[j].y * v[j].y) + (v[j].z * v[j].z + v[j].w * v[j].w);
    const float rstd = rsqrtf(wave_sum(s) * (1.f / 2048.f) + EPS);
#pragma unroll
    for (int j = 0; j < 8; ++j) {
        const int i4 = lane + 64 * j;
        const f32x4 w = ((const GAS f32x4*)nw)[i4], a = ((const GAS f32x4*)sh)[i4], c = ((const GAS f32x4*)sc)[i4];
        const f32x4 y = (v[j] * rstd) * w * (c + 1.0f) + a;
        v2u o; o.x = pk2(y.x, y.y); o.y = pk2(y.z, y.w);
        if (FP8OUT) { unsigned w8 = 0; w8 = __builtin_amdgcn_cvt_pk_fp8_f32(y.x, y.y, w8, false); w8 = __builtin_amdgcn_cvt_pk_fp8_f32(y.z, y.w, w8, true); *(GAS unsigned*)((FP8OUT == 2 ? grow8 : (unsigned char*)grow) + 4 * i4) = w8; }
        if (FP8OUT != 1) *(GAS v2u*)(grow + 4 * i4) = o;
        *(LAS v2u*)(lrow + 4 * i4) = o;
    }
}
template <int NT32>
DI void skinny_bload(bf16x8 (&bf)[16][NT32], const bf16_t* Bt, int wave, int lane) {
#pragma unroll
    for (int ks = 0; ks < 16; ++ks)
#pragma unroll
        for (int j = 0; j < NT32; ++j) bf[ks][j] = *(const GAS bf16x8*)(Bt + (size_t)(32 * j + (lane & 31)) * 2048 + 256 * wave + 16 * ks + 8 * (lane >> 5));
}
template <int NT32>
DI void skinny_gemm(LAS unsigned char* tile, const bf16x8 (&bf)[16][NT32], f32x16 (&acc)[NT32], int wave, int lane, int row0 = 0, int rowmax = 31) {
    const int arow = (row0 + (lane & 31)) < rowmax ? (row0 + (lane & 31)) : rowmax;
#pragma unroll
    for (int ks = 0; ks < 16; ++ks) {
        const int k = 256 * wave + 16 * ks + 8 * (lane >> 5);
        const bf16x8 a = *(const LAS bf16x8*)(tile + arow * (AST * 2) + k * 2);
#pragma unroll
        for (int j = 0; j < NT32; ++j) acc[j] = MFMA32(a, bf[ks][j], acc[j]);
        if ((ks & 3) == 3) asm volatile("" ::: "memory");
    }
}
template <int NT32>
DI void skinny_store_partial(LAS float* red, const f32x16 (&acc)[NT32], int wave, int lane) {
#pragma unroll
    for (int j = 0; j < NT32; ++j)
#pragma unroll
        for (int r = 0; r < 16; ++r) red[(wave * 32 + crow32(r, lane >> 5)) * (32 * NT32) + 32 * j + (lane & 31)] = acc[j][r];
}

DI void p1_norm1(Frame& F) {
    const float* MOD = (const float*)(F.ws + WS_MOD);
    bf16_t* H = (bf16_t*)(F.ws + WS_H);
    float* GKD = (float*)(F.ws + WS_GKD);
    const bf16_t* WG = (const bf16_t*)(F.ws + WS_WGKD_T);
    const float* n1w = F.in[I_N1W];
    constexpr int RPT = 36;
    for (int tile = F.bid; tile < TA / RPT; tile += F.G) {
        const int nr = (F.wave < 4) ? 5 : 4, r0 = (F.wave < 4) ? 5 * F.wave : 20 + 4 * (F.wave - 4);
        {
            f32x4 va[8], vb[8];
            auto rowsrc = [&](int lr) -> const float* { const int row = tile * RPT + lr; return (row < T) ? (F.in[I_X] + (size_t)row * D) : (F.in[I_CTX] + (size_t)(row - T) * D); };
            auto finish = [&](const f32x4 (&v)[8], int lr) { const int row = tile * RPT + lr; const float* mr = MOD + (size_t)((row < T) ? (row / SEQ) : 4) * (NMOD * D);
                norm_row_finish<2>(v, n1w, mr, mr + D, H + (size_t)row * D, (LAS bf16_t*)F.lds + lr * AST, F.lane, F.ws + WS_H8 + (size_t)row * D); };
            norm_row_load(va, rowsrc(r0), F.lane);
            norm_row_load(vb, rowsrc(r0 + 1), F.lane); finish(va, r0);
            norm_row_load(va, rowsrc(r0 + 2), F.lane); finish(vb, r0 + 1);
            norm_row_load(vb, rowsrc(r0 + 3), F.lane); finish(va, r0 + 2);
            if (nr == 5) { norm_row_load(va, rowsrc(r0 + 4), F.lane); finish(vb, r0 + 3); finish(va, r0 + 4); }
            else finish(vb, r0 + 3);
        }
        bf16x8 bfr[16][1]; skinny_bload<1>(bfr, WG, F.wave, F.lane);
        __syncthreads();
        f32x16 acc0[1], acc1[1];
#pragma unroll
        for (int r = 0; r < 16; ++r) { acc0[0][r] = 0.f; acc1[0][r] = 0.f; }
        skinny_gemm<1>(F.lds, bfr, acc0, F.wave, F.lane, 0, 31);
        skinny_gemm<1>(F.lds, bfr, acc1, F.wave, F.lane, 32, RPT - 1);
        __syncthreads();
        LAS float* red = (LAS float*)F.lds;
        skinny_store_partial<1>(red, acc0, F.wave, F.lane);
        skinny_store_partial<1>(red + 8192, acc1, F.wave, F.lane);
        __syncthreads();
        for (int o = F.tid; o < RPT * 32; o += 512) { const int lr = o >> 5, n = o & 31; const LAS float* rp = red + (lr >> 5) * 8192 + (lr & 31) * 32 + n; float s = 0.f;
#pragma unroll
            for (int w = 0; w < 8; ++w) s += rp[w * 1024];
            GKD[(size_t)(tile * RPT + lr) * 32 + n] = s; }
        __syncthreads();
    }
}

DI bool static_tile(int L, int nM, int nN, int& pm, int& pn) {
    const int nwg = nM * nN; if (L >= nwg) return false;
    int wgid = L; { const int q = nwg / 8, r = nwg % 8, xcd = wgid % 8, off = wgid / 8; wgid = (xcd < r ? xcd * (q + 1) : r * (q + 1) + (xcd - r) * q) + off; }
    const int nig = 8 * nN, gid = wgid / nig, fm = gid * 8, gsz = (nM - fm) < 8 ? (nM - fm) : 8;
    pm = fm + ((wgid % nig) % gsz); pn = (wgid % nig) / gsz; return true;
}
struct DenseOrder {
    const bf16_t* A; const bf16_t* Bt; int nM, nN, K, G, c; bool halfn;
    DI bool next(int i, pg8::Unit& u) const {
        int pm, pn; const int L = i * G + c;
        if (!static_tile(halfn ? (L >> 1) : L, nM, nN, pm, pn)) return false;
        const int half = halfn ? (L & 1) : 0;
        u.a = (const char*)(A + (size_t)pm * 256 * K); u.b = (const char*)(Bt + ((size_t)pn * 256 + 128 * half) * K); u.idx = nullptr; u.nvalid = 256; u.pm = pm; u.pn = pn; u.e = 0;
        u.cb = 256 * pn + 128 * half; u.flags = halfn ? 2 : 0; return true;
    }
};
struct DenseOrder8 {
    const unsigned char* A; const unsigned char* Bt; int nM, nN, K, G, c; bool halfn;
    DI bool next(int i, pg8::Unit& u) const {
        int pm, pn; const int L = i * G + c;
        if (!static_tile(halfn ? (L >> 1) : L, nM, nN, pm, pn)) return false;
        const int half = halfn ? (L & 1) : 0;
        u.a = (const char*)(A + (size_t)pm * 256 * K); u.b = (const char*)(Bt + ((size_t)pn * 256 + 128 * half) * K); u.idx = nullptr; u.nvalid = 256; u.pm = pm; u.pn = pn; u.e = 0;
        u.cb = 256 * pn + 128 * half; u.flags = halfn ? 2 : 0; return true;
    }
};
struct G1Order {
    const bf16_t* A; const bf16_t* Bt; int G, c;
    DI bool next(int i, pg8::Unit& u) const {
        const int L = i * G + c; int pm, pn;
        if (L < 128) { int j; static_tile(L, 32, 4, pm, j); pn = (j < 2) ? 4 + j : 8 + j; }
        else if (L < 136) { const int j = L - 128; pm = 32 + (j & 3); pn = 4 + (j >> 2); }
        else return false;
        u.a = (const char*)(A + (size_t)pm * 256 * D); u.b = (const char*)(Bt + (size_t)pn * 256 * D); u.idx = nullptr; u.nvalid = 256; u.pm = pm; u.pn = pn; u.e = 0;
        u.cb = 256 * pn; u.flags = 0; return true;
    }
};
struct G1Order8 {
    const unsigned char* A; const unsigned char* Bt; int G, c;
    DI bool next(int i, pg8::Unit& u) const {
        int L;
        if (G == 256) {
            if (i < 3) L = i * 256 + c;
            else { const int cc = c - 136; if (cc < 0) return false;
                if (i == 3) { if (cc >= 120) return false; L = 768 + cc; } else if (i == 4) { if (cc >= 40) return false; L = 888 + cc; } else return false; }
        } else { L = i * G + c; if (L >= 928) return false; }
        int pm, pn;
        if (L < 896) { int j; static_tile(L, 32, 28, pm, j); pn = (j < 4) ? j : ((j < 8) ? j + 2 : j + 4); }
        else { const int jj = L - 896, q = jj >> 2; pm = 32 + (jj & 3); pn = (q < 4) ? q : q + 2; }
        u.a = (const char*)(A + (size_t)pm * 256 * D); u.b = (const char*)(Bt + (size_t)pn * 256 * D); u.idx = nullptr; u.nvalid = 256; u.pm = pm; u.pn = pn; u.e = 0;
        u.cb = 256 * pn; u.flags = 0; return true;
    }
};
constexpr int MT_CNT = 0, MT_MT = 80, MT_NF = 160, MT_HB = 240, MT_XF = 320, MT_XL = 400, MT_WORDS = 480;
DI int wave_excl_scan(int v, int lane) {
    int s = v;
#pragma unroll
    for (int d = 1; d < 64; d <<= 1) { const int t = __shfl_up(s, d); if (lane >= d) s += t; }
    return s - v;
}
DI void moe_tables(Frame& F, volatile LAS int* tb) {
    if (F.tid < 64) {
        const int e = F.tid;
        const unsigned* cnt = (const unsigned*)(F.ws + WS_CTL) + CW_CNT;
        const int c = (int)__hip_atomic_load(cnt + 16 * e, RLX_AGENT);
        const int m = (c + 255) >> 8, nf = (c + 127) >> 8;
        const int hb = wave_excl_scan(m * 256, e);
        tb[MT_CNT + e] = c; tb[MT_MT + e] = m; tb[MT_NF + e] = nf; tb[MT_HB + e] = hb;
        if (e == 63) { const int tot = hb + m * 256; tb[MT_CNT + 64] = T; tb[MT_MT + 64] = T / 256; tb[MT_NF + 64] = T / 256; tb[MT_HB + 64] = tot; tb[MT_HB + 65] = tot + T; }
        const int x = e >> 3, k = e & 7, src = x + 8 * k;
        const int nfj = __shfl(nf, src), lj = __shfl(m - nf, src);
        const int pf = wave_excl_scan(nfj, e) + 4 * x, pl = wave_excl_scan(lj, e);
        tb[MT_XF + 10 * x + k] = pf; tb[MT_XL + 10 * x + k] = pl;
        if (k == 7) { tb[MT_XF + 10 * x + 8] = pf + nfj; tb[MT_XF + 10 * x + 9] = pf + nfj + 4; tb[MT_XL + 10 * x + 8] = pl + lj; tb[MT_XL + 10 * x + 9] = pl + lj; }
    }
    __syncthreads();
}
constexpr int MT_UL = 480;
template <int NTN>
DI void moe_unit_list(Frame& F, volatile LAS int* tb) {
    if (F.tid < 64) {
        const int i = F.tid, c = F.bid, G = F.G;
        int e = -1, mtile = 0, nt_ = 0, fl = 0;
        const int xg = c & 7, R = G >> 3, UF = tb[MT_XF + 79] * NTN, UL = tb[MT_XL + 79] * NTN;
        const int f0 = (int)(((long)UF * xg) >> 3), f1 = (int)(((long)UF * (xg + 1)) >> 3), l0 = (int)(((long)UL * xg) >> 3), l1 = (int)(((long)UL * (xg + 1)) >> 3);
        const int Q = i * R + (c >> 3);
        if (Q < f1 - f0) {
            const int P = f0 + Q;
            int x = 0;
#pragma unroll
            for (int q = 1; q < 8; ++q) x += (tb[MT_XF + 10 * q] * NTN <= P) ? 1 : 0;
            int k = 0;
#pragma unroll
            for (int q = 1; q < 9; ++q) k += (tb[MT_XF + 10 * x + q] * NTN <= P) ? 1 : 0;
            const int loc = P - tb[MT_XF + 10 * x + k] * NTN;
            if (k < 8) { e = x + 8 * k; const int m = tb[MT_NF + e]; mtile = loc % m; nt_ = loc / m; }
            else { e = 64; mtile = 4 * x + (loc & 3); nt_ = loc >> 2; }
        } else if (Q - (f1 - f0) < l1 - l0) {
            const int P = l0 + Q - (f1 - f0);
            int x = 0;
#pragma unroll
            for (int q = 1; q < 8; ++q) x += (tb[MT_XL + 10 * q] * NTN <= P) ? 1 : 0;
            int k = 0;
#pragma unroll
            for (int q = 1; q < 8; ++q) k += (tb[MT_XL + 10 * x + q] * NTN <= P) ? 1 : 0;
            e = x + 8 * k; mtile = tb[MT_NF + e]; nt_ = P - tb[MT_XL + 10 * x + k] * NTN; fl = 1;
        }
        tb[MT_UL + 4 * i] = e; tb[MT_UL + 4 * i + 1] = mtile; tb[MT_UL + 4 * i + 2] = nt_; tb[MT_UL + 4 * i + 3] = fl;
    }
    __syncthreads();
}
template <int NTN, int ES>
struct MoeOrder {
    const volatile LAS int* tb; const unsigned char* A; const unsigned char* Bt; const int* list; int K, G, c;
    DI bool next(int i, pg8::Unit& u) const {
        if (i >= 64) return false;
        const int e = __builtin_amdgcn_readfirstlane(tb[MT_UL + 4 * i]);
        if (e < 0) return false;
        const int mtile = __builtin_amdgcn_readfirstlane(tb[MT_UL + 4 * i + 1]), nt_ = __builtin_amdgcn_readfirstlane(tb[MT_UL + 4 * i + 2]), fl = __builtin_amdgcn_readfirstlane(tb[MT_UL + 4 * i + 3]);
        const int hb = __builtin_amdgcn_readfirstlane(tb[MT_HB + e]), cnt = __builtin_amdgcn_readfirstlane(tb[MT_CNT + e]);
        u.e = e; u.pn = nt_; u.pm = (hb >> 8) + mtile; u.nvalid = (cnt - mtile * 256) < 256 ? (cnt - mtile * 256) : 256;
        u.cb = 256 * nt_; u.flags = fl;
        u.b = (const char*)(Bt + (size_t)e * (NTN * 256) * K * ES + (size_t)nt_ * 256 * 128);
        if (NTN == 4) { u.a = (const char*)A; u.idx = list + (size_t)e * T + mtile * 256; }
        else { u.a = (const char*)(A + (size_t)(hb + mtile * 256) * K * ES); u.idx = nullptr; }
        return true;
    }
};

DI v4u pack8(const f32x4 v0, const f32x4 v1) { v4u w; w.x = pg8::cvt_pk_bf16(v0[0], v0[1]); w.y = pg8::cvt_pk_bf16(v0[2], v0[3]); w.z = pg8::cvt_pk_bf16(v1[0], v1[1]); w.w = pg8::cvt_pk_bf16(v1[2], v1[3]); return w; }
DI void unpack8(const v4u w, f32x4& v0, f32x4& v1) { v0 = (f32x4){bflo(w.x), bfhi(w.x), bflo(w.y), bfhi(w.y)}; v1 = (f32x4){bflo(w.z), bfhi(w.z), bflo(w.w), bfhi(w.w)}; }

struct EpiG1 {
    static constexpr bool PERM = true;
    unsigned char* ws;
    DI void operator()(const f32x4 (&acc)[2][2][4][2], const pg8::Unit& u, int wr, int wc, int fr, int fq) const {
        const int pn = u.cb >> 8; bf16_t* dst; int ld, c0, act;
        if (pn < 4) { dst = (bf16_t*)(ws + WS_U); ld = 1024; c0 = 256 * pn; act = 0; }
        else if (pn < 6) { dst = (bf16_t*)(ws + WS_KK); ld = 512; c0 = 256 * (pn - 4); act = 0; }
        else if (pn < 10) { dst = (bf16_t*)(ws + WS_V); ld = 1024; c0 = 256 * (pn - 6); act = 0; }
        else if (pn < 12) { dst = (bf16_t*)(ws + WS_Q); ld = 512; c0 = 256 * (pn - 10); act = 1; }
        else if (pn < 16) { dst = (bf16_t*)(ws + WS_GO); ld = 1024; c0 = 256 * (pn - 12); act = 2; }
        else if (pn < 24) { dst = (bf16_t*)(ws + WS_GS); ld = 2048; c0 = 256 * (pn - 16); act = 3; }
        else { dst = (bf16_t*)(ws + WS_GG); ld = 2048; c0 = 256 * (pn - 24); act = 3; }
        const int row0 = u.pm * 256 + wr * 64 + fr, col0 = c0 + (u.cb & 255) + wc * 32 + 8 * fq;
#pragma unroll
        for (int ai = 0; ai < 2; ++ai)
#pragma unroll
            for (int m = 0; m < 4; ++m) { bf16_t* rowp = dst + (size_t)(row0 + ai * 128 + m * 16) * ld + col0;
#pragma unroll
                for (int bj = 0; bj < 2; ++bj) { if (bj && (u.flags & 2)) continue; f32x4 v0 = acc[ai][bj][m][0], v1 = acc[ai][bj][m][1];
                    if (act == 1) { v0 *= 0.08838834764831845f; v1 *= 0.08838834764831845f; }
                    else if (act == 2) {
#pragma unroll
                        for (int j = 0; j < 4; ++j) { v0[j] = siluf_(v0[j]); v1[j] = siluf_(v1[j]); } }
                    else if (act == 3) {
#pragma unroll
                        for (int j = 0; j < 4; ++j) { v0[j] = sigmoidf_(v0[j]); v1[j] = sigmoidf_(v1[j]); } }
                    *(GAS v4u*)(rowp + bj * 128) = pack8(v0, v1); } }
    }
};
template <int MODE>
struct EpiEw {
    static constexpr bool PERM = true;
    bf16_t* O; const bf16_t* P1; int ld;
    DI void operator()(const f32x4 (&acc)[2][2][4][2], const pg8::Unit& u, int wr, int wc, int fr, int fq) const {
        const int rl0 = wr * 64 + fr, col0 = u.cb + wc * 32 + 8 * fq;
        const bool nb1 = (u.flags & 2) != 0;
#pragma unroll
        for (int ai = 0; ai < 2; ++ai) {
            v4u p1[4][2], po[4][2];
            if (MODE != 3) {
#pragma unroll
                for (int m = 0; m < 4; ++m)
#pragma unroll
                    for (int bj = 0; bj < 2; ++bj) { if (bj && nb1) continue; const size_t off = (size_t)(u.pm * 256 + rl0 + ai * 128 + m * 16) * ld + col0 + bj * 128;
                        p1[m][bj] = *(const GAS v4u*)(P1 + off); if (MODE == 2) po[m][bj] = *(const GAS v4u*)(O + off); }
            }
#pragma unroll
            for (int m = 0; m < 4; ++m) { const int rl = rl0 + ai * 128 + m * 16; const size_t off = (size_t)(u.pm * 256 + rl) * ld + col0;
                if (MODE == 3 && rl >= u.nvalid) continue;
#pragma unroll
                for (int bj = 0; bj < 2; ++bj) { if (bj && nb1) continue; f32x4 v0 = acc[ai][bj][m][0], v1 = acc[ai][bj][m][1];
                    if (MODE != 3) { f32x4 q0, q1; unpack8(p1[m][bj], q0, q1);
                        if (MODE == 0) {
#pragma unroll
                            for (int j = 0; j < 4; ++j) { v0[j] = q0[j] * sigmoidf_(v0[j]); v1[j] = q1[j] * sigmoidf_(v1[j]); } }
                        else { v0 *= q0; v1 *= q1; }
                        if (MODE == 2) { f32x4 o0, o1; unpack8(po[m][bj], o0, o1); v0 += o0; v1 += o1; } }
                    if (MODE == 3) { unsigned w0 = 0, w1 = 0;
                        w0 = __builtin_amdgcn_cvt_pk_fp8_f32(v0[0], v0[1], w0, false); w0 = __builtin_amdgcn_cvt_pk_fp8_f32(v0[2], v0[3], w0, true);
                        w1 = __builtin_amdgcn_cvt_pk_fp8_f32(v1[0], v1[1], w1, false); w1 = __builtin_amdgcn_cvt_pk_fp8_f32(v1[2], v1[3], w1, true);
                        *(GAS v2u*)((unsigned char*)O + off + bj * 128) = (v2u){w0, w1}; }
                    else if (MODE == 0) { unsigned w0 = 0, w1 = 0;
                        w0 = __builtin_amdgcn_cvt_pk_fp8_f32(v0[0], v0[1], w0, false); w0 = __builtin_amdgcn_cvt_pk_fp8_f32(v0[2], v0[3], w0, true);
                        w1 = __builtin_amdgcn_cvt_pk_fp8_f32(v1[0], v1[1], w1, false); w1 = __builtin_amdgcn_cvt_pk_fp8_f32(v1[2], v1[3], w1, true);
                        *(GAS v2u*)((unsigned char*)O + off + bj * 128) = (v2u){w0, w1}; }
                    else *(GAS v4u*)(O + off + bj * 128) = pack8(v0, v1); } }
            asm volatile("" ::: "memory");
        }
    }
};
struct EpiY8 {
    static constexpr bool PERM = true;
    unsigned char* O; int ld;
    DI void operator()(const f32x4 (&acc)[2][2][4][2], const pg8::Unit& u, int wr, int wc, int fr, int fq) const {
        const bool odd = (fr & 1) != 0;
        const int rl0 = wr * 64 + (fr & ~1), colb = u.cb + 64 * wc + 8 * fq + (odd ? 32 : 0);
#pragma unroll
        for (int ai = 0; ai < 2; ++ai) {
#pragma unroll
            for (int m = 0; m < 4; ++m) {
                unsigned w[2][2];
#pragma unroll
                for (int bj = 0; bj < 2; ++bj) { const f32x4 v0 = acc[ai][bj][m][0], v1 = acc[ai][bj][m][1]; unsigned w0 = 0, w1 = 0;
                    w0 = __builtin_amdgcn_cvt_pk_fp8_f32(v0[0], v0[1], w0, false); w0 = __builtin_amdgcn_cvt_pk_fp8_f32(v0[2], v0[3], w0, true);
                    w1 = __builtin_amdgcn_cvt_pk_fp8_f32(v1[0], v1[1], w1, false); w1 = __builtin_amdgcn_cvt_pk_fp8_f32(v1[2], v1[3], w1, true);
                    w[bj][0] = w0; w[bj][1] = w1; }
                const unsigned s0 = odd ? w[0][0] : w[1][0], s1 = odd ? w[0][1] : w[1][1];
                const unsigned r0 = (unsigned)__builtin_amdgcn_mov_dpp((int)s0, 0xB1, 0xf, 0xf, true), r1 = (unsigned)__builtin_amdgcn_mov_dpp((int)s1, 0xB1, 0xf, 0xf, true);
                const v2u d1 = odd ? (v2u){r0, r1} : (v2u){w[0][0], w[0][1]};
                const v2u d2 = odd ? (v2u){w[1][0], w[1][1]} : (v2u){r0, r1};
                const int rl = rl0 + ai * 128 + m * 16; const size_t off = (size_t)(u.pm * 256 + rl) * ld + colb;
                if (rl < u.nvalid) *(GAS v2u*)(O + off) = d1;
                if (rl + 1 < u.nvalid) *(GAS v2u*)(O + off + ld) = d2;
            }
            asm volatile("" ::: "memory");
        }
    }
};
struct MergeOrder {
    const unsigned char* A0; const unsigned char* B0; const unsigned char* A1; const unsigned char* B1; int G, c;
    DI bool next(int i, pg8::Unit& u) const {
        const int t = (i >> 1) * G + c, ty = i & 1; int pm, pn;
        if (!static_tile(t, 32, 8, pm, pn)) return false;
        u.a = (const char*)((ty ? A1 : A0) + (size_t)pm * 256 * 1024); u.b = (const char*)((ty ? B1 : B0) + (size_t)pn * 256 * 1024); u.idx = nullptr; u.nvalid = 256; u.pm = pm; u.pn = pn; u.e = ty;
        u.cb = 256 * pn; u.flags = 0; return true;
    }
};
struct EpiMerge {
    static constexpr bool PERM = true; static constexpr int NSTORES = 0;
    bf16_t* M; const bf16_t* GS; const bf16_t* GG;
    DI void operator()(const f32x4 (&acc)[2][2][4][2], const pg8::Unit& u, int wr, int wc, int fr, int fq) const {
        if (u.e == 0) { EpiEw<1> e{M, GS, 2048}; e(acc, u, wr, wc, fr, fq); }
        else { EpiEw<2> e{M, GG, 2048}; e(acc, u, wr, wc, fr, fq); }
    }
};
DI void p64_swap(bool odd, f32x4 (&x0)[2], f32x4 (&x1)[2]) {
#pragma unroll
    for (int n = 0; n < 2; ++n)
#pragma unroll
        for (int j = 0; j < 4; ++j) {
            const float a = x0[n][j], b = x1[n][j];
            const float snd = odd ? a : b;
            const float rcv = __int_as_float(__builtin_amdgcn_mov_dpp(__float_as_int(snd), 0xB1, 0xf, 0xf, true));
            x0[n][j] = odd ? rcv : a; x1[n][j] = odd ? b : rcv;
        }
}
struct EpiMerge64 {
    static constexpr bool PERM = true;
    bf16_t* M; const bf16_t* GS; const bf16_t* GG; unsigned char* M8;
    DI void operator()(const f32x4 (&acc)[2][2][4][2], const pg8::Unit& u, int wr, int wc, int fr, int fq) const {
        const bool odd = (fr & 1) != 0, second = (u.e != 0);
        const bf16_t* P1 = second ? GG : GS;
        const size_t base = (size_t)(u.pm * 256 + wr * 64 + (fr & ~1)) * 2048 + u.cb + 64 * wc + (odd ? 32 : 0) + 8 * fq;
#pragma unroll
        for (int ai = 0; ai < 2; ++ai) {
            v4u p1[4][2], po[4][2];
#pragma unroll
            for (int m = 0; m < 4; ++m)
#pragma unroll
                for (int k = 0; k < 2; ++k) { const size_t off = base + (size_t)(ai * 128 + m * 16 + k) * 2048;
                    p1[m][k] = *(const GAS v4u*)(P1 + off); if (second) po[m][k] = *(const GAS v4u*)(M + off); }
#pragma unroll
            for (int m = 0; m < 4; ++m) {
                f32x4 y0[2] = {acc[ai][0][m][0], acc[ai][0][m][1]}, y1[2] = {acc[ai][1][m][0], acc[ai][1][m][1]};
                p64_swap(odd, y0, y1);
#pragma unroll
                for (int k = 0; k < 2; ++k) { const size_t off = base + (size_t)(ai * 128 + m * 16 + k) * 2048;
                    f32x4 v0 = k ? y1[0] : y0[0], v1 = k ? y1[1] : y0[1], q0, q1; unpack8(p1[m][k], q0, q1);
                    v0 *= q0; v1 *= q1;
                    if (second) { f32x4 o0, o1; unpack8(po[m][k], o0, o1); v0 += o0; v1 += o1;
                        unsigned w0 = 0, w1 = 0;
                        w0 = __builtin_amdgcn_cvt_pk_fp8_f32(v0[0], v0[1], w0, false); w0 = __builtin_amdgcn_cvt_pk_fp8_f32(v0[2], v0[3], w0, true);
                        w1 = __builtin_amdgcn_cvt_pk_fp8_f32(v1[0], v1[1], w1, false); w1 = __builtin_amdgcn_cvt_pk_fp8_f32(v1[2], v1[3], w1, true);
                        *(GAS v2u*)(M8 + off) = (v2u){w0, w1}; }
                    else *(GAS v4u*)(M + off) = pack8(v0, v1); }
            }
            asm volatile("" ::: "memory");
        }
    }
};
struct EpiOut {
    static constexpr bool PERM = true;
    const float* x; const float* mod; bf16_t* X1;
    DI void operator()(const f32x4 (&acc)[2][2][4][2], const pg8::Unit& u, int wr, int wc, int fr, int fq) const {
        const int row0 = u.pm * 256 + wr * 64 + fr, col0 = u.cb + wc * 32 + 8 * fq;
        const float* g1 = mod + (size_t)(u.pm * 256 / SEQ) * (NMOD * D) + 2 * D;
        f32x4 gv[2][2];
#pragma unroll
        for (int bj = 0; bj < 2; ++bj)
#pragma unroll
            for (int n = 0; n < 2; ++n) gv[bj][n] = *(const GAS f32x4*)(g1 + col0 + bj * 128 + n * 4);
#pragma unroll
        for (int ai = 0; ai < 2; ++ai)
#pragma unroll
            for (int mh = 0; mh < 2; ++mh) {
                f32x4 xs[2][2][2];
#pragma unroll
                for (int mm = 0; mm < 2; ++mm)
#pragma unroll
                    for (int bj = 0; bj < 2; ++bj)
#pragma unroll
                        for (int n = 0; n < 2; ++n) xs[mm][bj][n] = __builtin_nontemporal_load((const GAS f32x4*)(x + (size_t)(row0 + ai * 128 + (2 * mh + mm) * 16) * D + col0 + bj * 128 + n * 4));
#pragma unroll
                for (int mm = 0; mm < 2; ++mm)
#pragma unroll
                    for (int bj = 0; bj < 2; ++bj) { const int m = 2 * mh + mm;
                        *(GAS v4u*)(X1 + (size_t)(row0 + ai * 128 + m * 16) * D + col0 + bj * 128) = pack8(xs[mm][bj][0] + gv[bj][0] * acc[ai][bj][m][0], xs[mm][bj][1] + gv[bj][1] * acc[ai][bj][m][1]); }
                asm volatile("" ::: "memory");
            }
    }
};
struct EpiGU {
    static constexpr bool PERM = true;
    unsigned char* HID;
    DI void operator()(const f32x4 (&acc)[2][2][4][2], const pg8::Unit& u, int wr, int wc, int fr, int fq) const {
        const int rl0 = wr * 64 + fr, col0 = u.pn * 128 + wc * 32 + 8 * fq;
#pragma unroll
        for (int ai = 0; ai < 2; ++ai)
#pragma unroll
            for (int m = 0; m < 4; ++m) { const int rl = rl0 + ai * 128 + m * 16; if (rl >= u.nvalid) continue;
                float v[8];
#pragma unroll
                for (int j = 0; j < 4; ++j) { v[j] = siluf_(acc[ai][0][m][0][j]) * acc[ai][1][m][0][j]; v[4 + j] = siluf_(acc[ai][0][m][1][j]) * acc[ai][1][m][1][j]; }
                unsigned w0 = 0, w1 = 0;
                w0 = __builtin_amdgcn_cvt_pk_fp8_f32(v[0], v[1], w0, false); w0 = __builtin_amdgcn_cvt_pk_fp8_f32(v[2], v[3], w0, true);
                w1 = __builtin_amdgcn_cvt_pk_fp8_f32(v[4], v[5], w1, false); w1 = __builtin_amdgcn_cvt_pk_fp8_f32(v[6], v[7], w1, true);
                *(GAS v2u*)(HID + (size_t)(u.pm * 256 + rl) * DEXP + col0) = (v2u){w0, w1}; }
    }
};

DI float gelu_tanh(float x) {
    const float u = 0.7978845608028654f * (x + 0.044715f * x * x * x);
    const float e = __expf(2.f * u);
    const float th = 1.f - 2.f * __builtin_amdgcn_rcpf(e + 1.f);
    return 0.5f * x * (1.f + th);
}
DI int chunk_rowbase(int b, int n) { return (n < NCHC) ? (T + b * CTX + n * GCH) : (b * SEQ + (n - NCHC) * GCH); }
DI float fma_s(float a, float b, float c) { float r; asm("v_fma_f32 %0, %1, %2, %3" : "=v"(r) : "v"(a), "v"(b), "v"(c)); return r; }
struct S5Cur { bf16x8 afr[2]; f32x2 s; };
template <bool READOUT, int DR>
DI void s5_dir(f32x4 (&yacc)[2][2], const S5Cur& o, f32x2& sout, const f32x2 lam, const bf16x8 (&bfr)[4], const bf16x8 (&cfr)[4], LAS unsigned char* hsb, int lane) {
    const int l15 = lane & 15, q4 = lane >> 4;
    const float lr = lam.x, li = lam.y, nli = -lam.y;
    float sr = o.s.x, si = o.s.y;
#pragma unroll
    for (int sbi = 0; sbi < 2; ++sbi) {
        const int sb = DR ? (1 - sbi) : sbi;
        f32x16 c[4];
#pragma unroll
        for (int j = 0; j < 4; ++j) {
#pragma unroll
            for (int r = 0; r < 16; ++r) c[j][r] = 0.f;
            c[j] = MFMA32(o.afr[sb], bfr[j], c[j]);
        }
        float xr[2][16], xi[2][16];
#pragma unroll
        for (int r = 0; r < 16; ++r) {
            const float c0 = c[0][r], c1 = c[1][r], c2 = c[2][r], c3 = c[3][r];
            auto pr = __builtin_amdgcn_permlane32_swap(__float_as_uint(c0), __float_as_uint(c2), false, false);
            auto pi = __builtin_amdgcn_permlane32_swap(__float_as_uint(c1), __float_as_uint(c3), false, false);
            const unsigned pr0 = pr[0], pr1 = pr[1], pi0 = pi[0], pi1 = pi[1];
            xr[0][r] = __uint_as_float(pr0); xr[1][r] = __uint_as_float(pr1);
            xi[0][r] = __uint_as_float(pi0); xi[1][r] = __uint_as_float(pi1);
        }
        if (READOUT) asm volatile("s_waitcnt lgkmcnt(0)" ::: "memory");
#pragma unroll
        for (int tt = 0; tt < 32; ++tt) {
            const int t = DR ? (31 - tt) : tt;
            const int half = (t >> 2) & 1, r = (t & 3) + 4 * (t >> 3);
            const float t1 = fma_s(nli, si, xr[half][r]), t2 = fma_s(li, sr, xi[half][r]);
            const float nr = fma_s(lr, sr, t1), ni = fma_s(lr, si, t2);
            sr = nr; si = ni;
            if (READOUT) *(LAS unsigned*)(hsb + t * 256 + ((((lane >> 2) ^ (t & 15))) << 4) + (lane & 3) * 4) = pk2(nr, ni);
        }
        if (READOUT) {
            asm volatile("s_waitcnt lgkmcnt(0)" ::: "memory");
#pragma unroll
            for (int mt = 0; mt < 2; ++mt)
#pragma unroll
                for (int ks = 0; ks < 4; ++ks) {
                    const int row = 16 * mt + l15, ch = 4 * ks + q4;
                    const bf16x8 a = *(const LAS bf16x8*)(hsb + row * 256 + ((ch ^ l15) << 4));
                    yacc[sb][mt] = MFMA16(a, cfr[ks], yacc[sb][mt]);
                }
        }
    }
    sout = (f32x2){sr, si};
}
template <bool READOUT>
DI void s5_phase(Frame& F) {
    constexpr int NC = READOUT ? NCHL : NCH, NIT = NB * NC * 16;
    const int lane = F.lane, l31 = lane & 31, hi = lane >> 5, l15 = lane & 15, q4 = lane >> 4;
    const int gq = F.wave & 3, dr = F.wave >> 2;
    LAS unsigned char* hsb = F.lds + F.wave * 8192;
    LAS float* ysh = (LAS float*)(F.lds + 65536) + gq * 1024;
    int itn = 0;
    const bf16_t* U = (const bf16_t*)(F.ws + WS_U);
    const bf16_t* BT = (const bf16_t*)(F.ws + WS_S5TAB + S5TAB_BT);
    const bf16_t* CT = (const bf16_t*)(F.ws + WS_S5TAB + S5TAB_CT);
    const f32x2* LAM = (const f32x2*)(F.ws + WS_S5TAB + S5TAB_LAM);
    f32x2* ST = (f32x2*)(F.ws + WS_S5ST);
    bf16_t* YS = (bf16_t*)(F.ws + WS_YS); unsigned char* YS8 = F.ws + WS_YS8;
    bf16x8 bfr[4], cfr[4]; f32x2 lam = (f32x2){0.f, 0.f}; int cur_gb4 = -1;
    S5Cur cur, nxt;
#define S5_LOAD(dst, jj) do { const int gb4_ = (jj) & 15, rest_ = (jj) >> 4, n_ = (rest_ % NC) + (READOUT ? NCHC : 0), b_ = rest_ / NC, g_ = gb4_ * 4 + gq, base_ = chunk_rowbase(b_, n_); \
        _Pragma("unroll") for (int sb = 0; sb < 2; ++sb) (dst).afr[sb] = *(const GAS bf16x8*)(U + (size_t)(base_ + 32 * sb + l31) * S5W + g_ * 16 + 8 * hi); \
        (dst).s = READOUT ? ST[((size_t)((b_ * NCH + n_) * 2 + dr) * 64 + g_) * 64 + lane] : (f32x2){0.f, 0.f}; } while (0)
    if (F.bid < NIT) S5_LOAD(cur, F.bid);
    for (int j = F.bid; j < NIT; j += F.G) {
        const int gb4 = j & 15, rest = j >> 4, n = (rest % NC) + (READOUT ? NCHC : 0), b = rest / NC, g = gb4 * 4 + gq, base = chunk_rowbase(b, n), tg = dr * 64 + g;
        if (gb4 != cur_gb4) {
#pragma unroll
            for (int jj = 0; jj < 4; ++jj) bfr[jj] = *(const GAS bf16x8*)(BT + ((size_t)tg * 128 + 32 * jj + l31) * 16 + 8 * hi);
#pragma unroll
            for (int ks = 0; ks < 4; ++ks) cfr[ks] = READOUT ? *(const GAS bf16x8*)(CT + ((size_t)tg * 16 + l15) * 128 + 32 * ks + 8 * q4) : bfr[ks];
            lam = LAM[tg * 64 + lane]; cur_gb4 = gb4;
        }
        if (j + F.G < NIT) S5_LOAD(nxt, j + F.G);
        f32x4 yacc[2][2];
#pragma unroll
        for (int a = 0; a < 2; ++a)
#pragma unroll
            for (int c = 0; c < 2; ++c) yacc[a][c] = (f32x4){0.f, 0.f, 0.f, 0.f};
        float uskip[8];
        if (READOUT) {
#pragma unroll
            for (int mt = 0; mt < 2; ++mt)
#pragma unroll
                for (int i = 0; i < 4; ++i) uskip[mt * 4 + i] = bf2f(U[(size_t)(base + 32 * dr + 16 * mt + 4 * q4 + i) * S5W + g * 16 + l15]);
        }
        f32x2 sout;
        if (dr == 0) s5_dir<READOUT, 0>(yacc, cur, sout, lam, bfr, cfr, hsb, lane);
        else s5_dir<READOUT, 1>(yacc, cur, sout, lam, bfr, cfr, hsb, lane);
        if (!READOUT) ST[((size_t)((b * NCH + n) * 2 + dr) * 64 + g) * 64 + lane] = sout;
        if (READOUT) {
            LAS float* yx = ysh + (itn & 1) * 4096;
            const int ch = g * 16 + l15; const int osb = 1 - dr;
#pragma unroll
            for (int mt = 0; mt < 2; ++mt)
#pragma unroll
                for (int i = 0; i < 4; ++i) yx[osb * 512 + (16 * mt + 4 * q4 + i) * 16 + l15] = (osb == 0) ? yacc[0][mt][i] : yacc[1][mt][i];
            LDS_BAR();
            const float dsk = F.in[I_S5D][ch];
#pragma unroll
            for (int mt = 0; mt < 2; ++mt)
#pragma unroll
                for (int i = 0; i < 4; ++i) {
                    const int row = 32 * dr + 16 * mt + 4 * q4 + i; const size_t o = (size_t)(base + row) * S5W + ch;
                    const float mine = (dr == 0) ? yacc[0][mt][i] : yacc[1][mt][i];
                    const float yv = gelu_tanh(mine + yx[dr * 512 + (16 * mt + 4 * q4 + i) * 16 + l15] + dsk * uskip[mt * 4 + i]);
                    YS[o] = (bf16_t)f2bf(yv);
                    YS8[o] = (unsigned char)(__builtin_amdgcn_cvt_pk_fp8_f32(yv, 0.f, 0u, false) & 0xffu);
                }
        }
        ++itn;
        cur = nxt;
    }
#undef S5_LOAD
}
DI int chunk_order(int dr, int step) { return dr == 0 ? step : (step < NCHC ? NCHC - 1 - step : NCH + NCHC - 1 - step); }
DI void s5_carry(Frame& F) {
    const int gid = F.bid * 512 + F.tid;
    if (gid >= NB * 2 * 4096) return;
    const int b = gid >> 13, dr = (gid >> 12) & 1, gp = gid & 4095;
    const f32x2 l64 = ((const f32x2*)(F.ws + WS_S5TAB + S5TAB_LAM64))[dr * 4096 + gp];
    f32x2* ST = (f32x2*)(F.ws + WS_S5ST);
    f32x2 e[NCH];
#pragma unroll
    for (int step = 0; step < NCH; ++step) e[step] = ST[(size_t)((b * NCH + chunk_order(dr, step)) * 2 + dr) * 4096 + gp];
    f32x2 h = (f32x2){0.f, 0.f};
#pragma unroll
    for (int step = 0; step < NCH; ++step) {
        ST[(size_t)((b * NCH + chunk_order(dr, step)) * 2 + dr) * 4096 + gp] = h;
        h = (f32x2){l64.x * h.x - l64.y * h.y + e[step].x, l64.x * h.y + l64.y * h.x + e[step].y};
    }
}

constexpr int KST = 72;
constexpr int QST = 136;
struct GlaPre { float up[16]; float bias; f32x4 gs; };
DI void gla_pre_load(Frame& F, int rowbase, int h, int dr, GlaPre& p) {
    const int c = F.tid & 127;
    const float* GKD = (const float*)(F.ws + WS_GKD);
#pragma unroll
    for (int r = 0; r < 16; ++r) p.up[r] = F.in[I_GKUP][(size_t)(dr * 16 + r) * GKW + h * GDK + c];
    p.bias = F.in[I_GKB][dr * GKW + h * GDK + c];
    p.gs = (F.tid < 256) ? *(const GAS f32x4*)(GKD + (size_t)(rowbase + (F.tid >> 2)) * 32 + 16 * dr + 4 * (F.tid & 3)) : (f32x4){0.f, 0.f, 0.f, 0.f};
}
DI float gla_decay(Frame& F, int dr, const GlaPre& p, LAS float* gsc, LAS float* tot, float (&bv)[16]) {
    const int c = F.tid & 127, tq = F.tid >> 7;
    if (F.tid < 256) *(LAS f32x4*)(gsc + (F.tid >> 2) * 16 + 4 * (F.tid & 3)) = p.gs;
    LDS_BAR();
    float gl[16];
#pragma unroll
    for (int tt = 0; tt < 16; ++tt) {
        const LAS f32x4* gr = (const LAS f32x4*)(gsc + (16 * tq + tt) * 16);
        float z = p.bias;
#pragma unroll
        for (int r4 = 0; r4 < 4; ++r4) { const f32x4 gv = gr[r4]; z += gv.x * p.up[4 * r4] + gv.y * p.up[4 * r4 + 1] + gv.z * p.up[4 * r4 + 2] + gv.w * p.up[4 * r4 + 3]; }
        gl[tt] = (fminf(z, 0.f) - __logf(1.f + __expf(-fabsf(z)))) * (1.f / 16.f);
    }
    float run = 0.f;
    if (dr == 0) {
#pragma unroll
        for (int tt = 0; tt < 16; ++tt) { run += gl[tt]; bv[tt] = run; }
    } else {
#pragma unroll
        for (int tt = 15; tt >= 0; --tt) { run += gl[tt]; bv[tt] = run; }
    }
    tot[tq * 128 + c] = run;
    LDS_BAR();
    const float t0 = tot[c], t1 = tot[128 + c], t2 = tot[256 + c], t3 = tot[384 + c];
    float off;
    if (dr == 0) off = (tq > 0 ? t0 : 0.f) + (tq > 1 ? t1 : 0.f) + (tq > 2 ? t2 : 0.f);
    else off = (tq < 1 ? t1 : 0.f) + (tq < 2 ? t2 : 0.f) + (tq < 3 ? t3 : 0.f);
#pragma unroll
    for (int tt = 0; tt < 16; ++tt) bv[tt] += off;
    return (t0 + t1) + (t2 + t3);
}
DI void gla_vT_load(Frame& F, int rowbase, int h, unsigned short (&e)[32]) {
    const bf16_t* V = (const bf16_t*)(F.ws + WS_V);
    const int dv = F.tid & 255, half = F.tid >> 8;
#pragma unroll
    for (int j = 0; j < 32; ++j) e[j] = V[(size_t)(rowbase + 32 * half + j) * GVW + h * GDV + dv];
}
DI void gla_vT_store(Frame& F, const unsigned short (&e)[32], LAS bf16_t* vT) {
    const int dv = F.tid & 255, half = F.tid >> 8;
#pragma unroll
    for (int t8 = 0; t8 < 4; ++t8) {
        v4u w; w.x = e[8 * t8] | ((unsigned)e[8 * t8 + 1] << 16); w.y = e[8 * t8 + 2] | ((unsigned)e[8 * t8 + 3] << 16); w.z = e[8 * t8 + 4] | ((unsigned)e[8 * t8 + 5] << 16); w.w = e[8 * t8 + 6] | ((unsigned)e[8 * t8 + 7] << 16);
        *(LAS v4u*)(vT + dv * KST + 32 * half + 8 * t8) = w;
    }
}
DI void gla_state_item(Frame& F, int b, int h, int n) {
    LAS float* gsc = (LAS float*)F.lds; LAS float* tot = (LAS float*)(F.lds + 4096);
    LAS bf16_t* kdT = (LAS bf16_t*)(F.lds + 6144); LAS bf16_t* vT = (LAS bf16_t*)(F.lds + 24576);
    const int rowbase = chunk_rowbase(b, n);
    const bf16_t* KK = (const bf16_t*)(F.ws + WS_KK);
    bf16_t* GST = (bf16_t*)(F.ws + WS_GST); float* GDEC = (float*)(F.ws + WS_GDEC);
    const int c = F.tid & 127, tq = F.tid >> 7, lane = F.lane, l31 = lane & 31, hi = lane >> 5, w = F.wave;
    GlaPre pre[2]; unsigned short ve[32]; float kf[16];
    gla_pre_load(F, rowbase, h, 0, pre[0]); gla_pre_load(F, rowbase, h, 1, pre[1]);
#pragma unroll
    for (int tt = 0; tt < 16; ++tt) kf[tt] = bf2f(KK[(size_t)(rowbase + 16 * tq + tt) * GKW + h * GDK + c]);
    gla_vT_load(F, rowbase, h, ve);
    gla_vT_store(F, ve, vT);
#pragma unroll
    for (int dr = 0; dr < 2; ++dr) {
        float bv[16];
        const float blast = gla_decay(F, dr, pre[dr], gsc, tot, bv);
        const size_t sbase = (size_t)(((b * GH + h) * NCH + n) * 2 + dr);
        unsigned pk[8];
#pragma unroll
        for (int t2 = 0; t2 < 8; ++t2) pk[t2] = pk2(kf[2 * t2] * __expf(blast - bv[2 * t2]), kf[2 * t2 + 1] * __expf(blast - bv[2 * t2 + 1]));
        *(LAS v4u*)(kdT + c * KST + 16 * tq) = (v4u){pk[0], pk[1], pk[2], pk[3]};
        *(LAS v4u*)(kdT + c * KST + 16 * tq + 8) = (v4u){pk[4], pk[5], pk[6], pk[7]};
        if (tq == 0) GDEC[sbase * GDK + c] = __expf(blast);
        LDS_BAR();
        f32x16 acc[4];
#pragma unroll
        for (int j = 0; j < 4; ++j)
#pragma unroll
            for (int r = 0; r < 16; ++r) acc[j][r] = 0.f;
#pragma unroll
        for (int ks = 0; ks < 4; ++ks) {
            const bf16x8 a = *(const LAS bf16x8*)(vT + (32 * w + l31) * KST + 16 * ks + 8 * hi);
#pragma unroll
            for (int j = 0; j < 4; ++j) { const bf16x8 bb = *(const LAS bf16x8*)(kdT + (32 * j + l31) * KST + 16 * ks + 8 * hi); acc[j] = MFMA32(a, bb, acc[j]); }
        }
#pragma unroll
        for (int j = 0; j < 4; ++j)
#pragma unroll
            for (int r = 0; r < 16; ++r) GST[(sbase * GDV + 32 * w + crow32(r, hi)) * GDK + 32 * j + l31] = (bf16_t)f2bf(acc[j][r]);
        LDS_BAR();
    }
}
DI void gla_carry(Frame& F) {
    bf16_t* GST = (bf16_t*)(F.ws + WS_GST); const float* GDEC = (const float*)(F.ws + WS_GDEC);
    for (int chain = F.bid * 512 + F.tid; chain < NB * GH * 2 * GDV * 16; chain += F.G * 512) {
        const int k8 = chain & 15, dv = (chain >> 4) & 255, dr = (chain >> 12) & 1, h = (chain >> 13) & 3, b = chain >> 15;
        float S[8];
#pragma unroll
        for (int j = 0; j < 8; ++j) S[j] = 0.f;
        constexpr int PF = 4;
        v4u dsw[PF]; f32x4 d0[PF], d1[PF];
#define GC_LOAD(slot, step_) do { const int n_ = chunk_order(dr, (step_)); const size_t sb_ = (size_t)(((b * GH + h) * NCH + n_) * 2 + dr); \
            dsw[slot] = __builtin_nontemporal_load((const GAS v4u*)(GST + (sb_ * GDV + dv) * GDK + 8 * k8)); d0[slot] = *(const GAS f32x4*)(GDEC + sb_ * GDK + 8 * k8); d1[slot] = *(const GAS f32x4*)(GDEC + sb_ * GDK + 8 * k8 + 4); } while (0)
#pragma unroll
        for (int q = 0; q < PF; ++q) GC_LOAD(q, q);
#pragma unroll
        for (int step0 = 0; step0 < NCH; step0 += PF) {
#pragma unroll
            for (int q = 0; q < PF; ++q) {
                const int step = step0 + q;
                const int n = chunk_order(dr, step);
                const size_t sbase = (size_t)(((b * GH + h) * NCH + n) * 2 + dr);
                const v4u w = dsw[q]; const f32x4 e0d = d0[q], e1d = d1[q];
                *(GAS v4u*)(GST + (sbase * GDV + dv) * GDK + 8 * k8) = (v4u){pk2(S[0], S[1]), pk2(S[2], S[3]), pk2(S[4], S[5]), pk2(S[6], S[7])};
                if (step + PF < NCH) GC_LOAD(q, step + PF);
                f32x4 e0, e1; unpack8(w, e0, e1);
#pragma unroll
                for (int j = 0; j < 4; ++j) { S[j] = e0d[j] * S[j] + e0[j]; S[4 + j] = e1d[j] * S[4 + j] + e1[j]; }
            }
        }
#undef GC_LOAD
    }
}
DI void gla_out_item(Frame& F, int b, int h, int nl) {
    LAS float* gsc = (LAS float*)F.lds; LAS float* tot = (LAS float*)(F.lds + 4096);
    LAS bf16_t* qb = (LAS bf16_t*)(F.lds + 6144); LAS bf16_t* kb = (LAS bf16_t*)(F.lds + 23552);
    LAS bf16_t* vT = (LAS bf16_t*)(F.lds + 40960); LAS bf16_t* P = (LAS bf16_t*)(F.lds + 77824);
    LAS float* ot = (LAS float*)F.lds;
    const int n = nl + NCHC, rowbase = b * SEQ + nl * GCH;
    const bf16_t* KK = (const bf16_t*)(F.ws + WS_KK); const bf16_t* Q = (const bf16_t*)(F.ws + WS_Q);
    const bf16_t* GST = (const bf16_t*)(F.ws + WS_GST);
    const int c = F.tid & 127, tq = F.tid >> 7, lane = F.lane, l31 = lane & 31, hi = lane >> 5, w = F.wave;
    f32x16 oacc[2];
#pragma unroll
    for (int mi = 0; mi < 2; ++mi)
#pragma unroll
        for (int r = 0; r < 16; ++r) oacc[mi][r] = 0.f;
    GlaPre pre[2]; unsigned short ve[32]; float kf[16], qf[16]; bf16x8 sfr[2][8];
    gla_pre_load(F, rowbase, h, 0, pre[0]); gla_pre_load(F, rowbase, h, 1, pre[1]);
#pragma unroll
    for (int tt = 0; tt < 16; ++tt) { kf[tt] = bf2f(KK[(size_t)(rowbase + 16 * tq + tt) * GKW + h * GDK + c]); qf[tt] = bf2f(Q[(size_t)(rowbase + 16 * tq + tt) * GKW + h * GDK + c]); }
    gla_vT_load(F, rowbase, h, ve);
#pragma unroll
    for (int dr = 0; dr < 2; ++dr)
#pragma unroll
        for (int ks = 0; ks < 8; ++ks) sfr[dr][ks] = *(const GAS bf16x8*)(GST + (((size_t)(((b * GH + h) * NCH + n) * 2 + dr)) * GDV + 32 * w + l31) * GDK + 16 * ks + 8 * hi);
    v4u gov[4];
    { const size_t o_ = (size_t)(rowbase + (F.tid >> 3)) * GVW + h * GDV + 32 * (F.tid & 7); const bf16_t* GO_ = (const bf16_t*)(F.ws + WS_GO);
#pragma unroll
      for (int j2 = 0; j2 < 4; ++j2) gov[j2] = *(const GAS v4u*)(GO_ + o_ + 8 * j2); }
    gla_vT_store(F, ve, vT);
#pragma unroll
    for (int dr = 0; dr < 2; ++dr) {
        float bv[16];
        (void)gla_decay(F, dr, pre[dr], gsc, tot, bv);
#pragma unroll
        for (int tt = 0; tt < 16; ++tt) {
            const int tau = 16 * tq + tt;
            qb[tau * QST + c] = (bf16_t)f2bf(qf[tt] * __expf(bv[tt]));
            kb[tau * QST + c] = (bf16_t)f2bf(kf[tt] * __expf(-bv[tt]));
        }
        LDS_BAR();
        if (w < 4) {
            const int mi = w >> 1, nj = w & 1;
            f32x16 sc;
#pragma unroll
            for (int r = 0; r < 16; ++r) sc[r] = 0.f;
#pragma unroll
            for (int ks = 0; ks < 8; ++ks) {
                const bf16x8 a = *(const LAS bf16x8*)(qb + (32 * mi + l31) * QST + 16 * ks + 8 * hi);
                const bf16x8 bb = *(const LAS bf16x8*)(kb + (32 * nj + l31) * QST + 16 * ks + 8 * hi);
                sc = MFMA32(a, bb, sc);
            }
#pragma unroll
            for (int r = 0; r < 16; ++r) { const int i = 32 * mi + crow32(r, hi), j = 32 * nj + l31;
                const bool keep = dr ? (j > i) : (j <= i);
                P[i * KST + j] = (bf16_t)f2bf(keep ? sc[r] : 0.f); }
        } else {
        }
#pragma unroll
        for (int ks = 0; ks < 8; ++ks) {
#pragma unroll
            for (int mi = 0; mi < 2; ++mi) { const bf16x8 a = *(const LAS bf16x8*)(qb + (32 * mi + l31) * QST + 16 * ks + 8 * hi); oacc[mi] = MFMA32(a, sfr[dr][ks], oacc[mi]); }
        }
        LDS_BAR();
#pragma unroll
        for (int mi = 0; mi < 2; ++mi) {
#pragma unroll
            for (int ks = 0; ks < 4; ++ks) {
                const bf16x8 a = *(const LAS bf16x8*)(P + (32 * mi + l31) * KST + 16 * ks + 8 * hi);
                const bf16x8 bb = *(const LAS bf16x8*)(vT + (32 * w + l31) * KST + 16 * ks + 8 * hi);
                oacc[mi] = MFMA32(a, bb, oacc[mi]);
            }
        }
        LDS_BAR();
    }
#pragma unroll
    for (int mi = 0; mi < 2; ++mi)
#pragma unroll
        for (int r = 0; r < 16; ++r) ot[(32 * mi + crow32(r, hi)) * 260 + 32 * w + l31] = oacc[mi][r];
    LDS_BAR();
    {
        const int i = F.tid >> 3, seg = F.tid & 7;
        const LAS f32x4* orow = (const LAS f32x4*)(ot + i * 260 + 32 * seg);
        f32x4 v[8]; float ss = 0.f;
#pragma unroll
        for (int j = 0; j < 8; ++j) { v[j] = orow[j]; ss += (v[j].x * v[j].x + v[j].y * v[j].y) + (v[j].z * v[j].z + v[j].w * v[j].w); }
        ss += __shfl_xor(ss, 1); ss += __shfl_xor(ss, 2); ss += __shfl_xor(ss, 4);
        const float rstd = rsqrtf(ss * (1.f / GDV) + EPS);
        const size_t o = (size_t)(rowbase + i) * GVW + h * GDV + 32 * seg;
        unsigned char* OG = F.ws + WS_OG;
        const float* gnw = F.in[I_GNW] + 32 * seg; f32x4 wv[8];
#pragma unroll
        for (int j2 = 0; j2 < 8; ++j2) wv[j2] = *(const GAS f32x4*)(gnw + 4 * j2);
#pragma unroll
        for (int j2 = 0; j2 < 4; ++j2) {
            f32x4 g0, g1; unpack8(gov[j2], g0, g1);
            const f32x4 a0 = v[2 * j2] * rstd * wv[2 * j2] * g0, a1 = v[2 * j2 + 1] * rstd * wv[2 * j2 + 1] * g1;
            unsigned w0 = 0, w1 = 0;
            w0 = __builtin_amdgcn_cvt_pk_fp8_f32(a0.x, a0.y, w0, false); w0 = __builtin_amdgcn_cvt_pk_fp8_f32(a0.z, a0.w, w0, true);
            w1 = __builtin_amdgcn_cvt_pk_fp8_f32(a1.x, a1.y, w1, false); w1 = __builtin_amdgcn_cvt_pk_fp8_f32(a1.z, a1.w, w1, true);
            *(GAS v2u*)(OG + o + 8 * j2) = (v2u){w0, w1};
        }
    }
    LDS_BAR();
}

DI void p9_route(Frame& F) {
    const float* MOD = (const float*)(F.ws + WS_MOD);
    const bf16_t* X1 = (const bf16_t*)(F.ws + WS_X1);
    bf16_t* T2 = (bf16_t*)(F.ws + WS_T2);
    const bf16_t* RT = (const bf16_t*)(F.ws + WS_ROUT_T);
    unsigned* cnt = (unsigned*)(F.ws + WS_CTL) + CW_CNT;
    int* list = (int*)(F.ws + WS_ROUTE + ROUTE_LIST);
    int* eidx = (int*)(F.ws + WS_ROUTE + ROUTE_EIDX); int* slot = (int*)(F.ws + WS_ROUTE + ROUTE_SLOT); float* wts = (float*)(F.ws + WS_ROUTE + ROUTE_WTS);
    LAS float* lg = (LAS float*)(F.lds + 65536);
    LAS unsigned* hist = (LAS unsigned*)(F.lds + 65536 + 8192);
    LAS unsigned* hbase = hist + 64;
    LAS float* wcv = (LAS float*)(F.lds + 132096); LAS float* shv = wcv + 2048;
    const int lane = F.lane;
    for (int tile = F.bid; tile < T / 32; tile += F.G) {
        bf16x8 bfA[16][1]; skinny_bload<1>(bfA, RT, F.wave, lane);
        {
            v4u ra[4], rb[4];
            auto load = [&](v4u (&r)[4], int lr) { const bf16_t* xr = X1 + (size_t)(tile * 32 + lr) * D + 8 * lane;
#pragma unroll
                for (int j = 0; j < 4; ++j) r[j] = *(const GAS v4u*)(xr + 512 * j); };
            auto finish = [&](const v4u (&r)[4], int lr) { const int row = tile * 32 + lr;
                f32x4 v[8]; float ss = 0.f;
#pragma unroll
                for (int j = 0; j < 4; ++j) { unpack8(r[j], v[2 * j], v[2 * j + 1]);
                    ss += (v[2 * j].x * v[2 * j].x + v[2 * j].y * v[2 * j].y) + (v[2 * j].z * v[2 * j].z + v[2 * j].w * v[2 * j].w) + (v[2 * j + 1].x * v[2 * j + 1].x + v[2 * j + 1].y * v[2 * j + 1].y) + (v[2 * j + 1].z * v[2 * j + 1].z + v[2 * j + 1].w * v[2 * j + 1].w); }
                const float rstd = rsqrtf(wave_sum(ss) * (1.f / 2048.f) + EPS);
#pragma unroll
                for (int j = 0; j < 4; ++j) { const int col = 8 * lane + 512 * j;
                    f32x4 y[2];
#pragma unroll
                    for (int q = 0; q < 2; ++q) { const f32x4 wc = *(const LAS f32x4*)(wcv + col + 4 * q), a = *(const LAS f32x4*)(shv + col + 4 * q);
                        y[q] = (v[2 * j + q] * rstd) * wc + a; }
                    unsigned w0 = 0, w1 = 0;
                    w0 = __builtin_amdgcn_cvt_pk_fp8_f32(y[0].x, y[0].y, w0, false); w0 = __builtin_amdgcn_cvt_pk_fp8_f32(y[0].z, y[0].w, w0, true);
                    w1 = __builtin_amdgcn_cvt_pk_fp8_f32(y[1].x, y[1].y, w1, false); w1 = __builtin_amdgcn_cvt_pk_fp8_f32(y[1].z, y[1].w, w1, true);
                    *(GAS v2u*)((unsigned char*)T2 + (size_t)row * D + col) = (v2u){w0, w1};
                    *(LAS v4u*)((LAS bf16_t*)F.lds + lr * AST + col) = (v4u){pk2(y[0].x, y[0].y), pk2(y[0].z, y[0].w), pk2(y[1].x, y[1].y), pk2(y[1].z, y[1].w)}; } };
            const int lr0 = 4 * F.wave;
            load(ra, lr0);
            load(rb, lr0 + 1);
            {
                const float* mr = MOD + (size_t)((tile * 32) / SEQ) * (NMOD * D); const int c4 = 4 * F.tid;
                const f32x4 w = *(const GAS f32x4*)(F.in[I_N2W] + c4), a = *(const GAS f32x4*)(mr + 3 * D + c4), c = *(const GAS f32x4*)(mr + 4 * D + c4);
                *(LAS f32x4*)(wcv + c4) = w * (c + 1.0f); *(LAS f32x4*)(shv + c4) = a;
                __syncthreads();
            }
            finish(ra, lr0);
            load(ra, lr0 + 2); finish(rb, lr0 + 1);
            load(rb, lr0 + 3); finish(ra, lr0 + 2);
            finish(rb, lr0 + 3);
        }
        __syncthreads();
        f32x16 acc[2];
#pragma unroll
        for (int j = 0; j < 2; ++j)
#pragma unroll
            for (int r = 0; r < 16; ++r) acc[j][r] = 0.f;
        { f32x16 a0[1] = {acc[0]}, a1[1] = {acc[1]};
          skinny_gemm<1>(F.lds, bfA, a0, F.wave, lane);
          asm volatile("" ::: "memory");
          skinny_bload<1>(bfA, RT + (size_t)32 * 2048, F.wave, lane);
          skinny_gemm<1>(F.lds, bfA, a1, F.wave, lane);
          acc[0] = a0[0]; acc[1] = a1[0]; }
        __syncthreads();
        LAS float* red = (LAS float*)F.lds;
        skinny_store_partial<2>(red, acc, F.wave, lane);
        if (F.tid < 64) hist[F.tid] = 0u;
        __syncthreads();
        for (int o = F.tid; o < 32 * 64; o += 512) { float s = 0.f;
#pragma unroll
            for (int w = 0; w < 8; ++w) s += red[w * 2048 + o];
            lg[o] = s; }
        __syncthreads();
        int loc[4]; int rk[4]; float sw[4];
        const float rb = F.in[I_RB][lane];
#pragma unroll
        for (int rr = 0; rr < 4; ++rr) {
            const int lr = 4 * F.wave + rr;
            const float s = 1.0f / (1.0f + expf(-lg[lr * 64 + lane]));
            const float ch = s + rb;
            float m1 = ch; m1 = fmaxf(m1, __shfl_xor(m1, 1)); m1 = fmaxf(m1, __shfl_xor(m1, 2)); m1 = fmaxf(m1, __shfl_xor(m1, 4));
            const unsigned long long eq = __ballot(ch == m1);
            const int gshift = lane & ~7;
            const int first = __builtin_ctzll((eq >> gshift) & 0xffull) + gshift;
            float m2 = (lane == first) ? -INFINITY : ch; m2 = fmaxf(m2, __shfl_xor(m2, 1)); m2 = fmaxf(m2, __shfl_xor(m2, 2)); m2 = fmaxf(m2, __shfl_xor(m2, 4));
            const float gs = m1 + m2; const int mygrp = lane >> 3;
            int grank = 0;
#pragma unroll
            for (int gg = 0; gg < 8; ++gg) { const float og = __int_as_float(__builtin_amdgcn_readlane(__float_as_int(gs), gg * 8)); grank += (og > gs || (og == gs && gg < mygrp)) ? 1 : 0; }
            const float cm = (grank < TOPKG) ? ch : -INFINITY;
            int erank = 0;
#pragma unroll
            for (int e2 = 0; e2 < 64; ++e2) { const float oc = __int_as_float(__builtin_amdgcn_readlane(__float_as_int(cm), e2)); erank += (oc > cm || (oc == cm && e2 < lane)) ? 1 : 0; }
            const bool sel = erank < TOPK;
            const float ssum = wave_sum(sel ? s : 0.f);
            rk[rr] = sel ? erank : -1;
            sw[rr] = s / ssum * 2.5f;
            loc[rr] = sel ? (int)__hip_atomic_fetch_add(&hist[lane], 1u, __ATOMIC_RELAXED, __HIP_MEMORY_SCOPE_WORKGROUP) : 0;
        }
        __syncthreads();
        if (F.tid < 64) hbase[F.tid] = atomicAdd(&cnt[16 * F.tid], hist[F.tid]);
        __syncthreads();
#pragma unroll
        for (int rr = 0; rr < 4; ++rr) {
            const int row = tile * 32 + 4 * F.wave + rr;
            if (rk[rr] >= 0) {
                const int pos = (int)hbase[lane] + loc[rr];
                list[(size_t)lane * T + pos] = row;
                eidx[row * 8 + rk[rr]] = lane; slot[row * 8 + rk[rr]] = pos; wts[row * 8 + rk[rr]] = sw[rr];
            }
            if (lane == 0) list[(size_t)64 * T + row] = row;
        }
        __syncthreads();
    }
}

DI void p12_combine(Frame& F, volatile LAS int* tbv) {
    const float* MOD = (const float*)(F.ws + WS_MOD);
    const bf16_t* X1 = (const bf16_t*)(F.ws + WS_X1);
    const unsigned char* YB8 = F.ws + WS_YBUF;
    const int* eidx = (const int*)(F.ws + WS_ROUTE + ROUTE_EIDX); const int* slot = (const int*)(F.ws + WS_ROUTE + ROUTE_SLOT); const float* wts = (const float*)(F.ws + WS_ROUTE + ROUTE_WTS);
    const float* fnw = F.in[I_FNW];
    const int lane = F.lane;
    const LAS int* tb = (const LAS int*)tbv;
    f32x4 fw[8];
#pragma unroll
    for (int j = 0; j < 4; ++j) { fw[2 * j] = *(const GAS f32x4*)(fnw + 8 * lane + 512 * j); fw[2 * j + 1] = *(const GAS f32x4*)(fnw + 8 * lane + 512 * j + 4); }
    const int hbsh = tb[MT_HB + 64];
    for (int row = F.bid * 8 + F.wave; row < T; row += F.G * 8) {
        const float* g2 = MOD + (size_t)(row / SEQ) * (NMOD * D) + 5 * D;
        int e = 64, sl = row; float w = 1.f;
        if (lane < 8) { e = eidx[row * 8 + lane]; sl = slot[row * 8 + lane]; w = wts[row * 8 + lane]; }
        const int yrow = tb[MT_HB + e] + sl;
        unsigned ro[9]; float wk[9];
#pragma unroll
        for (int k = 0; k < 9; ++k) { ro[k] = (unsigned)__builtin_amdgcn_readlane(yrow, k); wk[k] = __builtin_bit_cast(float, __builtin_amdgcn_readlane(__builtin_bit_cast(int, w), k)); }
        f32x4 x2[8]; float ss = 0.f;
#pragma unroll
        for (int jp = 0; jp < 2; ++jp) {
            v2u y[2][9]; v4u xw[2]; f32x4 xa[2], xb[2], ga[2], gb[2];
#pragma unroll
            for (int jj = 0; jj < 2; ++jj) {
                const int col = 8 * lane + 512 * (2 * jp + jj);
#pragma unroll
                for (int k = 0; k < 9; ++k) y[jj][k] = __builtin_nontemporal_load((const GAS v2u*)(YB8 + (size_t)ro[k] * D + col));
                xw[jj] = *(const GAS v4u*)(X1 + (size_t)row * D + col);
                ga[jj] = *(const GAS f32x4*)(g2 + col); gb[jj] = *(const GAS f32x4*)(g2 + col + 4);
            }
#pragma unroll
            for (int jj = 0; jj < 2; ++jj) {
                const int j = 2 * jp + jj;
                unpack8(xw[jj], xa[jj], xb[jj]);
                f32x4 a0 = (f32x4){0.f, 0.f, 0.f, 0.f}, a1 = a0;
#pragma unroll
                for (int k = 0; k < 9; ++k) {
                    const f32x2 p0 = __builtin_amdgcn_cvt_pk_f32_fp8(y[jj][k].x, false), p1 = __builtin_amdgcn_cvt_pk_f32_fp8(y[jj][k].x, true);
                    const f32x2 p2 = __builtin_amdgcn_cvt_pk_f32_fp8(y[jj][k].y, false), p3 = __builtin_amdgcn_cvt_pk_f32_fp8(y[jj][k].y, true);
                    a0 += (f32x4){p0.x, p0.y, p1.x, p1.y} * wk[k]; a1 += (f32x4){p2.x, p2.y, p3.x, p3.y} * wk[k]; }
                x2[2 * j] = xa[jj] + ga[jj] * a0; x2[2 * j + 1] = xb[jj] + gb[jj] * a1;
                ss += (x2[2 * j].x * x2[2 * j].x + x2[2 * j].y * x2[2 * j].y) + (x2[2 * j].z * x2[2 * j].z + x2[2 * j].w * x2[2 * j].w);
                ss += (x2[2 * j + 1].x * x2[2 * j + 1].x + x2[2 * j + 1].y * x2[2 * j + 1].y) + (x2[2 * j + 1].z * x2[2 * j + 1].z + x2[2 * j + 1].w * x2[2 * j + 1].w);
            }
            asm volatile("" ::: "memory");
        }
        const float rstd = rsqrtf(wave_sum(ss) * (1.f / D) + EPS);
#pragma unroll
        for (int j = 0; j < 4; ++j) {
            const int col = 8 * lane + 512 * j;
            __builtin_nontemporal_store(x2[2 * j] * rstd * fw[2 * j], (GAS f32x4*)(F.out + (size_t)row * D + col));
            __builtin_nontemporal_store(x2[2 * j + 1] * rstd * fw[2 * j + 1], (GAS f32x4*)(F.out + (size_t)row * D + col + 4));
        }
    }
}

constexpr int NPHASE = 13;
__global__ void __launch_bounds__(512, 2) hyb_fwd(Args args) {
    extern __shared__ __attribute__((aligned(16))) unsigned char lds[];
    Frame F;
    F.lds = (LAS unsigned char*)lds; F.ws = args.ws; F.in = args.in; F.out = args.out;
    F.tid = threadIdx.x; F.lane = F.tid & 63; F.wave = __builtin_amdgcn_readfirstlane(F.tid >> 6); F.G = gridDim.x; F.bid = blockIdx.x;
    volatile LAS unsigned* MISC = (volatile LAS unsigned*)(F.lds + MISC_OFF);
    volatile LAS int* mtb = (volatile LAS int*)(F.lds + MISC_OFF + 256);
    for (int u = F.tid; u < (LDS_BYTES - MISC_OFF) / 4; u += 512) MISC[u] = 0u;
    __syncthreads();
    unsigned char* ws = args.ws;
    unsigned* ctl = (unsigned*)(ws + WS_CTL);
    const int lo = args.ph_lo, hi = args.ph_hi;
    const bool multi = (hi - lo) > 1;
    XcdBarrier bar; bar.bar = ctl + CW_BAR; bar.x = 0; bar.st = nullptr;
    if (multi) bar = xcd_barrier_post(ctl + CW_BAR, MISC + 8);
#ifndef PHMASK
#define PHMASK 0x1fff
#endif
#define IN(k) ((((PHMASK) >> (k)) & 1) && lo <= (k) && (k) < hi)
#define SEAM(k) do { if (IN(k) && IN((k) + 1)) xcd_barrier(bar); } while (0)
#ifndef REPMASK
#define REPMASK 0
#endif
#ifndef REPPART
#define REPPART 3
#endif
#define REP(k) for (int rep_ = 0; rep_ < 1 + (((REPMASK) >> (k)) & 1); ++rep_, (rep_ < 1 + (((REPMASK) >> (k)) & 1) && multi) ? (xcd_barrier(bar), 0) : 0)

    if (IN(0)) REP(0) { p0_prologue(F); }
    SEAM(0);
    if (IN(1)) REP(1) { p1_norm1(F); }
    SEAM(1);
    if (IN(2)) REP(2) {
        if (F.bid & 1) p0_convert(F, 0, NP_EXPERT);
        { G1Order S{(const bf16_t*)(ws + WS_H), (const bf16_t*)(ws + WS_WIN_T), F.G, F.bid}; EpiG1 E{ws};
          pg8::gemm_phase<EpiG1, G1Order, false>(F.lds, D, S, E); }
        { G1Order8 S{ws + WS_H8, ws + WS_WIN8, F.G, F.bid}; EpiG1 E{ws};
          pg8::gemm_phase<EpiG1, G1Order8, false, 1>(F.lds, D, S, E); }
        if (!(F.bid & 1)) p0_convert(F, 0, NP_EXPERT);
    }
    SEAM(2);
    if (IN(3)) REP(3) {
        if (!rep_ || ((REPPART) & 1)) for (int it = F.bid; it < NB * GH * NCH; it += F.G) { const int n = it % NCH, h = (it / NCH) % GH, b = it / (NCH * GH); gla_state_item(F, b, h, n); }
        if (!rep_ || ((REPPART) & 2)) s5_phase<false>(F);
    }
    SEAM(3);
    if (IN(4)) REP(4) { s5_carry(F); gla_carry(F); }
    SEAM(4);
    if (IN(5)) REP(5) {
        if (!rep_ || ((REPPART) & 1)) for (int it = F.bid; it < NB * GH * NCHL; it += F.G) { const int nl = it % NCHL, h = (it / NCHL) % GH, b = it / (NCHL * GH); gla_out_item(F, b, h, nl); }
        if (!rep_ || ((REPPART) & 2)) s5_phase<true>(F);
    }
    SEAM(5);
    if (IN(6)) REP(6) {
        DenseOrder8 S{ws + WS_YS8, ws + WS_GLU_T, 32, 4, 1024, F.G, F.bid, true};
        EpiEw<0> E{(bf16_t*)(ws + WS_S5G), (const bf16_t*)(ws + WS_YS), 1024};
        pg8::gemm_phase<EpiEw<0>, DenseOrder8, false, 1>(F.lds, 1024, S, E);
    }
    SEAM(6);
    if (IN(7)) REP(7) {
        MergeOrder S{ws + WS_S5G, ws + WS_S5P_T, ws + WS_OG, ws + WS_GLAP_T, F.G, F.bid};
        EpiMerge64 E{(bf16_t*)(ws + WS_M), (const bf16_t*)(ws + WS_GS), (const bf16_t*)(ws + WS_GG), ws + WS_M8};
        pg8::gemm_phase<EpiMerge64, MergeOrder, false, 1, true, true, 0, true>(F.lds, 1024, S, E);
    }
    SEAM(7);
    if (IN(8)) REP(8) {
        DenseOrder8 S{ws + WS_M8, ws + WS_WOUT_T, 32, 8, 2048, F.G, F.bid, false};
        EpiOut E{F.in[I_X], (const float*)(ws + WS_MOD), (bf16_t*)(ws + WS_X1)};
        pg8::gemm_phase<EpiOut, DenseOrder8, false, 1>(F.lds, 2048, S, E);
    }
    SEAM(8);
    if (IN(9)) REP(9) { p9_route(F); }
    SEAM(9);
    if (IN(10)) REP(10) {
        moe_tables(F, mtb); moe_unit_list<4>(F, mtb);
        MoeOrder<4, 1> S{mtb, ws + WS_T2, ws + WS_WGU_T, (const int*)(ws + WS_ROUTE + ROUTE_LIST), 2048, F.G, F.bid};
        EpiGU E{ws + WS_HID};
        pg8::gemm_phase<EpiGU, MoeOrder<4, 1>, true, 1, true, true, 1024>(F.lds, 2048, S, E);
    }
    SEAM(10);
    if (IN(11)) REP(11) {
        moe_tables(F, mtb); moe_unit_list<8>(F, mtb);
        MoeOrder<8, 1> S{mtb, ws + WS_HID, ws + WS_WD_T, nullptr, 512, F.G, F.bid};
        EpiY8 E{ws + WS_YBUF, 2048};
        pg8::gemm_phase<EpiY8, MoeOrder<8, 1>, false, 1, true, true, 2048, true>(F.lds, 512, S, E);
    }
    SEAM(11);
    if (IN(12)) REP(12) { moe_tables(F, mtb); p12_combine(F, mtb); }
#undef IN
#undef SEAM
}

extern "C" void kernel_launch(void* const* d_in, const int* in_sizes, int n_in, void* d_out, int out_size, void* d_ws, size_t ws_size, hipStream_t stream) {
    static int grid = 0;
    if (grid == 0) {
        if (n_in != NIN || out_size != T * D || ws_size < WS_END) { fprintf(stderr, "kernel_launch: unexpected shapes (n_in %d out %d ws %zu need %zu)\n", n_in, out_size, ws_size, (size_t)WS_END); grid = -1; return; }
        int dev = 0, cus = 0, per_cu = 0;
        if (hipGetDevice(&dev) != hipSuccess || hipDeviceGetAttribute(&cus, hipDeviceAttributeMultiprocessorCount, dev) != hipSuccess) { grid = -1; return; }
        if (hipFuncSetAttribute((const void*)hyb_fwd, hipFuncAttributeMaxDynamicSharedMemorySize, LDS_BYTES) != hipSuccess) { fprintf(stderr, "kernel_launch: hipFuncSetAttribute failed\n"); grid = -1; return; }
        if (hipOccupancyMaxActiveBlocksPerMultiprocessor(&per_cu, (const void*)hyb_fwd, 512, LDS_BYTES) != hipSuccess || per_cu < 1) { fprintf(stderr, "kernel_launch: occupancy query says %d\n", per_cu); }
        (void)hipGetLastError();
        grid = cus & ~15;
    }
    if (grid < 0) return;
    (void)hipMemsetAsync((char*)d_ws + WS_CTL, 0, CTL_ZERO_BYTES, stream);
    Args a{};
    for (int i = 0; i < NIN; ++i) a.in[i] = (const float*)d_in[i];
    a.out = (float*)d_out; a.ws = (unsigned char*)d_ws;
#if MK_N_LAUNCHES == 1
    a.ph_lo = 0; a.ph_hi = NPHASE;
    hipLaunchKernelGGL(hyb_fwd, dim3(grid), dim3(512), LDS_BYTES, stream, a);
#else
    for (int p = 0; p < NPHASE; ++p) { a.ph_lo = p; a.ph_hi = p + 1; hipLaunchKernelGGL(hyb_fwd, dim3(grid), dim3(512), LDS_BYTES, stream, a); }
#endif
}
```

```cpp
#include <hip/hip_runtime.h>
#include <cstdio>
#include <cstdint>

#ifndef MK_N_LAUNCHES
#define MK_N_LAUNCHES 1
#endif

constexpr int D = 2048, NB = 4, SEQ = 2048, CTX = 256;
constexpr int T = NB * SEQ;
constexpr int TC = NB * CTX;
constexpr int TA = T + TC;
constexpr int NMOD = 6;
constexpr int S5W = 1024, S5G_ = 16, S5NG = 64, S5P = 64;
constexpr int GH = 4, GKW = 512, GVW = 1024, GDK = 128, GDV = 256, GRANK = 16, GCH = 64;
constexpr int INW = 8224;
constexpr int NE = 64, TOPK = 8, NGRP = 8, TOPKG = 4, DEXP = 512;
constexpr float EPS = 1e-6f;
constexpr int NCH = (SEQ + CTX) / GCH;
constexpr int NCHC = CTX / GCH;
constexpr int NCHL = SEQ / GCH;
constexpr int HIDROWS = 90112;

constexpr size_t MiB = 1u << 20;
constexpr size_t WS_CTL = 0, CTL_ZERO_BYTES = 65536;
constexpr size_t WS_MOD = 1 * MiB;
constexpr size_t WS_S5TAB = 2 * MiB;
constexpr size_t S5TAB_LAM = 0, S5TAB_LAM64 = 65536, S5TAB_BT = 131072, S5TAB_CT = 131072 + 524288;
constexpr size_t WS_ROUT_T = 4 * MiB;
constexpr size_t WS_ROUTE = 5 * MiB;
constexpr size_t ROUTE_LIST = 0, ROUTE_EIDX = 3 * MiB, ROUTE_SLOT = 3 * MiB + 262144, ROUTE_WTS = 3 * MiB + 524288;
constexpr size_t WS_WGU_T = 9 * MiB;
constexpr size_t WS_WD_T = 269 * MiB;
constexpr size_t WS_X1 = 399 * MiB;
constexpr size_t WS_AB = 463 * MiB;
constexpr size_t WS_WIN_T = WS_AB + 0 * MiB;
constexpr size_t WS_WGKD_T = WS_AB + 32 * MiB;
constexpr size_t WS_GLU_T = WS_AB + 33 * MiB;
constexpr size_t WS_S5P_T = WS_AB + 35 * MiB;
constexpr size_t WS_GLAP_T = WS_AB + 39 * MiB;
constexpr size_t WS_WOUT_T = WS_AB + 43 * MiB;
constexpr size_t WS_H = WS_AB + 51 * MiB;
constexpr size_t WS_GKD = WS_AB + 87 * MiB;
constexpr size_t WS_U = WS_AB + 89 * MiB;
constexpr size_t WS_KK = WS_AB + 107 * MiB;
constexpr size_t WS_V = WS_AB + 116 * MiB;
constexpr size_t WS_Q = WS_AB + 134 * MiB;
constexpr size_t WS_GO = WS_AB + 142 * MiB;
constexpr size_t WS_GS = WS_AB + 158 * MiB;
constexpr size_t WS_GG = WS_AB + 190 * MiB;
constexpr size_t WS_S5ST = WS_AB + 222 * MiB;
constexpr size_t WS_GST = WS_AB + 232 * MiB;
constexpr size_t WS_GDEC = WS_AB + 304 * MiB;
constexpr size_t WS_YS = WS_AB + 305 * MiB;
constexpr size_t WS_OG = WS_AB + 321 * MiB;
constexpr size_t WS_YS8 = WS_AB + 329 * MiB;
constexpr size_t WS_S5G = WS_AB + 337 * MiB;
constexpr size_t WS_M = WS_AB + 353 * MiB;
constexpr size_t WS_M8 = WS_AB + 410 * MiB;
constexpr size_t WS_A_END = WS_AB + 385 * MiB;
constexpr size_t WS_T2 = WS_AB + 0 * MiB;
constexpr size_t WS_HID = WS_AB + 32 * MiB;
constexpr size_t WS_YBUF = WS_AB + 120 * MiB;
constexpr size_t WS_WIN8 = WS_WIN_T + 16 * MiB;
constexpr size_t WS_H8 = WS_AB + 390 * MiB;
constexpr size_t WS_END = WS_AB + 472 * MiB;
static_assert(WS_A_END <= WS_END, "ws map");

constexpr int CW_TMO = 0, CW_CODE = 1;
constexpr int CW_BAR = 4096;
constexpr int CW_CNT = 8192;

constexpr int SCR_BYTES = 155648;
constexpr int MISC_OFF = SCR_BYTES;
constexpr int LDS_BYTES = 163840;

#define GAS __attribute__((address_space(1)))
#define LAS __attribute__((address_space(3)))
typedef unsigned short bf16_t;
typedef unsigned v4u __attribute__((ext_vector_type(4)));
typedef unsigned v2u __attribute__((ext_vector_type(2)));
typedef float f32x2 __attribute__((ext_vector_type(2)));
typedef float f32x4 __attribute__((ext_vector_type(4)));
typedef float f32x16 __attribute__((ext_vector_type(16)));
typedef short bf16x8 __attribute__((ext_vector_type(8)));
typedef GAS unsigned gu32;

#define DI __device__ __forceinline__
#define LDS_WAIT() asm volatile("s_waitcnt lgkmcnt(0)" ::: "memory")
#define LDS_BAR() do { asm volatile("s_waitcnt lgkmcnt(0)" ::: "memory"); __builtin_amdgcn_s_barrier(); asm volatile("" ::: "memory"); } while (0)
#define VM_WAIT() asm volatile("s_waitcnt vmcnt(0)" ::: "memory")
#define RLX_AGENT __ATOMIC_RELAXED, __HIP_MEMORY_SCOPE_AGENT

typedef __bf16 bf16x2_hw __attribute__((ext_vector_type(2)));
DI unsigned pk2(float lo, float hi) { const f32x2 v = {lo, hi}; return __builtin_bit_cast(unsigned, __builtin_convertvector(v, bf16x2_hw)); }
DI unsigned f2bf(float f) { return pk2(f, 0.f) & 0xffffu; }
DI float bflo(unsigned w) { return __builtin_bit_cast(float, w << 16); }
DI float bfhi(unsigned w) { return __builtin_bit_cast(float, w & 0xffff0000u); }
DI float bf2f(bf16_t b) { return __builtin_bit_cast(float, ((unsigned)b) << 16); }
DI float sigmoidf_(float x) { return __builtin_amdgcn_rcpf(1.0f + __expf(-x)); }
DI float siluf_(float x) { return x * sigmoidf_(x); }
DI float wave_sum(float v) {
#pragma unroll
    for (int o = 1; o < 64; o <<= 1) v += __shfl_xor(v, o);
    return v;
}
DI int crow32(int r, int hi) { return (r & 3) + 8 * (r >> 2) + 4 * hi; }
#define MFMA32(a, b, c) __builtin_amdgcn_mfma_f32_32x32x16_bf16((a), (b), (c), 0, 0, 0)
#define MFMA16(a, b, c) __builtin_amdgcn_mfma_f32_16x16x32_bf16((a), (b), (c), 0, 0, 0)

namespace pg8 {
constexpr int BM = 256, BK = 64, HALF = 128, HTB = HALF * BK * 2, STAGE_BYTES = 8 * HTB;
DI int lds_byte(int r, int c) { const int st = (r >> 4) * 2 + (c >> 5), rr = r & 15, cc = c & 31, ob = rr * 64 + cc * 2; return st * 1024 + (ob ^ (((ob >> 9) & 1) << 5)); }
DI void stage_rc(int b, int& R, int& C) { const int st = b / 1024, sb = b % 1024, swz = sb ^ (((sb >> 9) & 1) << 5); R = (st >> 1) * 16 + swz / 64; C = (st & 1) * 32 + (swz % 64) / 2; }
DI int perm32(int rho) { const int n = rho >> 4, i = rho & 15; return 8 * (i >> 2) + 4 * n + (i & 3); }
DI unsigned cvt_pk_bf16(float lo, float hi) { unsigned r; asm volatile("v_cvt_pk_bf16_f32 %0, %1, %2" : "=v"(r) : "v"(lo), "v"(hi)); return r; }

typedef short v8i __attribute__((ext_vector_type(16)));
DI v8i ld32(const LAS unsigned char* p) { const bf16x8 lo = *(const LAS bf16x8*)p, hi = *(const LAS bf16x8*)(p + 16); return __builtin_shufflevector(lo, hi, 0, 1, 2, 3, 4, 5, 6, 7, 8, 9, 10, 11, 12, 13, 14, 15); }
constexpr int FP8_WSHIFT = 5;
constexpr int FP8_SCALE_W = 0x01010101 * (127 - FP8_WSHIFT);
constexpr int FP8_SCALE_A = 0x7f7f7f7f;
struct Unit {
    const char* a;
    const char* b;
    const int* idx;
    int nvalid;
    int pm, pn, e;
    int cb;
    int flags;
};

template <class Epi, class Sched, bool GATHER, int ES = 2, bool ALIGN_EPI = true, bool SP2 = true, int BKT = 0, bool P64 = false>
DI void gemm_phase(LAS unsigned char* lds, const int K, const Sched& S, const Epi& E) {
    const int tid = threadIdx.x, wid = __builtin_amdgcn_readfirstlane(tid >> 6), lane = tid & 63, wr = wid >> 2, wc = wid & 3, fr = lane & 15, fq = lane >> 4;
    const int nt = (K * ES) / 128;
    int Rr[2], Cc[2];
    unsigned voffB[2], vc[2][2], vn[2][2];
#pragma unroll
    for (int i = 0; i < 2; ++i) { int R, C; stage_rc(tid * 16 + i * 8192, R, C); const int Rb = P64 ? (2 * (R & ~31) + perm32(R & 31)) : (Epi::PERM ? ((R & ~31) + perm32(R & 31)) : R);
        Rr[i] = R; Cc[i] = C; voffB[i] = BKT ? ((unsigned)Rb * 128u + (unsigned)C * 2u) : ((unsigned)(Rb * K) * (unsigned)ES + (unsigned)C * 2u);
#pragma unroll
        for (int h = 0; h < 2; ++h) { vc[h][i] = (unsigned)((h * HALF + R) * K) * (unsigned)ES + (unsigned)C * 2u; vn[h][i] = vc[h][i]; } }
    const size_t kstep = (size_t)(BK * 2);
    const size_t hstep = (size_t)HALF * K * ES;
    const size_t kstepB = BKT ? (size_t)BKT * 128 : kstep, hstepB = (size_t)(P64 ? 32 : HALF) * (BKT ? (size_t)128 : (size_t)K * ES);
    const unsigned ldsw = (unsigned)wid * 1024u;
    const int aoff = lds_byte(wr * 64 + fr, (ES == 2 ? 8 : 16) * fq), boff = lds_byte(wc * 32 + fr, (ES == 2 ? 8 : 16) * fq);
#define PG8_SA(b, h) (((b) * 2 + (h)) * HTB)
#define PG8_SB(b, h) ((4 + (b) * 2 + (h)) * HTB)
#define PG8_STAGE_B(bufoff, gbase) do { _Pragma("unroll") for (int _i = 0; _i < 2; ++_i) \
        __builtin_amdgcn_global_load_lds((const unsigned*)((const char*)(gbase) + voffB[_i]), (LAS unsigned*)(lds + (bufoff) + ldsw + _i * 8192), 16, 0, 0); } while (0)
#define PG8_STAGE_A(bufoff, gbase, h, usen) do { _Pragma("unroll") for (int _i = 0; _i < 2; ++_i) \
        __builtin_amdgcn_global_load_lds((const unsigned*)((const char*)(gbase) + ((usen) ? vn[h][_i] : vc[h][_i])), (LAS unsigned*)(lds + (bufoff) + ldsw + _i * 8192), 16, 0, 0); } while (0)
#define PG8_LDA(dst, b, h) do { if constexpr (ES == 2) { _Pragma("unroll") for (int m = 0; m < 4; ++m) _Pragma("unroll") for (int k = 0; k < 2; ++k) dst[m][k] = *(const LAS bf16x8*)(lds + PG8_SA(b, h) + aoff + m * 2048 + k * 1024); } \
        else { _Pragma("unroll") for (int m = 0; m < 4; ++m) dst##8[m] = ld32(lds + PG8_SA(b, h) + aoff + m * 2048); } } while (0)
#define PG8_LDB(dst, b, h) do { if constexpr (ES == 2) { _Pragma("unroll") for (int n = 0; n < 2; ++n) _Pragma("unroll") for (int k = 0; k < 2; ++k) dst[n][k] = *(const LAS bf16x8*)(lds + PG8_SB(b, h) + boff + n * 2048 + k * 1024); } \
        else { _Pragma("unroll") for (int n = 0; n < 2; ++n) dst##8[n] = ld32(lds + PG8_SB(b, h) + boff + n * 2048); } } while (0)
#define PG8_MMA(ai, bj, At, Bt) do { __builtin_amdgcn_s_setprio(1); _Pragma("unroll") for (int m = 0; m < 4; ++m) _Pragma("unroll") for (int n = 0; n < 2; ++n) { \
        if constexpr (ES == 2) { _Pragma("unroll") for (int k = 0; k < 2; ++k) acc[ai][bj][m][n] = __builtin_amdgcn_mfma_f32_16x16x32_bf16(Bt[n][k], At[m][k], acc[ai][bj][m][n], 0, 0, 0); } \
        else { asm volatile("v_mfma_scale_f32_16x16x128_f8f6f4 %0, %1, %2, %0, %3, %4 op_sel_hi:[0,0,0]" : "+v"(acc[ai][bj][m][n]) : "v"(Bt##8[n]), "v"(At##8[m]), "v"(sc_w), "v"(sc_a)); } } \
        __builtin_amdgcn_s_setprio(0); } while (0)
#define PG8_WAIT_V(n) asm volatile("s_waitcnt vmcnt(" #n ")" ::: "memory")
#define PG8_WAIT_L(n) asm volatile("s_waitcnt lgkmcnt(" #n ")" ::: "memory")
#define PG8_BAR __builtin_amdgcn_s_barrier()
#define PG8_SCHED __builtin_amdgcn_sched_barrier(0)
    Unit cur, nxt; int ui = 0;
    if (!S.next(0, cur)) return;
    f32x4 acc[2][2][4][2];
#pragma unroll
    for (int a = 0; a < 2; ++a)
#pragma unroll
        for (int b = 0; b < 2; ++b)
#pragma unroll
            for (int m = 0; m < 4; ++m)
#pragma unroll
                for (int n = 0; n < 2; ++n) acc[a][b][m][n] = (f32x4){0.f, 0.f, 0.f, 0.f};
    bf16x8 At[4][2], B0[2][2], B1[2][2];
    v8i At8[4], B08[2], B18[2];
    int sc_w = FP8_SCALE_W, sc_a = FP8_SCALE_A;
    asm volatile("" : "+v"(sc_w), "+v"(sc_a));
    const char* cA = cur.a; const char* cB = cur.b;
    if constexpr (GATHER) {
#pragma unroll
        for (int h = 0; h < 2; ++h)
#pragma unroll
            for (int i = 0; i < 2; ++i) { const int r = h * HALF + Rr[i]; const int row = (r < cur.nvalid) ? cur.idx[r] : 0; vc[h][i] = (unsigned)(row * K) * (unsigned)ES + (unsigned)Cc[i] * 2u; }
    }
    if constexpr (SP2) {
        PG8_STAGE_B(PG8_SB(0, 0), cB); PG8_STAGE_B(PG8_SB(0, 1), cB + hstepB); PG8_STAGE_A(PG8_SA(0, 0), cA, 0, false); PG8_STAGE_A(PG8_SA(0, 1), cA, 1, false);
        if (wr == 1) PG8_BAR;
        PG8_WAIT_V(2); PG8_BAR;
        PG8_STAGE_B(PG8_SB(1, 0), cB + kstepB); PG8_STAGE_A(PG8_SA(1, 0), cA + kstep, 0, false); PG8_STAGE_B(PG8_SB(1, 1), cB + hstepB + kstepB);
        PG8_WAIT_V(6); PG8_BAR;
    } else {
        PG8_STAGE_B(PG8_SB(0, 0), cB); PG8_STAGE_A(PG8_SA(0, 0), cA, 0, false); PG8_STAGE_B(PG8_SB(0, 1), cB + hstepB); PG8_STAGE_A(PG8_SA(0, 1), cA, 1, false);
        if (wr == 1) PG8_BAR;
        PG8_WAIT_V(4); PG8_BAR;
        PG8_STAGE_B(PG8_SB(1, 0), cB + kstepB); PG8_STAGE_A(PG8_SA(1, 0), cA + kstep, 0, false); PG8_STAGE_B(PG8_SB(1, 1), cB + hstepB + kstepB);
        PG8_WAIT_V(6); PG8_BAR;
    }
    for (;;) {
        const bool has_next = S.next(ui + 1, nxt);
        const int fl = cur.flags;
        const char* nA = has_next ? nxt.a : cA; const char* nB = has_next ? nxt.b : cB;
        if constexpr (GATHER) {
            if (has_next) { if (wid == 0) __builtin_amdgcn_global_load_lds((const unsigned*)(nxt.idx + 4 * lane), (LAS unsigned*)(lds + STAGE_BYTES + ((ui + 1) & 1) * 1024), 16, 0, 0); }
            else {
#pragma unroll
                for (int h = 0; h < 2; ++h)
#pragma unroll
                    for (int i = 0; i < 2; ++i) vn[h][i] = vc[h][i];
            }
        }
        for (int t = 0; t < nt; t += 2) {
            const bool last = (t == nt - 2);
            const char* a1 = cA + (size_t)(t + 1) * kstep;
            const char* a2 = last ? nA : cA + (size_t)(t + 2) * kstep; const char* b2 = last ? nB : cB + (size_t)(t + 2) * kstepB;
            const char* a3 = a2 + kstep; const char* b3 = b2 + kstepB;
            const bool un = GATHER && last;
            if constexpr (GATHER) { if (last && has_next) {
                const LAS int* ib = (const LAS int*)(lds + STAGE_BYTES + ((ui + 1) & 1) * 1024);
#pragma unroll
                for (int h = 0; h < 2; ++h)
#pragma unroll
                    for (int i = 0; i < 2; ++i) { const int r = h * HALF + Rr[i]; const int row = (r < nxt.nvalid) ? ib[r] : 0; vn[h][i] = (unsigned)(row * K) * (unsigned)ES + (unsigned)Cc[i] * 2u; } } }
            if constexpr (SP2) {
            PG8_LDB(B0, 0, 0); PG8_LDB(B1, 0, 1); PG8_SCHED; PG8_LDA(At, 0, 0); PG8_STAGE_A(PG8_SA(1, 1), a1, 1, false);
            PG8_WAIT_V(8); PG8_WAIT_L(0); PG8_BAR; PG8_MMA(0, 0, At, B0); if (!(fl & 2)) PG8_MMA(0, 1, At, B1); PG8_BAR; PG8_SCHED;
            PG8_LDA(At, 0, 1); PG8_STAGE_B(PG8_SB(0, 0), b2); PG8_STAGE_B(PG8_SB(0, 1), b2 + hstepB); PG8_STAGE_A(PG8_SA(0, 0), a2, 0, un);
            PG8_WAIT_V(8); PG8_WAIT_L(0); PG8_BAR; if (!(fl & 1)) { PG8_MMA(1, 0, At, B0); if (!(fl & 2)) PG8_MMA(1, 1, At, B1); } PG8_BAR; PG8_SCHED;
            PG8_LDB(B0, 1, 0); PG8_LDB(B1, 1, 1); PG8_SCHED; PG8_LDA(At, 1, 0); PG8_STAGE_A(PG8_SA(0, 1), a2, 1, un);
            PG8_WAIT_V(8); PG8_WAIT_L(0); PG8_BAR; PG8_MMA(0, 0, At, B0); if (!(fl & 2)) PG8_MMA(0, 1, At, B1); PG8_BAR; PG8_SCHED;
            PG8_LDA(At, 1, 1); PG8_STAGE_B(PG8_SB(1, 0), b3); PG8_STAGE_B(PG8_SB(1, 1), b3 + hstepB); PG8_STAGE_A(PG8_SA(1, 0), a3, 0, un);
            PG8_WAIT_V(8); PG8_WAIT_L(0); PG8_BAR; if (!(fl & 1)) { PG8_MMA(1, 0, At, B0); if (!(fl & 2)) PG8_MMA(1, 1, At, B1); } PG8_BAR; PG8_SCHED;
            } else {
            PG8_LDB(B0, 0, 0); PG8_SCHED; PG8_LDA(At, 0, 0); PG8_STAGE_A(PG8_SA(1, 1), a1, 1, false);
            PG8_WAIT_L(8); PG8_BAR; PG8_WAIT_L(0); PG8_MMA(0, 0, At, B0); PG8_BAR; PG8_SCHED;
            PG8_LDB(B1, 0, 1); PG8_STAGE_B(PG8_SB(0, 0), b2);
            PG8_BAR; PG8_WAIT_L(0); PG8_MMA(0, 1, At, B1); PG8_BAR;
            PG8_LDA(At, 0, 1); PG8_STAGE_A(PG8_SA(0, 0), a2, 0, un);
            PG8_BAR; PG8_WAIT_L(0); PG8_MMA(1, 0, At, B0); PG8_BAR; PG8_SCHED;
            PG8_STAGE_B(PG8_SB(0, 1), b2 + hstepB);
            PG8_WAIT_V(6); PG8_BAR; PG8_MMA(1, 1, At, B1); PG8_BAR;
            PG8_LDB(B0, 1, 0); PG8_SCHED; PG8_LDA(At, 1, 0); PG8_STAGE_A(PG8_SA(0, 1), a2, 1, un);
            PG8_WAIT_L(8); PG8_BAR; PG8_WAIT_L(0); PG8_MMA(0, 0, At, B0); PG8_BAR; PG8_SCHED;
            PG8_LDB(B1, 1, 1); PG8_STAGE_B(PG8_SB(1, 0), b3);
            PG8_BAR; PG8_WAIT_L(0); PG8_MMA(0, 1, At, B1); PG8_BAR;
            PG8_LDA(At, 1, 1); PG8_STAGE_A(PG8_SA(1, 0), a3, 0, un);
            PG8_BAR; PG8_WAIT_L(0); PG8_MMA(1, 0, At, B0); PG8_BAR; PG8_SCHED;
            PG8_STAGE_B(PG8_SB(1, 1), b3 + hstepB);
            PG8_WAIT_V(6); PG8_BAR; PG8_MMA(1, 1, At, B1); PG8_BAR;
            }
        }
        if constexpr (ALIGN_EPI) { if (wr == 0) PG8_BAR; }
        if constexpr (ES == 1) asm volatile("s_nop 15\n\ts_nop 15" ::: "memory");
        E(acc, cur, wr, wc, fr, fq);
        if (!has_next) break;
#pragma unroll
        for (int a = 0; a < 2; ++a)
#pragma unroll
            for (int b = 0; b < 2; ++b)
#pragma unroll
                for (int m = 0; m < 4; ++m)
#pragma unroll
                    for (int n = 0; n < 2; ++n) acc[a][b][m][n] = (f32x4){0.f, 0.f, 0.f, 0.f};
        cur = nxt; cA = nA; cB = nB; ++ui;
        if constexpr (GATHER) {
#pragma unroll
            for (int h = 0; h < 2; ++h)
#pragma unroll
                for (int i = 0; i < 2; ++i) vc[h][i] = vn[h][i];
        }
        if constexpr (ALIGN_EPI) { if (wr == 1) PG8_BAR; }
    }
    PG8_WAIT_V(0);
    if constexpr (!ALIGN_EPI) { if (wr == 0) PG8_BAR; }
    PG8_BAR;
#undef PG8_SA
#undef PG8_SB
#undef PG8_STAGE_A
#undef PG8_STAGE_B
#undef PG8_LDA
#undef PG8_LDB
#undef PG8_MMA
#undef PG8_WAIT_V
#undef PG8_WAIT_L
#undef PG8_BAR
#undef PG8_SCHED
}
}

#define XB_TMO      128
#define XB_XCNT(j)  (256  + 64 * (j))
#define XB_XSUB(j)  (1280 + 64 * (j))
#define XB_XGEN(j)  (2304 + 64 * (j))
#define XB_TOP      3328
#define XB_TOPGEN   3392
#define XCD_BAR_WORDS 3456
#define XB_SPIN_CAP (1u << 18)
DI unsigned xb_ld(unsigned* p)              { return __hip_atomic_load(p, __ATOMIC_RELAXED, __HIP_MEMORY_SCOPE_AGENT); }
DI unsigned xb_add(unsigned* p, unsigned v) { return __hip_atomic_fetch_add(p, v, __ATOMIC_RELAXED, __HIP_MEMORY_SCOPE_AGENT); }
DI unsigned xb_xcc_id() { return (unsigned)__builtin_amdgcn_s_getreg((3 << 11) | 20) & 0xFu; }
#define XB_SPIN(cond, bar) do { unsigned _sp = 0; while (cond) { __builtin_amdgcn_s_sleep(1); \
    if ((++_sp & 255u) == 0u) { if (xb_ld(&(bar)[XB_TMO])) break; if (_sp > XB_SPIN_CAP) { atomicAdd(&(bar)[XB_TMO], 1u); break; } } } } while (0)
struct XcdBarrier { unsigned* bar; unsigned x; volatile LAS unsigned* st; };
DI XcdBarrier xcd_barrier_post(unsigned* bar, volatile LAS unsigned* st) {
    XcdBarrier b; b.bar = bar; b.x = xb_xcc_id(); b.st = st;
    if (threadIdx.x == 0) (void)xb_add(&bar[XB_XCNT(b.x)], 1u);
    return b;
}
DI void xcd_barrier_complete(unsigned* bar, unsigned x, unsigned& nloc, unsigned& nx) {
    const unsigned G = gridDim.x * gridDim.y * gridDim.z;
    unsigned sum, cnt, mine, sp = 0u;
    for (;;) {
        sum = 0u; cnt = 0u; mine = 0u;
#pragma unroll
        for (unsigned j = 0; j < 16; ++j) { const unsigned c = xb_ld(&bar[XB_XCNT(j)]); sum += c; cnt += (c > 0u) ? 1u : 0u; mine = (j == x) ? c : mine; }
        if (sum == G) break;
        __builtin_amdgcn_s_sleep(1);
        if ((++sp & 255u) == 0u) { if (xb_ld(&bar[XB_TMO])) break; if (sp > XB_SPIN_CAP) { atomicAdd(&bar[XB_TMO], 1u); break; } }
    }
    nloc = mine > 0u ? mine : 1u; nx = cnt > 0u ? cnt : 1u;
}
DI void xcd_barrier(const XcdBarrier& b) {
    asm volatile("s_waitcnt vmcnt(0)" ::: "memory");
    __syncthreads();
    if (threadIdx.x == 0) {
        unsigned* bar = b.bar;
        __builtin_amdgcn_s_waitcnt(0);
        unsigned nloc = b.st[0], nx = b.st[1];
        if (nloc == 0u) { xcd_barrier_complete(bar, b.x, nloc, nx); b.st[0] = nloc; b.st[1] = nx; }
        const unsigned old = xb_add(&bar[XB_XSUB(b.x)], 1u);
        const unsigned gen = old / nloc;
        if (old + 1u == (gen + 1u) * nloc) {
            __builtin_amdgcn_fence(__ATOMIC_RELEASE, "agent");
            asm volatile("s_waitcnt vmcnt(0)" ::: "memory");
            const unsigned og = xb_add(&bar[XB_TOP], 1u);
            const unsigned tg = og / nx;
            if (og + 1u == (tg + 1u) * nx) xb_add(&bar[XB_TOPGEN], 1u);
            else XB_SPIN(xb_ld(&bar[XB_TOPGEN]) == tg, bar);
            __builtin_amdgcn_fence(__ATOMIC_ACQUIRE, "agent");
            xb_add(&bar[XB_XGEN(b.x)], 1u);
            asm volatile("s_waitcnt vmcnt(0)" ::: "memory");
        } else {
            XB_SPIN(xb_ld(&bar[XB_XGEN(b.x)]) == gen, bar);
            __builtin_amdgcn_fence(__ATOMIC_ACQUIRE, "agent");
            asm volatile("s_waitcnt vmcnt(0)" ::: "memory");
        }
    }
    __syncthreads();
}

constexpr int NIN = 33;
struct Args { const float* in[NIN]; float* out; unsigned char* ws; int ph_lo, ph_hi; };
struct Frame {
    LAS unsigned char* lds;
    unsigned char* ws;
    const float* const* in;
    float* out;
    int tid, lane, wave, G, bid;
};
enum InIdx { I_X = 0, I_C, I_CTX, I_CCTX, I_ADAW, I_ADAB, I_N1W, I_N2W, I_WIN, I_LAMRE, I_LAMIM, I_LOGDT, I_BRE, I_BIM, I_CRE, I_CIM, I_S5D, I_GLUW, I_GKUP, I_GKB, I_GNW,
             I_WS5P, I_WGLAP, I_WOUT, I_RW, I_RB, I_EWG, I_EWU, I_EWD, I_SWG, I_SWU, I_SWD, I_FNW };

struct TrItem { const float* src; bf16_t* dst; int ldw, ldt; int fp8; };
DI void tr_load(const TrItem& it, f32x4 (&v)[8], int lane) {
    const int kk = lane >> 3, n4 = lane & 7;
    const float* src = it.src + (size_t)kk * it.ldw + 4 * n4;
#pragma unroll
    for (int i = 0; i < 8; ++i) v[i] = *(const GAS f32x4*)(src + (size_t)(8 * i) * it.ldw);
}
DI void tr_finish(const TrItem& it, const f32x4 (&v)[8], LAS float* scr, int lane) {
    const int kk = lane >> 3, n4 = lane & 7;
#pragma unroll
    for (int i = 0; i < 8; ++i) { LAS float* d = scr + (8 * i + kk) * 33 + 4 * n4; d[0] = v[i].x; d[1] = v[i].y; d[2] = v[i].z; d[3] = v[i].w; }
    LDS_WAIT(); asm volatile("" ::: "memory");
    const int c = lane & 7;
    if (it.fp8) {
        unsigned char* dst8 = (unsigned char*)it.dst; const float sc = (float)(1 << pg8::FP8_WSHIFT);
#pragma unroll
        for (int j = 0; j < 4; ++j) { const int n = (lane >> 3) + 8 * j; const LAS float* s = scr + (8 * c) * 33 + n;
            unsigned w0 = 0, w1 = 0;
            w0 = __builtin_amdgcn_cvt_pk_fp8_f32(s[0 * 33] * sc, s[1 * 33] * sc, w0, false); w0 = __builtin_amdgcn_cvt_pk_fp8_f32(s[2 * 33] * sc, s[3 * 33] * sc, w0, true);
            w1 = __builtin_amdgcn_cvt_pk_fp8_f32(s[4 * 33] * sc, s[5 * 33] * sc, w1, false); w1 = __builtin_amdgcn_cvt_pk_fp8_f32(s[6 * 33] * sc, s[7 * 33] * sc, w1, true);
            *(GAS v2u*)(dst8 + (size_t)n * it.ldt + 8 * c) = (v2u){w0, w1}; }
    } else {
#pragma unroll
        for (int j = 0; j < 4; ++j) { const int n = (lane >> 3) + 8 * j; const LAS float* s = scr + (8 * c) * 33 + n;
            v4u o; o.x = pk2(s[0 * 33], s[1 * 33]); o.y = pk2(s[2 * 33], s[3 * 33]); o.z = pk2(s[4 * 33], s[5 * 33]); o.w = pk2(s[6 * 33], s[7 * 33]);
            *(GAS v4u*)(it.dst + (size_t)n * it.ldt + 8 * c) = o; }
    }
    LDS_WAIT(); asm volatile("" ::: "memory");
}
DI TrItem tr_make(const float* W, int ldw, int k0, int col0, bf16_t* WT, int ldt, int row0) { TrItem t; t.src = W + (size_t)k0 * ldw + col0; t.dst = WT + (size_t)row0 * ldt + k0; t.ldw = ldw; t.ldt = ldt; t.fp8 = 0; return t; }
DI TrItem tr_dense(const float* W, int ldw, int col0, int ncols, bf16_t* WT, int ldt, int row0, int it) {
    const int nblk = ncols / 32, kb = it / nblk, nb = it % nblk;
    return tr_make(W, ldw, 64 * kb, col0 + 32 * nb, WT, ldt, row0 + 32 * nb);
}
constexpr int NP_EXPERT = 65 * 2 * 32 + 65 * 32, NP_CONV_ALL = NP_EXPERT + 16 * 32 + (16 * 4 + 16 * 8 + 16 * 8 + 32 * 8) / 2;
DI void p0_convert(Frame& F, const int qbeg, const int qend) {
    const float* const* in = F.in;
    {
        __syncthreads();
        LAS float* img = (LAS float*)F.lds;
        LAS unsigned char* obuf = F.lds + 66560;
        int tid = F.tid; asm volatile("" : "+v"(tid));
        constexpr int NP_GU = 65 * 2 * 32, NP_DN = 65 * 32, NP_WIN = 16 * 32, NT_GLU = 16 * 4, NT_S5P = 16 * 8, NT_GLAP = 16 * 8, NT_WOUT = 32 * 8;
        constexpr int NP_ALL = NP_GU + NP_DN + NP_WIN + (NT_GLU + NT_S5P + NT_GLAP + NT_WOUT) / 2;
        static_assert(NP_GU + NP_DN == NP_EXPERT && NP_ALL == NP_CONV_ALL, "item counts");
        struct Tile { const float* src; unsigned char* dst; int ldw, ldt, fp8, gu; };
        auto make = [&](int q, const int half) -> Tile {
            Tile t; t.fp8 = 1; t.gu = 0; t.ldt = 128;
            if (q < NP_GU) {
                const int blk = q >> 5, ii = q & 31, e = blk >> 1, gu = blk & 1, kt = ii >> 1, nb = ii & 1, kb = 2 * kt + half;
                const float* W = (e < 64) ? ((gu ? in[I_EWU] : in[I_EWG]) + (size_t)e * 2048 * 512) : (gu ? in[I_SWU] : in[I_SWG]);
                t.src = W + (size_t)(64 * kb) * 512 + 256 * nb; t.ldw = 512; t.gu = 1;
                t.dst = F.ws + WS_WGU_T + (size_t)e * 1024 * 2048 + (size_t)kt * (1024 * 128) + (size_t)(512 * nb + 128 * gu) * 128; return t; }
            q -= NP_GU;
            if (q < NP_DN) { const int e = q >> 5, ii = q & 31, kt = ii >> 3, nb = ii & 7, kb = 2 * kt + half;
                const float* W = (e < 64) ? (in[I_EWD] + (size_t)e * 512 * 2048) : in[I_SWD];
                t.src = W + (size_t)(64 * kb) * 2048 + 256 * nb; t.ldw = 2048;
                t.dst = F.ws + WS_WD_T + (size_t)e * 2048 * 512 + (size_t)kt * (2048 * 128) + (size_t)(256 * nb) * 128; return t; }
            q -= NP_DN;
            if (q < NP_WIN) { const int kbp = q >> 5, nb = q & 31, drow = 256 * nb, kb = 2 * kbp + half; int scol;
                if (drow < 1024) scol = drow; else if (drow < 1536) scol = 1536 + (drow - 1024); else if (drow < 2560) scol = 2048 + (drow - 1536); else if (drow < 3072) scol = 1024 + (drow - 2560);
                else if (drow < 4096) scol = 3072 + (drow - 3072); else if (drow < 6144) scol = 4128 + (drow - 4096); else scol = 6176 + (drow - 6144);
                t.src = in[I_WIN] + (size_t)(64 * kb) * INW + scol; t.ldw = INW;
                if (nb == 4 || nb == 5 || nb == 10 || nb == 11) { t.fp8 = 0; t.ldt = 2048 * 2; t.dst = F.ws + WS_WIN_T + ((size_t)drow * 2048 + 64 * kb) * 2; }
                else { t.ldt = 2048; t.dst = F.ws + WS_WIN8 + (size_t)drow * 2048 + 128 * kbp; }
                return t; }
            q -= NP_WIN;
            if (q < NT_WOUT / 2) { const int kbp = q >> 3, nb = q & 7, kb = 2 * kbp + half;
                t.src = in[I_WOUT] + (size_t)(64 * kb) * 2048 + 256 * nb; t.ldw = 2048; t.ldt = 2048; t.dst = F.ws + WS_WOUT_T + (size_t)(256 * nb) * 2048 + 128 * kbp; return t; }
            q -= NT_WOUT / 2;
            if (q < NT_S5P / 2 + NT_GLAP / 2) { const int which = q >= NT_S5P / 2, qq = which ? q - NT_S5P / 2 : q, kbp = qq >> 3, nb = qq & 7, kb = 2 * kbp + half;
                t.src = (which ? in[I_WGLAP] : in[I_WS5P]) + (size_t)(64 * kb) * 2048 + 256 * nb; t.ldw = 2048; t.ldt = 1024; t.dst = F.ws + (which ? WS_GLAP_T : WS_S5P_T) + (size_t)(256 * nb) * 1024 + 128 * kbp; return t; }
            q -= NT_S5P / 2 + NT_GLAP / 2;
            { const int kbp = q >> 2, nb = q & 3, kb = 2 * kbp + half;
              t.src = in[I_GLUW] + (size_t)(64 * kb) * 1024 + 256 * nb; t.ldw = 1024; t.ldt = 1024; t.dst = F.ws + WS_GLU_T + (size_t)(256 * nb) * 1024 + 128 * kbp; return t; }
            return t;
        };
        f32x4 va[8], vb[8]; Tile ta, tb;
        auto issue = [&](f32x4 (&v)[8], const Tile& t) {
            const float* p_ = t.src + (size_t)(tid >> 6) * t.ldw + 4 * (tid & 63);
#pragma unroll
            for (int i = 0; i < 8; ++i) v[i] = __builtin_nontemporal_load((const GAS f32x4*)(p_ + (size_t)(8 * i) * t.ldw));
        };
#define CV_WAIT(v, n) do { } while (0)
        auto stage = [&](const f32x4 (&v)[8]) {
#pragma unroll
            for (int i = 0; i < 8; ++i) *(LAS f32x4*)(img + (8 * i + (tid >> 6)) * 260 + 4 * (tid & 63)) = v[i];
        };
        auto convert = [&](const Tile& cur, const int half) {
            const int n = tid & 255, kh = tid >> 8;
            const LAS float* sp = img + (32 * kh) * 260 + n;
            LAS unsigned char* orow = obuf + n * 128; const int sw = n & 7;
            if (cur.fp8) {
                const float sc = (float)(1 << pg8::FP8_WSHIFT);
                unsigned w[8];
#pragma unroll
                for (int q = 0; q < 8; ++q) { unsigned x = 0;
                    x = __builtin_amdgcn_cvt_pk_fp8_f32(sp[(4 * q) * 260] * sc, sp[(4 * q + 1) * 260] * sc, x, false);
                    x = __builtin_amdgcn_cvt_pk_fp8_f32(sp[(4 * q + 2) * 260] * sc, sp[(4 * q + 3) * 260] * sc, x, true); w[q] = x; }
                const int c0 = 4 * half + 2 * kh;
                *(LAS v4u*)(orow + (((c0) ^ sw) << 4)) = (v4u){w[0], w[1], w[2], w[3]}; *(LAS v4u*)(orow + (((c0 + 1) ^ sw) << 4)) = (v4u){w[4], w[5], w[6], w[7]};
            } else {
                unsigned w[16];
#pragma unroll
                for (int q = 0; q < 16; ++q) w[q] = pk2(sp[(2 * q) * 260], sp[(2 * q + 1) * 260]);
#pragma unroll
                for (int q4 = 0; q4 < 4; ++q4) *(LAS v4u*)(orow + (((4 * kh + q4) ^ sw) << 4)) = (v4u){w[4 * q4], w[4 * q4 + 1], w[4 * q4 + 2], w[4 * q4 + 3]};
            }
        };
        auto flush = [&](const Tile& cur) {
#pragma unroll
            for (int i = 0; i < 4; ++i) { const int p = i * 512 + tid, n = p >> 3, c = p & 7;
                const v4u x = *(const LAS v4u*)(obuf + n * 128 + ((c ^ (n & 7)) << 4));
                const int drow = cur.gu ? (256 * (n >> 7) + (n & 127)) : n;
                *(GAS v4u*)(cur.dst + (size_t)drow * cur.ldt + 16 * c) = x; }
        };
        int q = qbeg + F.bid;
        if (q < qend) { ta = make(q, 0); issue(va, ta); tb = make(q, 1); issue(vb, tb); CV_WAIT(va, 8); }
        while (q < qend) {
            const bool hn = q + F.G < qend;
            CV_WAIT(va, 12);
            stage(va);
            LDS_BAR();
            const Tile ca = ta;
            if (hn) { ta = make(q + F.G, 0); issue(va, ta); }
            convert(ca, 0);
            LDS_BAR();
            if (!ca.fp8) flush(ca);
            if (hn) CV_WAIT(vb, 8); else CV_WAIT(vb, 0);
            stage(vb);
            LDS_BAR();
            const Tile cb = tb;
            if (hn) { tb = make(q + F.G, 1); issue(vb, tb); }
            convert(cb, 1 & cb.fp8);
            LDS_BAR();
            flush(cb);
            q += F.G;
        }
#undef CV_WAIT
        LDS_BAR();
    }
}
constexpr int IT_GKD = 32 * 1, IT_RW = 32 * 2;
DI void p0_prologue(Frame& F) {
    const float* const* in = F.in;
    {
        LAS float* sv = (LAS float*)F.lds;
        LAS float* red = (LAS float*)(F.lds + 40960);
        for (int i = F.tid; i < 5 * 2048; i += 512) { const int r = i >> 11, k = i & 2047; const float c = (r < 4) ? in[I_C][r * 2048 + k] : in[I_CCTX][k]; sv[i] = siluf_(c); }
        __syncthreads();
        const int NCOLB = 48;
        for (int cb = F.bid; cb < (NMOD * D) / NCOLB; cb += F.G) {
            const int n0 = cb * NCOLB;
            const int c4 = F.tid % 12, kr = F.tid / 12;
            f32x4 acc[5];
#pragma unroll
            for (int r = 0; r < 5; ++r) acc[r] = (f32x4){0.f, 0.f, 0.f, 0.f};
            if (kr < 42) {
                const float* wp = in[I_ADAW] + n0 + 4 * c4;
#pragma unroll 1
                for (int j0 = 0; j0 < 48; j0 += 8) {
                    f32x4 w[8];
#pragma unroll
                    for (int j = 0; j < 8; ++j) w[j] = __builtin_nontemporal_load((const GAS f32x4*)(wp + (size_t)(kr + 42 * (j0 + j)) * (NMOD * D)));
#pragma unroll
                    for (int j = 0; j < 8; ++j)
#pragma unroll
                        for (int r = 0; r < 5; ++r) acc[r] += w[j] * sv[r * 2048 + kr + 42 * (j0 + j)];
                }
                if (kr < 32) { const int k = kr + 42 * 48; const f32x4 w = __builtin_nontemporal_load((const GAS f32x4*)(wp + (size_t)k * (NMOD * D)));
#pragma unroll
                    for (int r = 0; r < 5; ++r) acc[r] += w * sv[r * 2048 + k]; }
#pragma unroll
                for (int r = 0; r < 5; ++r) *(LAS f32x4*)(red + (kr * 5 + r) * 48 + 4 * c4) = acc[r];
            }
            __syncthreads();
            if (F.tid < 240) { const int r = F.tid / 48, n = F.tid % 48; float s = 0.f;
                for (int k = 0; k < 42; ++k) s += red[(k * 5 + r) * 48 + n];
                ((float*)(F.ws + WS_MOD))[r * (NMOD * D) + n0 + n] = s + in[I_ADAB][n0 + n]; }
            __syncthreads();
        }
    }
    {
        for (int gid = (F.tid < 32) ? (F.bid * 32 + F.tid) : (2 * S5NG * S5P); gid < 2 * S5NG * S5P; gid += F.G * 32) {
            const int dr = gid >> 12, g = (gid >> 6) & 63, p = gid & 63;
            const float lre = in[I_LAMRE][gid], lim = in[I_LAMIM][gid];
            const float dt = expf(in[I_LOGDT][dr * 64 + g]);
            const float mag = expf(lre * dt), ph = lim * dt;
            const float lbr = mag * cosf(ph), lbi = mag * sinf(ph);
            const float mag64 = expf(lre * dt * 64.f), ph64 = ph * 64.f;
            f32x2* lam = (f32x2*)(F.ws + WS_S5TAB + S5TAB_LAM); f32x2* lam64 = (f32x2*)(F.ws + WS_S5TAB + S5TAB_LAM64);
            lam[gid] = (f32x2){lbr, lbi};
            lam64[gid] = (f32x2){mag64 * cosf(ph64), mag64 * sinf(ph64)};
            const float nr = lbr - 1.f, ni = lbi, den = lre * lre + lim * lim;
            const float cr = (nr * lre + ni * lim) / den, ci = (ni * lre - nr * lim) / den;
            bf16_t* BT = (bf16_t*)(F.ws + WS_S5TAB + S5TAB_BT) + (size_t)(dr * 64 + g) * 128 * 16;
            bf16_t* CT = (bf16_t*)(F.ws + WS_S5TAB + S5TAB_CT) + (size_t)(dr * 64 + g) * 16 * 128;
            const float* bre = in[I_BRE] + (size_t)gid * 16; const float* bim = in[I_BIM] + (size_t)gid * 16;
#pragma unroll
            for (int h = 0; h < 16; ++h) {
                const float br = bre[h], bi = bim[h];
                BT[(64 * (p >> 5) + (p & 31)) * 16 + h] = (bf16_t)f2bf(cr * br - ci * bi);
                BT[(64 * (p >> 5) + 32 + (p & 31)) * 16 + h] = (bf16_t)f2bf(cr * bi + ci * br);
                const size_t ci_idx = ((size_t)(dr * 64 + g) * 16 + h) * 64 + p;
                CT[h * 128 + 2 * p] = (bf16_t)f2bf(in[I_CRE][ci_idx]);
                CT[h * 128 + 2 * p + 1] = (bf16_t)f2bf(-in[I_CIM][ci_idx]);
            }
        }
    }
    p0_convert(F, NP_EXPERT, NP_CONV_ALL);
    {
        {
            LAS float* scr = (LAS float*)(F.lds + F.wave * 16384);
            const int gw = F.bid * 8 + F.wave, NGW = F.G * 8;
            f32x4 va[8];
            for (int it = gw; it < IT_GKD + IT_RW; it += NGW) {
                const TrItem ti = (it < IT_GKD) ? tr_make(in[I_WIN], INW, 64 * it, 4096, (bf16_t*)(F.ws + WS_WGKD_T), 2048, 0) : tr_dense(in[I_RW], 64, 0, 64, (bf16_t*)(F.ws + WS_ROUT_T), 2048, 0, it - IT_GKD);
                tr_load(ti, va, F.lane); tr_finish(ti, va, scr, F.lane);
            }
        }
    }
}

constexpr int AST = 2056;
DI void norm_row_load(f32x4 (&v)[8], const float* xrow, int lane) {
    const GAS f32x4* xr = (const GAS f32x4*)xrow + lane;
#pragma unroll
    for (int j = 0; j < 8; ++j) v[j] = __builtin_nontemporal_load(xr + 64 * j);
}
template <int FP8OUT>
DI void norm_row_finish(const f32x4 (&v)[8], const float* nw, const float* sh, const float* sc, bf16_t* grow, LAS bf16_t* lrow, int lane, unsigned char* grow8 = nullptr) {
    float s = 0.f;
#pragma unroll
    for (int j = 0; j < 8; ++j) s += (v[j].x * v[j].x + v[j].y * v[j].y) + (v[j].z * v[j].z + v[j].w * v[j].w);
    const float rstd = rsqrtf(wave_sum(s) * (1.f / 2048.f) + EPS);
#pragma unroll
    for (int j = 0; j < 8; ++j) {
        const int i4 = lane + 64 * j;
        const f32x4 w = ((const GAS f32x4*)nw)[i4], a = ((const GAS f32x4*)sh)[i4], c = ((const GAS f32x4*)sc)[i4];
        const f32x4 y = (v[j] * rstd) * w * (c + 1.0f) + a;
        v2u o; o.x = pk2(y.x, y.y); o.y = pk2(y.z, y.w);
        if (FP8OUT) { unsigned w8 = 0; w8 = __builtin_amdgcn_cvt_pk_fp8_f32(y.x, y.y, w8, false); w8 = __builtin_amdgcn_cvt_pk_fp8_f32(y.z, y.w, w8, true); *(GAS unsigned*)((FP8OUT == 2 ? grow8 : (unsigned char*)grow) + 4 * i4) = w8; }
        if (FP8OUT != 1) *(GAS v2u*)(grow + 4 * i4) = o;
        *(LAS v2u*)(lrow + 4 * i4) = o;
    }
}
template <int FP8OUT>
DI void norm_row_finish_reg(const f32x4 (&v)[8], const f32x4 (&wc)[8], const f32x4 (&sh)[8], bf16_t* grow, LAS bf16_t* lrow, int lane, unsigned char* grow8 = nullptr) {
    float s = 0.f;
#pragma unroll
    for (int j = 0; j < 8; ++j) s += (v[j].x * v[j].x + v[j].y * v[j].y) + (v[j].z * v[j].z + v[j].w * v[j].w);
    const float rstd = rsqrtf(wave_sum(s) * (1.f / 2048.f) + EPS);
#pragma unroll
    for (int j = 0; j < 8; ++j) {
        const int i4 = lane + 64 * j;
        const f32x4 y = (v[j] * rstd) * wc[j] + sh[j];
        v2u o; o.x = pk2(y.x, y.y); o.y = pk2(y.z, y.w);
        if (FP8OUT) { unsigned w8 = 0; w8 = __builtin_amdgcn_cvt_pk_fp8_f32(y.x, y.y, w8, false); w8 = __builtin_amdgcn_cvt_pk_fp8_f32(y.z, y.w, w8, true); *(GAS unsigned*)((FP8OUT == 2 ? grow8 : (unsigned char*)grow) + 4 * i4) = w8; }
        if (FP8OUT != 1) *(GAS v2u*)(grow + 4 * i4) = o;
        *(LAS v2u*)(lrow + 4 * i4) = o;
    }
}
template <int NT32>
DI void skinny_bload(bf16x8 (&bf)[16][NT32], const bf16_t* Bt, int wave, int lane) {
#pragma unroll
    for (int ks = 0; ks < 16; ++ks)
#pragma unroll
        for (int j = 0; j < NT32; ++j) bf[ks][j] = *(const GAS bf16x8*)(Bt + (size_t)(32 * j + (lane & 31)) * 2048 + 256 * wave + 16 * ks + 8 * (lane >> 5));
}
template <int NT32>
DI void skinny_gemm(LAS unsigned char* tile, const bf16x8 (&bf)[16][NT32], f32x16 (&acc)[NT32], int wave, int lane, int row0 = 0, int rowmax = 31) {
    const int arow = (row0 + (lane & 31)) < rowmax ? (row0 + (lane & 31)) : rowmax;
#pragma unroll
    for (int ks = 0; ks < 16; ++ks) {
        const int k = 256 * wave + 16 * ks + 8 * (lane >> 5);
        const bf16x8 a = *(const LAS bf16x8*)(tile + arow * (AST * 2) + k * 2);
#pragma unroll
        for (int j = 0; j < NT32; ++j) acc[j] = MFMA32(a, bf[ks][j], acc[j]);
        if ((ks & 3) == 3) asm volatile("" ::: "memory");
    }
}
template <int NT32>
DI void skinny_store_partial(LAS float* red, const f32x16 (&acc)[NT32], int wave, int lane) {
#pragma unroll
    for (int j = 0; j < NT32; ++j)
#pragma unroll
        for (int r = 0; r < 16; ++r) red[(wave * 32 + crow32(r, lane >> 5)) * (32 * NT32) + 32 * j + (lane & 31)] = acc[j][r];
}

DI void p1_norm1(Frame& F) {
    const float* MOD = (const float*)(F.ws + WS_MOD);
    bf16_t* H = (bf16_t*)(F.ws + WS_H);
    float* GKD = (float*)(F.ws + WS_GKD);
    const bf16_t* WG = (const bf16_t*)(F.ws + WS_WGKD_T);
    const float* n1w = F.in[I_N1W];
    constexpr int RPT = 36;
    for (int tile = F.bid; tile < TA / RPT; tile += F.G) {
        const int nr = (F.wave < 4) ? 5 : 4, r0 = (F.wave < 4) ? 5 * F.wave : 20 + 4 * (F.wave - 4);
        {
            f32x4 va[8], vb[8];
            auto rowsrc = [&](int lr) -> const float* { const int row = tile * RPT + lr; return (row < T) ? (F.in[I_X] + (size_t)row * D) : (F.in[I_CTX] + (size_t)(row - T) * D); };
            f32x4 wc[8], shv[8]; int curb = -1;
            auto finish = [&](const f32x4 (&v)[8], int lr) { const int row = tile * RPT + lr; const int bsel = __builtin_amdgcn_readfirstlane((row < T) ? (row / SEQ) : 4);
                if (bsel != curb) { curb = bsel; const float* mr = MOD + (size_t)bsel * (NMOD * D);
#pragma unroll
                    for (int j = 0; j < 8; ++j) { const int i4 = F.lane + 64 * j; const f32x4 w = ((const GAS f32x4*)n1w)[i4], a = ((const GAS f32x4*)mr)[i4], c = ((const GAS f32x4*)(mr + D))[i4]; wc[j] = w * (c + 1.0f); shv[j] = a; } }
                norm_row_finish_reg<2>(v, wc, shv, H + (size_t)row * D, (LAS bf16_t*)F.lds + lr * AST, F.lane, F.ws + WS_H8 + (size_t)row * D); };
            norm_row_load(va, rowsrc(r0), F.lane);
            norm_row_load(vb, rowsrc(r0 + 1), F.lane); finish(va, r0);
            norm_row_load(va, rowsrc(r0 + 2), F.lane); finish(vb, r0 + 1);
            norm_row_load(vb, rowsrc(r0 + 3), F.lane); finish(va, r0 + 2);
            if (nr == 5) { norm_row_load(va, rowsrc(r0 + 4), F.lane); finish(vb, r0 + 3); finish(va, r0 + 4); }
            else finish(vb, r0 + 3);
        }
        bf16x8 bfr[16][1]; skinny_bload<1>(bfr, WG, F.wave, F.lane);
        __syncthreads();
        f32x16 acc0[1], acc1[1];
#pragma unroll
        for (int r = 0; r < 16; ++r) { acc0[0][r] = 0.f; acc1[0][r] = 0.f; }
        skinny_gemm<1>(F.lds, bfr, acc0, F.wave, F.lane, 0, 31);
        skinny_gemm<1>(F.lds, bfr, acc1, F.wave, F.lane, 32, RPT - 1);
        __syncthreads();
        LAS float* red = (LAS float*)F.lds;
        skinny_store_partial<1>(red, acc0, F.wave, F.lane);
        skinny_store_partial<1>(red + 8192, acc1, F.wave, F.lane);
        __syncthreads();
        for (int o = F.tid; o < RPT * 32; o += 512) { const int lr = o >> 5, n = o & 31; const LAS float* rp = red + (lr >> 5) * 8192 + (lr & 31) * 32 + n; float s = 0.f;
#pragma unroll
            for (int w = 0; w < 8; ++w) s += rp[w * 1024];
            GKD[(size_t)(tile * RPT + lr) * 32 + n] = s; }
        __syncthreads();
    }
}

DI bool static_tile(int L, int nM, int nN, int& pm, int& pn) {
    const int nwg = nM * nN; if (L >= nwg) return false;
    int wgid = L; { const int q = nwg / 8, r = nwg % 8, xcd = wgid % 8, off = wgid / 8; wgid = (xcd < r ? xcd * (q + 1) : r * (q + 1) + (xcd - r) * q) + off; }
    const int nig = 8 * nN, gid = wgid / nig, fm = gid * 8, gsz = (nM - fm) < 8 ? (nM - fm) : 8;
    pm = fm + ((wgid % nig) % gsz); pn = (wgid % nig) / gsz; return true;
}
struct DenseOrder {
    const bf16_t* A; const bf16_t* Bt; int nM, nN, K, G, c; bool halfn;
    DI bool next(int i, pg8::Unit& u) const {
        int pm, pn; const int L = i * G + c;
        if (!static_tile(halfn ? (L >> 1) : L, nM, nN, pm, pn)) return false;
        const int half = halfn ? (L & 1) : 0;
        u.a = (const char*)(A + (size_t)pm * 256 * K); u.b = (const char*)(Bt + ((size_t)pn * 256 + 128 * half) * K); u.idx = nullptr; u.nvalid = 256; u.pm = pm; u.pn = pn; u.e = 0;
        u.cb = 256 * pn + 128 * half; u.flags = halfn ? 2 : 0; return true;
    }
};
struct DenseOrder8 {
    const unsigned char* A; const unsigned char* Bt; int nM, nN, K, G, c; bool halfn;
    DI bool next(int i, pg8::Unit& u) const {
        int pm, pn; const int L = i * G + c;
        if (!static_tile(halfn ? (L >> 1) : L, nM, nN, pm, pn)) return false;
        const int half = halfn ? (L & 1) : 0;
        u.a = (const char*)(A + (size_t)pm * 256 * K); u.b = (const char*)(Bt + ((size_t)pn * 256 + 128 * half) * K); u.idx = nullptr; u.nvalid = 256; u.pm = pm; u.pn = pn; u.e = 0;
        u.cb = 256 * pn + 128 * half; u.flags = halfn ? 2 : 0; return true;
    }
};
struct G1Order {
    const bf16_t* A; const bf16_t* Bt; int G, c;
    DI bool next(int i, pg8::Unit& u) const {
        const int L = i * G + c; int pm, pn;
        if (L < 128) { int j; static_tile(L, 32, 4, pm, j); pn = (j < 2) ? 4 + j : 8 + j; }
        else if (L < 136) { const int j = L - 128; pm = 32 + (j & 3); pn = 4 + (j >> 2); }
        else return false;
        u.a = (const char*)(A + (size_t)pm * 256 * D); u.b = (const char*)(Bt + (size_t)pn * 256 * D); u.idx = nullptr; u.nvalid = 256; u.pm = pm; u.pn = pn; u.e = 0;
        u.cb = 256 * pn; u.flags = 0; return true;
    }
};
struct G1Order8 {
    const unsigned char* A; const unsigned char* Bt; int G, c;
    DI bool next(int i, pg8::Unit& u) const {
        int L;
        if (G == 256) {
            if (i < 3) L = i * 256 + c;
            else { const int cc = c - 136; if (cc < 0) return false;
                if (i == 3) { if (cc >= 120) return false; L = 768 + cc; } else if (i == 4) { if (cc >= 40) return false; L = 888 + cc; } else return false; }
        } else { L = i * G + c; if (L >= 928) return false; }
        int pm, pn;
        if (L < 896) { int j; static_tile(L, 32, 28, pm, j); pn = (j < 4) ? j : ((j < 8) ? j + 2 : j + 4); }
        else { const int jj = L - 896, q = jj >> 2; pm = 32 + (jj & 3); pn = (q < 4) ? q : q + 2; }
        u.a = (const char*)(A + (size_t)pm * 256 * D); u.b = (const char*)(Bt + (size_t)pn * 256 * D); u.idx = nullptr; u.nvalid = 256; u.pm = pm; u.pn = pn; u.e = 0;
        u.cb = 256 * pn; u.flags = 0; return true;
    }
};
constexpr int MT_CNT = 0, MT_MT = 80, MT_NF = 160, MT_HB = 240, MT_XF = 320, MT_XL = 400, MT_WORDS = 480;
DI int wave_excl_scan(int v, int lane) {
    int s = v;
#pragma unroll
    for (int d = 1; d < 64; d <<= 1) { const int t = __shfl_up(s, d); if (lane >= d) s += t; }
    return s - v;
}
DI void moe_tables(Frame& F, volatile LAS int* tb) {
    if (F.tid < 64) {
        const int e = F.tid;
        const unsigned* cnt = (const unsigned*)(F.ws + WS_CTL) + CW_CNT;
        const int c = (int)__hip_atomic_load(cnt + 16 * e, RLX_AGENT);
        const int m = (c + 255) >> 8, nf = (c + 127) >> 8;
        const int hb = wave_excl_scan(m * 256, e);
        tb[MT_CNT + e] = c; tb[MT_MT + e] = m; tb[MT_NF + e] = nf; tb[MT_HB + e] = hb;
        if (e == 63) { const int tot = hb + m * 256; tb[MT_CNT + 64] = T; tb[MT_MT + 64] = T / 256; tb[MT_NF + 64] = T / 256; tb[MT_HB + 64] = tot; tb[MT_HB + 65] = tot + T; }
        const int x = e >> 3, k = e & 7, src = x + 8 * k;
        const int nfj = __shfl(nf, src), lj = __shfl(m - nf, src);
        const int pf = wave_excl_scan(nfj, e) + 4 * x, pl = wave_excl_scan(lj, e);
        tb[MT_XF + 10 * x + k] = pf; tb[MT_XL + 10 * x + k] = pl;
        if (k == 7) { tb[MT_XF + 10 * x + 8] = pf + nfj; tb[MT_XF + 10 * x + 9] = pf + nfj + 4; tb[MT_XL + 10 * x + 8] = pl + lj; tb[MT_XL + 10 * x + 9] = pl + lj; }
    }
    __syncthreads();
}
constexpr int MT_UL = 480;
template <int NTN>
DI void moe_unit_list(Frame& F, volatile LAS int* tb) {
    if (F.tid < 64) {
        const int i = F.tid, c = F.bid, G = F.G;
        int e = -1, mtile = 0, nt_ = 0, fl = 0;
        const int xg = c & 7, R = G >> 3, UF = tb[MT_XF + 79] * NTN, UL = tb[MT_XL + 79] * NTN;
        const int f0 = (int)(((long)UF * xg) >> 3), f1 = (int)(((long)UF * (xg + 1)) >> 3), l0 = (int)(((long)UL * xg) >> 3), l1 = (int)(((long)UL * (xg + 1)) >> 3);
        const int Q = i * R + (c >> 3);
        if (Q < f1 - f0) {
            const int P = f0 + Q;
            int x = 0;
#pragma unroll
            for (int q = 1; q < 8; ++q) x += (tb[MT_XF + 10 * q] * NTN <= P) ? 1 : 0;
            int k = 0;
#pragma unroll
            for (int q = 1; q < 9; ++q) k += (tb[MT_XF + 10 * x + q] * NTN <= P) ? 1 : 0;
            const int loc = P - tb[MT_XF + 10 * x + k] * NTN;
            if (k < 8) { e = x + 8 * k; const int m = tb[MT_NF + e]; mtile = loc % m; nt_ = loc / m; }
            else { e = 64; mtile = 4 * x + (loc & 3); nt_ = loc >> 2; }
        } else if (Q - (f1 - f0) < l1 - l0) {
            const int P = l0 + Q - (f1 - f0);
            int x = 0;
#pragma unroll
            for (int q = 1; q < 8; ++q) x += (tb[MT_XL + 10 * q] * NTN <= P) ? 1 : 0;
            int k = 0;
#pragma unroll
            for (int q = 1; q < 8; ++q) k += (tb[MT_XL + 10 * x + q] * NTN <= P) ? 1 : 0;
            e = x + 8 * k; mtile = tb[MT_NF + e]; nt_ = P - tb[MT_XL + 10 * x + k] * NTN; fl = 1;
        }
        tb[MT_UL + 4 * i] = e; tb[MT_UL + 4 * i + 1] = mtile; tb[MT_UL + 4 * i + 2] = nt_; tb[MT_UL + 4 * i + 3] = fl;
    }
    __syncthreads();
}
template <int NTN, int ES>
struct MoeOrder {
    const volatile LAS int* tb; const unsigned char* A; const unsigned char* Bt; const int* list; int K, G, c;
    DI bool next(int i, pg8::Unit& u) const {
        if (i >= 64) return false;
        const int e = __builtin_amdgcn_readfirstlane(tb[MT_UL + 4 * i]);
        if (e < 0) return false;
        const int mtile = __builtin_amdgcn_readfirstlane(tb[MT_UL + 4 * i + 1]), nt_ = __builtin_amdgcn_readfirstlane(tb[MT_UL + 4 * i + 2]), fl = __builtin_amdgcn_readfirstlane(tb[MT_UL + 4 * i + 3]);
        const int hb = __builtin_amdgcn_readfirstlane(tb[MT_HB + e]), cnt = __builtin_amdgcn_readfirstlane(tb[MT_CNT + e]);
        u.e = e; u.pn = nt_; u.pm = (hb >> 8) + mtile; u.nvalid = (cnt - mtile * 256) < 256 ? (cnt - mtile * 256) : 256;
        u.cb = 256 * nt_; u.flags = fl;
        u.b = (const char*)(Bt + (size_t)e * (NTN * 256) * K * ES + (size_t)nt_ * 256 * 128);
        if (NTN == 4) { u.a = (const char*)A; u.idx = list + (size_t)e * T + mtile * 256; }
        else { u.a = (const char*)(A + (size_t)(hb + mtile * 256) * K * ES); u.idx = nullptr; }
        return true;
    }
};

DI v4u pack8(const f32x4 v0, const f32x4 v1) { v4u w; w.x = pg8::cvt_pk_bf16(v0[0], v0[1]); w.y = pg8::cvt_pk_bf16(v0[2], v0[3]); w.z = pg8::cvt_pk_bf16(v1[0], v1[1]); w.w = pg8::cvt_pk_bf16(v1[2], v1[3]); return w; }
DI void unpack8(const v4u w, f32x4& v0, f32x4& v1) { v0 = (f32x4){bflo(w.x), bfhi(w.x), bflo(w.y), bfhi(w.y)}; v1 = (f32x4){bflo(w.z), bfhi(w.z), bflo(w.w), bfhi(w.w)}; }

struct EpiG1 {
    static constexpr bool PERM = true;
    unsigned char* ws;
    DI void operator()(const f32x4 (&acc)[2][2][4][2], const pg8::Unit& u, int wr, int wc, int fr, int fq) const {
        const int pn = u.cb >> 8; bf16_t* dst; int ld, c0, act;
        if (pn < 4) { dst = (bf16_t*)(ws + WS_U); ld = 1024; c0 = 256 * pn; act = 0; }
        else if (pn < 6) { dst = (bf16_t*)(ws + WS_KK); ld = 512; c0 = 256 * (pn - 4); act = 0; }
        else if (pn < 10) { dst = (bf16_t*)(ws + WS_V); ld = 1024; c0 = 256 * (pn - 6); act = 0; }
        else if (pn < 12) { dst = (bf16_t*)(ws + WS_Q); ld = 512; c0 = 256 * (pn - 10); act = 1; }
        else if (pn < 16) { dst = (bf16_t*)(ws + WS_GO); ld = 1024; c0 = 256 * (pn - 12); act = 2; }
        else if (pn < 24) { dst = (bf16_t*)(ws + WS_GS); ld = 2048; c0 = 256 * (pn - 16); act = 3; }
        else { dst = (bf16_t*)(ws + WS_GG); ld = 2048; c0 = 256 * (pn - 24); act = 3; }
        const int row0 = u.pm * 256 + wr * 64 + fr, col0 = c0 + (u.cb & 255) + wc * 32 + 8 * fq;
#pragma unroll
        for (int ai = 0; ai < 2; ++ai)
#pragma unroll
            for (int m = 0; m < 4; ++m) { bf16_t* rowp = dst + (size_t)(row0 + ai * 128 + m * 16) * ld + col0;
#pragma unroll
                for (int bj = 0; bj < 2; ++bj) { if (bj && (u.flags & 2)) continue; f32x4 v0 = acc[ai][bj][m][0], v1 = acc[ai][bj][m][1];
                    if (act == 1) { v0 *= 0.08838834764831845f; v1 *= 0.08838834764831845f; }
                    else if (act == 2) {
#pragma unroll
                        for (int j = 0; j < 4; ++j) { v0[j] = siluf_(v0[j]); v1[j] = siluf_(v1[j]); } }
                    else if (act == 3) {
#pragma unroll
                        for (int j = 0; j < 4; ++j) { v0[j] = sigmoidf_(v0[j]); v1[j] = sigmoidf_(v1[j]); } }
                    *(GAS v4u*)(rowp + bj * 128) = pack8(v0, v1); } }
    }
};
template <int MODE>
struct EpiEw {
    static constexpr bool PERM = true;
    bf16_t* O; const bf16_t* P1; int ld;
    DI void operator()(const f32x4 (&acc)[2][2][4][2], const pg8::Unit& u, int wr, int wc, int fr, int fq) const {
        const int rl0 = wr * 64 + fr, col0 = u.cb + wc * 32 + 8 * fq;
        const bool nb1 = (u.flags & 2) != 0;
#pragma unroll
        for (int ai = 0; ai < 2; ++ai) {
            v4u p1[4][2], po[4][2];
            if (MODE != 3) {
#pragma unroll
                for (int m = 0; m < 4; ++m)
#pragma unroll
                    for (int bj = 0; bj < 2; ++bj) { if (bj && nb1) continue; const size_t off = (size_t)(u.pm * 256 + rl0 + ai * 128 + m * 16) * ld + col0 + bj * 128;
                        p1[m][bj] = *(const GAS v4u*)(P1 + off); if (MODE == 2) po[m][bj] = *(const GAS v4u*)(O + off); }
            }
#pragma unroll
            for (int m = 0; m < 4; ++m) { const int rl = rl0 + ai * 128 + m * 16; const size_t off = (size_t)(u.pm * 256 + rl) * ld + col0;
                if (MODE == 3 && rl >= u.nvalid) continue;
#pragma unroll
                for (int bj = 0; bj < 2; ++bj) { if (bj && nb1) continue; f32x4 v0 = acc[ai][bj][m][0], v1 = acc[ai][bj][m][1];
                    if (MODE != 3) { f32x4 q0, q1; unpack8(p1[m][bj], q0, q1);
                        if (MODE == 0) {
#pragma unroll
                            for (int j = 0; j < 4; ++j) { v0[j] = q0[j] * sigmoidf_(v0[j]); v1[j] = q1[j] * sigmoidf_(v1[j]); } }
                        else { v0 *= q0; v1 *= q1; }
                        if (MODE == 2) { f32x4 o0, o1; unpack8(po[m][bj], o0, o1); v0 += o0; v1 += o1; } }
                    if (MODE == 3) { unsigned w0 = 0, w1 = 0;
                        w0 = __builtin_amdgcn_cvt_pk_fp8_f32(v0[0], v0[1], w0, false); w0 = __builtin_amdgcn_cvt_pk_fp8_f32(v0[2], v0[3], w0, true);
                        w1 = __builtin_amdgcn_cvt_pk_fp8_f32(v1[0], v1[1], w1, false); w1 = __builtin_amdgcn_cvt_pk_fp8_f32(v1[2], v1[3], w1, true);
                        *(GAS v2u*)((unsigned char*)O + off + bj * 128) = (v2u){w0, w1}; }
                    else if (MODE == 0) { unsigned w0 = 0, w1 = 0;
                        w0 = __builtin_amdgcn_cvt_pk_fp8_f32(v0[0], v0[1], w0, false); w0 = __builtin_amdgcn_cvt_pk_fp8_f32(v0[2], v0[3], w0, true);
                        w1 = __builtin_amdgcn_cvt_pk_fp8_f32(v1[0], v1[1], w1, false); w1 = __builtin_amdgcn_cvt_pk_fp8_f32(v1[2], v1[3], w1, true);
                        *(GAS v2u*)((unsigned char*)O + off + bj * 128) = (v2u){w0, w1}; }
                    else *(GAS v4u*)(O + off + bj * 128) = pack8(v0, v1); } }
            asm volatile("" ::: "memory");
        }
    }
};
struct EpiY8 {
    static constexpr bool PERM = true;
    unsigned char* O; int ld;
    DI void operator()(const f32x4 (&acc)[2][2][4][2], const pg8::Unit& u, int wr, int wc, int fr, int fq) const {
        const bool odd = (fr & 1) != 0;
        const int rl0 = wr * 64 + (fr & ~1), colb = u.cb + 64 * wc + 8 * fq + (odd ? 32 : 0);
#pragma unroll
        for (int ai = 0; ai < 2; ++ai) {
#pragma unroll
            for (int m = 0; m < 4; ++m) {
                unsigned w[2][2];
#pragma unroll
                for (int bj = 0; bj < 2; ++bj) { const f32x4 v0 = acc[ai][bj][m][0], v1 = acc[ai][bj][m][1]; unsigned w0 = 0, w1 = 0;
                    w0 = __builtin_amdgcn_cvt_pk_fp8_f32(v0[0], v0[1], w0, false); w0 = __builtin_amdgcn_cvt_pk_fp8_f32(v0[2], v0[3], w0, true);
                    w1 = __builtin_amdgcn_cvt_pk_fp8_f32(v1[0], v1[1], w1, false); w1 = __builtin_amdgcn_cvt_pk_fp8_f32(v1[2], v1[3], w1, true);
                    w[bj][0] = w0; w[bj][1] = w1; }
                const unsigned s0 = odd ? w[0][0] : w[1][0], s1 = odd ? w[0][1] : w[1][1];
                const unsigned r0 = (unsigned)__builtin_amdgcn_mov_dpp((int)s0, 0xB1, 0xf, 0xf, true), r1 = (unsigned)__builtin_amdgcn_mov_dpp((int)s1, 0xB1, 0xf, 0xf, true);
                const v2u d1 = odd ? (v2u){r0, r1} : (v2u){w[0][0], w[0][1]};
                const v2u d2 = odd ? (v2u){w[1][0], w[1][1]} : (v2u){r0, r1};
                const int rl = rl0 + ai * 128 + m * 16; const size_t off = (size_t)(u.pm * 256 + rl) * ld + colb;
                if (rl < u.nvalid) *(GAS v2u*)(O + off) = d1;
                if (rl + 1 < u.nvalid) *(GAS v2u*)(O + off + ld) = d2;
            }
            asm volatile("" ::: "memory");
        }
    }
};
struct MergeOrder {
    const unsigned char* A0; const unsigned char* B0; const unsigned char* A1; const unsigned char* B1; int G, c;
    DI bool next(int i, pg8::Unit& u) const {
        const int t = (i >> 1) * G + c, ty = i & 1; int pm, pn;
        if (!static_tile(t, 32, 8, pm, pn)) return false;
        u.a = (const char*)((ty ? A1 : A0) + (size_t)pm * 256 * 1024); u.b = (const char*)((ty ? B1 : B0) + (size_t)pn * 256 * 1024); u.idx = nullptr; u.nvalid = 256; u.pm = pm; u.pn = pn; u.e = ty;
        u.cb = 256 * pn; u.flags = 0; return true;
    }
};
struct EpiMerge {
    static constexpr bool PERM = true; static constexpr int NSTORES = 0;
    bf16_t* M; const bf16_t* GS; const bf16_t* GG;
    DI void operator()(const f32x4 (&acc)[2][2][4][2], const pg8::Unit& u, int wr, int wc, int fr, int fq) const {
        if (u.e == 0) { EpiEw<1> e{M, GS, 2048}; e(acc, u, wr, wc, fr, fq); }
        else { EpiEw<2> e{M, GG, 2048}; e(acc, u, wr, wc, fr, fq); }
    }
};
DI void p64_swap(bool odd, f32x4 (&x0)[2], f32x4 (&x1)[2]) {
#pragma unroll
    for (int n = 0; n < 2; ++n)
#pragma unroll
        for (int j = 0; j < 4; ++j) {
            const float a = x0[n][j], b = x1[n][j];
            const float snd = odd ? a : b;
            const float rcv = __int_as_float(__builtin_amdgcn_mov_dpp(__float_as_int(snd), 0xB1, 0xf, 0xf, true));
            x0[n][j] = odd ? rcv : a; x1[n][j] = odd ? b : rcv;
        }
}
struct EpiMerge64 {
    static constexpr bool PERM = true;
    bf16_t* M; const bf16_t* GS; const bf16_t* GG; unsigned char* M8;
    DI void operator()(const f32x4 (&acc)[2][2][4][2], const pg8::Unit& u, int wr, int wc, int fr, int fq) const {
        const bool odd = (fr & 1) != 0, second = (u.e != 0);
        const bf16_t* P1 = second ? GG : GS;
        const size_t base = (size_t)(u.pm * 256 + wr * 64 + (fr & ~1)) * 2048 + u.cb + 64 * wc + (odd ? 32 : 0) + 8 * fq;
#pragma unroll
        for (int ai = 0; ai < 2; ++ai) {
            v4u p1[4][2], po[4][2];
#pragma unroll
            for (int m = 0; m < 4; ++m)
#pragma unroll
                for (int k = 0; k < 2; ++k) { const size_t off = base + (size_t)(ai * 128 + m * 16 + k) * 2048;
                    p1[m][k] = *(const GAS v4u*)(P1 + off); if (second) po[m][k] = *(const GAS v4u*)(M + off); }
#pragma unroll
            for (int m = 0; m < 4; ++m) {
                f32x4 y0[2] = {acc[ai][0][m][0], acc[ai][0][m][1]}, y1[2] = {acc[ai][1][m][0], acc[ai][1][m][1]};
                p64_swap(odd, y0, y1);
#pragma unroll
                for (int k = 0; k < 2; ++k) { const size_t off = base + (size_t)(ai * 128 + m * 16 + k) * 2048;
                    f32x4 v0 = k ? y1[0] : y0[0], v1 = k ? y1[1] : y0[1], q0, q1; unpack8(p1[m][k], q0, q1);
                    v0 *= q0; v1 *= q1;
                    if (second) { f32x4 o0, o1; unpack8(po[m][k], o0, o1); v0 += o0; v1 += o1;
                        unsigned w0 = 0, w1 = 0;
                        w0 = __builtin_amdgcn_cvt_pk_fp8_f32(v0[0], v0[1], w0, false); w0 = __builtin_amdgcn_cvt_pk_fp8_f32(v0[2], v0[3], w0, true);
                        w1 = __builtin_amdgcn_cvt_pk_fp8_f32(v1[0], v1[1], w1, false); w1 = __builtin_amdgcn_cvt_pk_fp8_f32(v1[2], v1[3], w1, true);
                        *(GAS v2u*)(M8 + off) = (v2u){w0, w1}; }
                    else *(GAS v4u*)(M + off) = pack8(v0, v1); }
            }
            asm volatile("" ::: "memory");
        }
    }
};
struct EpiOut {
    static constexpr bool PERM = true;
    const float* x; const float* mod; bf16_t* X1;
    DI void operator()(const f32x4 (&acc)[2][2][4][2], const pg8::Unit& u, int wr, int wc, int fr, int fq) const {
        const int row0 = u.pm * 256 + wr * 64 + fr, col0 = u.cb + wc * 32 + 8 * fq;
        const float* g1 = mod + (size_t)(u.pm * 256 / SEQ) * (NMOD * D) + 2 * D;
        f32x4 gv[2][2];
#pragma unroll
        for (int bj = 0; bj < 2; ++bj)
#pragma unroll
            for (int n = 0; n < 2; ++n) gv[bj][n] = *(const GAS f32x4*)(g1 + col0 + bj * 128 + n * 4);
#pragma unroll
        for (int ai = 0; ai < 2; ++ai)
#pragma unroll
            for (int mh = 0; mh < 2; ++mh) {
                f32x4 xs[2][2][2];
#pragma unroll
                for (int mm = 0; mm < 2; ++mm)
#pragma unroll
                    for (int bj = 0; bj < 2; ++bj)
#pragma unroll
                        for (int n = 0; n < 2; ++n) xs[mm][bj][n] = __builtin_nontemporal_load((const GAS f32x4*)(x + (size_t)(row0 + ai * 128 + (2 * mh + mm) * 16) * D + col0 + bj * 128 + n * 4));
#pragma unroll
                for (int mm = 0; mm < 2; ++mm)
#pragma unroll
                    for (int bj = 0; bj < 2; ++bj) { const int m = 2 * mh + mm;
                        *(GAS v4u*)(X1 + (size_t)(row0 + ai * 128 + m * 16) * D + col0 + bj * 128) = pack8(xs[mm][bj][0] + gv[bj][0] * acc[ai][bj][m][0], xs[mm][bj][1] + gv[bj][1] * acc[ai][bj][m][1]); }
                asm volatile("" ::: "memory");
            }
    }
};
struct EpiGU {
    static constexpr bool PERM = true;
    unsigned char* HID;
    DI void operator()(const f32x4 (&acc)[2][2][4][2], const pg8::Unit& u, int wr, int wc, int fr, int fq) const {
        const int rl0 = wr * 64 + fr, col0 = u.pn * 128 + wc * 32 + 8 * fq;
#pragma unroll
        for (int ai = 0; ai < 2; ++ai)
#pragma unroll
            for (int m = 0; m < 4; ++m) { const int rl = rl0 + ai * 128 + m * 16; if (rl >= u.nvalid) continue;
                float v[8];
#pragma unroll
                for (int j = 0; j < 4; ++j) { v[j] = siluf_(acc[ai][0][m][0][j]) * acc[ai][1][m][0][j]; v[4 + j] = siluf_(acc[ai][0][m][1][j]) * acc[ai][1][m][1][j]; }
                unsigned w0 = 0, w1 = 0;
                w0 = __builtin_amdgcn_cvt_pk_fp8_f32(v[0], v[1], w0, false); w0 = __builtin_amdgcn_cvt_pk_fp8_f32(v[2], v[3], w0, true);
                w1 = __builtin_amdgcn_cvt_pk_fp8_f32(v[4], v[5], w1, false); w1 = __builtin_amdgcn_cvt_pk_fp8_f32(v[6], v[7], w1, true);
                *(GAS v2u*)(HID + (size_t)(u.pm * 256 + rl) * DEXP + col0) = (v2u){w0, w1}; }
    }
};

DI float gelu_tanh(float x) {
    const float u = 0.7978845608028654f * (x + 0.044715f * x * x * x);
    const float e = __expf(2.f * u);
    const float th = 1.f - 2.f * __builtin_amdgcn_rcpf(e + 1.f);
    return 0.5f * x * (1.f + th);
}
DI int chunk_rowbase(int b, int n) { return (n < NCHC) ? (T + b * CTX + n * GCH) : (b * SEQ + (n - NCHC) * GCH); }
DI float fma_s(float a, float b, float c) { float r; asm("v_fma_f32 %0, %1, %2, %3" : "=v"(r) : "v"(a), "v"(b), "v"(c)); return r; }
struct S5Cur { bf16x8 afr[2]; f32x2 s; };
template <bool READOUT, int DR>
DI void s5_dir(f32x4 (&yacc)[2][2], const S5Cur& o, f32x2& sout, const f32x2 lam, const bf16x8 (&bfr)[4], const bf16x8 (&cfr)[4], LAS unsigned char* hsb, int lane) {
    const int l15 = lane & 15, q4 = lane >> 4;
    const float lr = lam.x, li = lam.y, nli = -lam.y;
    float sr = o.s.x, si = o.s.y;
#pragma unroll
    for (int sbi = 0; sbi < 2; ++sbi) {
        const int sb = DR ? (1 - sbi) : sbi;
        f32x16 c[4];
#pragma unroll
        for (int j = 0; j < 4; ++j) {
#pragma unroll
            for (int r = 0; r < 16; ++r) c[j][r] = 0.f;
            c[j] = MFMA32(o.afr[sb], bfr[j], c[j]);
        }
        float xr[2][16], xi[2][16];
#pragma unroll
        for (int r = 0; r < 16; ++r) {
            const float c0 = c[0][r], c1 = c[1][r], c2 = c[2][r], c3 = c[3][r];
            auto pr = __builtin_amdgcn_permlane32_swap(__float_as_uint(c0), __float_as_uint(c2), false, false);
            auto pi = __builtin_amdgcn_permlane32_swap(__float_as_uint(c1), __float_as_uint(c3), false, false);
            const unsigned pr0 = pr[0], pr1 = pr[1], pi0 = pi[0], pi1 = pi[1];
            xr[0][r] = __uint_as_float(pr0); xr[1][r] = __uint_as_float(pr1);
            xi[0][r] = __uint_as_float(pi0); xi[1][r] = __uint_as_float(pi1);
        }
        if (READOUT) asm volatile("s_waitcnt lgkmcnt(0)" ::: "memory");
#pragma unroll
        for (int tt = 0; tt < 32; ++tt) {
            const int t = DR ? (31 - tt) : tt;
            const int half = (t >> 2) & 1, r = (t & 3) + 4 * (t >> 3);
            const float t1 = fma_s(nli, si, xr[half][r]), t2 = fma_s(li, sr, xi[half][r]);
            const float nr = fma_s(lr, sr, t1), ni = fma_s(lr, si, t2);
            sr = nr; si = ni;
            if (READOUT) *(LAS unsigned*)(hsb + t * 256 + ((((lane >> 2) ^ (t & 15))) << 4) + (lane & 3) * 4) = pk2(nr, ni);
        }
        if (READOUT) {
            asm volatile("s_waitcnt lgkmcnt(0)" ::: "memory");
#pragma unroll
            for (int mt = 0; mt < 2; ++mt)
#pragma unroll
                for (int ks = 0; ks < 4; ++ks) {
                    const int row = 16 * mt + l15, ch = 4 * ks + q4;
                    const bf16x8 a = *(const LAS bf16x8*)(hsb + row * 256 + ((ch ^ l15) << 4));
                    yacc[sb][mt] = MFMA16(a, cfr[ks], yacc[sb][mt]);
                }
        }
    }
    sout = (f32x2){sr, si};
}
template <bool READOUT>
DI void s5_phase(Frame& F) {
    constexpr int NC = READOUT ? NCHL : NCH, NIT = NB * NC * 16;
    const int lane = F.lane, l31 = lane & 31, hi = lane >> 5, l15 = lane & 15, q4 = lane >> 4;
    const int gq = F.wave & 3, dr = F.wave >> 2;
    LAS unsigned char* hsb = F.lds + F.wave * 8192;
    LAS float* ysh = (LAS float*)(F.lds + 65536) + gq * 1024;
    int itn = 0;
    const bf16_t* U = (const bf16_t*)(F.ws + WS_U);
    const bf16_t* BT = (const bf16_t*)(F.ws + WS_S5TAB + S5TAB_BT);
    const bf16_t* CT = (const bf16_t*)(F.ws + WS_S5TAB + S5TAB_CT);
    const f32x2* LAM = (const f32x2*)(F.ws + WS_S5TAB + S5TAB_LAM);
    f32x2* ST = (f32x2*)(F.ws + WS_S5ST);
    bf16_t* YS = (bf16_t*)(F.ws + WS_YS); unsigned char* YS8 = F.ws + WS_YS8;
    bf16x8 bfr[4], cfr[4]; f32x2 lam = (f32x2){0.f, 0.f}; int cur_gb4 = -1;
    S5Cur cur, nxt;
#define S5_LOAD(dst, jj) do { const int gb4_ = (jj) & 15, rest_ = (jj) >> 4, n_ = (rest_ % NC) + (READOUT ? NCHC : 0), b_ = rest_ / NC, g_ = gb4_ * 4 + gq, base_ = chunk_rowbase(b_, n_); \
        _Pragma("unroll") for (int sb = 0; sb < 2; ++sb) (dst).afr[sb] = *(const GAS bf16x8*)(U + (size_t)(base_ + 32 * sb + l31) * S5W + g_ * 16 + 8 * hi); \
        (dst).s = READOUT ? ST[((size_t)((b_ * NCH + n_) * 2 + dr) * 64 + g_) * 64 + lane] : (f32x2){0.f, 0.f}; } while (0)
    if (F.bid < NIT) S5_LOAD(cur, F.bid);
    for (int j = F.bid; j < NIT; j += F.G) {
        const int gb4 = j & 15, rest = j >> 4, n = (rest % NC) + (READOUT ? NCHC : 0), b = rest / NC, g = gb4 * 4 + gq, base = chunk_rowbase(b, n), tg = dr * 64 + g;
        if (gb4 != cur_gb4) {
#pragma unroll
            for (int jj = 0; jj < 4; ++jj) bfr[jj] = *(const GAS bf16x8*)(BT + ((size_t)tg * 128 + 32 * jj + l31) * 16 + 8 * hi);
#pragma unroll
            for (int ks = 0; ks < 4; ++ks) cfr[ks] = READOUT ? *(const GAS bf16x8*)(CT + ((size_t)tg * 16 + l15) * 128 + 32 * ks + 8 * q4) : bfr[ks];
            lam = LAM[tg * 64 + lane]; cur_gb4 = gb4;
        }
        if (j + F.G < NIT) S5_LOAD(nxt, j + F.G);
        f32x4 yacc[2][2];
#pragma unroll
        for (int a = 0; a < 2; ++a)
#pragma unroll
            for (int c = 0; c < 2; ++c) yacc[a][c] = (f32x4){0.f, 0.f, 0.f, 0.f};
        float uskip[8];
        if (READOUT) {
#pragma unroll
            for (int mt = 0; mt < 2; ++mt)
#pragma unroll
                for (int i = 0; i < 4; ++i) uskip[mt * 4 + i] = bf2f(U[(size_t)(base + 32 * dr + 16 * mt + 4 * q4 + i) * S5W + g * 16 + l15]);
        }
        f32x2 sout;
        if (dr == 0) s5_dir<READOUT, 0>(yacc, cur, sout, lam, bfr, cfr, hsb, lane);
        else s5_dir<READOUT, 1>(yacc, cur, sout, lam, bfr, cfr, hsb, lane);
        if (!READOUT) ST[((size_t)((b * NCH + n) * 2 + dr) * 64 + g) * 64 + lane] = sout;
        if (READOUT) {
            LAS float* yx = ysh + (itn & 1) * 4096;
            const int ch = g * 16 + l15; const int osb = 1 - dr;
#pragma unroll
            for (int mt = 0; mt < 2; ++mt)
#pragma unroll
                for (int i = 0; i < 4; ++i) yx[osb * 512 + (16 * mt + 4 * q4 + i) * 16 + l15] = (osb == 0) ? yacc[0][mt][i] : yacc[1][mt][i];
            LDS_BAR();
            const float dsk = F.in[I_S5D][ch];
#pragma unroll
            for (int mt = 0; mt < 2; ++mt)
#pragma unroll
                for (int i = 0; i < 4; ++i) {
                    const int row = 32 * dr + 16 * mt + 4 * q4 + i; const size_t o = (size_t)(base + row) * S5W + ch;
                    const float mine = (dr == 0) ? yacc[0][mt][i] : yacc[1][mt][i];
                    const float yv = gelu_tanh(mine + yx[dr * 512 + (16 * mt + 4 * q4 + i) * 16 + l15] + dsk * uskip[mt * 4 + i]);
                    YS[o] = (bf16_t)f2bf(yv);
                    YS8[o] = (unsigned char)(__builtin_amdgcn_cvt_pk_fp8_f32(yv, 0.f, 0u, false) & 0xffu);
                }
        }
        ++itn;
        cur = nxt;
    }
#undef S5_LOAD
}
DI int chunk_order(int dr, int step) { return dr == 0 ? step : (step < NCHC ? NCHC - 1 - step : NCH + NCHC - 1 - step); }
DI void s5_carry(Frame& F) {
    const int gid = F.bid * 512 + F.tid;
    if (gid >= NB * 2 * 4096) return;
    const int b = gid >> 13, dr = (gid >> 12) & 1, gp = gid & 4095;
    const f32x2 l64 = ((const f32x2*)(F.ws + WS_S5TAB + S5TAB_LAM64))[dr * 4096 + gp];
    f32x2* ST = (f32x2*)(F.ws + WS_S5ST);
    f32x2 e[NCH];
#pragma unroll
    for (int step = 0; step < NCH; ++step) e[step] = ST[(size_t)((b * NCH + chunk_order(dr, step)) * 2 + dr) * 4096 + gp];
    f32x2 h = (f32x2){0.f, 0.f};
#pragma unroll
    for (int step = 0; step < NCH; ++step) {
        ST[(size_t)((b * NCH + chunk_order(dr, step)) * 2 + dr) * 4096 + gp] = h;
        h = (f32x2){l64.x * h.x - l64.y * h.y + e[step].x, l64.x * h.y + l64.y * h.x + e[step].y};
    }
}

constexpr int KST = 72;
constexpr int QST = 136;
struct GlaPre { float up[16]; float bias; f32x4 gs; };
DI void gla_pre_load(Frame& F, int rowbase, int h, int dr, GlaPre& p) {
    const int c = F.tid & 127;
    const float* GKD = (const float*)(F.ws + WS_GKD);
#pragma unroll
    for (int r = 0; r < 16; ++r) p.up[r] = F.in[I_GKUP][(size_t)(dr * 16 + r) * GKW + h * GDK + c];
    p.bias = F.in[I_GKB][dr * GKW + h * GDK + c];
    p.gs = (F.tid < 256) ? *(const GAS f32x4*)(GKD + (size_t)(rowbase + (F.tid >> 2)) * 32 + 16 * dr + 4 * (F.tid & 3)) : (f32x4){0.f, 0.f, 0.f, 0.f};
}
DI float gla_decay(Frame& F, int dr, const GlaPre& p, LAS float* gsc, LAS float* tot, float (&bv)[16]) {
    const int c = F.tid & 127, tq = F.tid >> 7;
    if (F.tid < 256) *(LAS f32x4*)(gsc + (F.tid >> 2) * 16 + 4 * (F.tid & 3)) = p.gs;
    LDS_BAR();
    float gl[16];
#pragma unroll
    for (int tt = 0; tt < 16; ++tt) {
        const LAS f32x4* gr = (const LAS f32x4*)(gsc + (16 * tq + tt) * 16);
        float z = p.bias;
#pragma unroll
        for (int r4 = 0; r4 < 4; ++r4) { const f32x4 gv = gr[r4]; z += gv.x * p.up[4 * r4] + gv.y * p.up[4 * r4 + 1] + gv.z * p.up[4 * r4 + 2] + gv.w * p.up[4 * r4 + 3]; }
        gl[tt] = (fminf(z, 0.f) - __logf(1.f + __expf(-fabsf(z)))) * (1.f / 16.f);
    }
    float run = 0.f;
    if (dr == 0) {
#pragma unroll
        for (int tt = 0; tt < 16; ++tt) { run += gl[tt]; bv[tt] = run; }
    } else {
#pragma unroll
        for (int tt = 15; tt >= 0; --tt) { run += gl[tt]; bv[tt] = run; }
    }
    tot[tq * 128 + c] = run;
    LDS_BAR();
    const float t0 = tot[c], t1 = tot[128 + c], t2 = tot[256 + c], t3 = tot[384 + c];
    float off;
    if (dr == 0) off = (tq > 0 ? t0 : 0.f) + (tq > 1 ? t1 : 0.f) + (tq > 2 ? t2 : 0.f);
    else off = (tq < 1 ? t1 : 0.f) + (tq < 2 ? t2 : 0.f) + (tq < 3 ? t3 : 0.f);
#pragma unroll
    for (int tt = 0; tt < 16; ++tt) bv[tt] += off;
    return (t0 + t1) + (t2 + t3);
}
DI void gla_vT_load(Frame& F, int rowbase, int h, unsigned short (&e)[32]) {
    const bf16_t* V = (const bf16_t*)(F.ws + WS_V);
    const int dv = F.tid & 255, half = F.tid >> 8;
#pragma unroll
    for (int j = 0; j < 32; ++j) e[j] = V[(size_t)(rowbase + 32 * half + j) * GVW + h * GDV + dv];
}
DI void gla_vT_store(Frame& F, const unsigned short (&e)[32], LAS bf16_t* vT) {
    const int dv = F.tid & 255, half = F.tid >> 8;
#pragma unroll
    for (int t8 = 0; t8 < 4; ++t8) {
        v4u w; w.x = e[8 * t8] | ((unsigned)e[8 * t8 + 1] << 16); w.y = e[8 * t8 + 2] | ((unsigned)e[8 * t8 + 3] << 16); w.z = e[8 * t8 + 4] | ((unsigned)e[8 * t8 + 5] << 16); w.w = e[8 * t8 + 6] | ((unsigned)e[8 * t8 + 7] << 16);
        *(LAS v4u*)(vT + dv * KST + 32 * half + 8 * t8) = w;
    }
}
DI void gla_state_item(Frame& F, int b, int h, int n) {
    LAS float* gsc = (LAS float*)F.lds; LAS float* tot = (LAS float*)(F.lds + 4096);
    LAS bf16_t* kdT = (LAS bf16_t*)(F.lds + 6144); LAS bf16_t* vT = (LAS bf16_t*)(F.lds + 24576);
    const int rowbase = chunk_rowbase(b, n);
    const bf16_t* KK = (const bf16_t*)(F.ws + WS_KK);
    bf16_t* GST = (bf16_t*)(F.ws + WS_GST); float* GDEC = (float*)(F.ws + WS_GDEC);
    const int c = F.tid & 127, tq = F.tid >> 7, lane = F.lane, l31 = lane & 31, hi = lane >> 5, w = F.wave;
    GlaPre pre[2]; unsigned short ve[32]; float kf[16];
    gla_pre_load(F, rowbase, h, 0, pre[0]); gla_pre_load(F, rowbase, h, 1, pre[1]);
#pragma unroll
    for (int tt = 0; tt < 16; ++tt) kf[tt] = bf2f(KK[(size_t)(rowbase + 16 * tq + tt) * GKW + h * GDK + c]);
    gla_vT_load(F, rowbase, h, ve);
    gla_vT_store(F, ve, vT);
#pragma unroll
    for (int dr = 0; dr < 2; ++dr) {
        float bv[16];
        const float blast = gla_decay(F, dr, pre[dr], gsc, tot, bv);
        const size_t sbase = (size_t)(((b * GH + h) * NCH + n) * 2 + dr);
        unsigned pk[8];
#pragma unroll
        for (int t2 = 0; t2 < 8; ++t2) pk[t2] = pk2(kf[2 * t2] * __expf(blast - bv[2 * t2]), kf[2 * t2 + 1] * __expf(blast - bv[2 * t2 + 1]));
        *(LAS v4u*)(kdT + c * KST + 16 * tq) = (v4u){pk[0], pk[1], pk[2], pk[3]};
        *(LAS v4u*)(kdT + c * KST + 16 * tq + 8) = (v4u){pk[4], pk[5], pk[6], pk[7]};
        if (tq == 0) GDEC[sbase * GDK + c] = __expf(blast);
        LDS_BAR();
        f32x16 acc[4];
#pragma unroll
        for (int j = 0; j < 4; ++j)
#pragma unroll
            for (int r = 0; r < 16; ++r) acc[j][r] = 0.f;
#pragma unroll
        for (int ks = 0; ks < 4; ++ks) {
            const bf16x8 a = *(const LAS bf16x8*)(vT + (32 * w + l31) * KST + 16 * ks + 8 * hi);
#pragma unroll
            for (int j = 0; j < 4; ++j) { const bf16x8 bb = *(const LAS bf16x8*)(kdT + (32 * j + l31) * KST + 16 * ks + 8 * hi); acc[j] = MFMA32(a, bb, acc[j]); }
        }
#pragma unroll
        for (int j = 0; j < 4; ++j)
#pragma unroll
            for (int r = 0; r < 16; ++r) GST[(sbase * GDV + 32 * w + crow32(r, hi)) * GDK + 32 * j + l31] = (bf16_t)f2bf(acc[j][r]);
        LDS_BAR();
    }
}
DI void gla_carry(Frame& F) {
    bf16_t* GST = (bf16_t*)(F.ws + WS_GST); const float* GDEC = (const float*)(F.ws + WS_GDEC);
    for (int chain = F.bid * 512 + F.tid; chain < NB * GH * 2 * GDV * 16; chain += F.G * 512) {
        const int k8 = chain & 15, dv = (chain >> 4) & 255, dr = (chain >> 12) & 1, h = (chain >> 13) & 3, b = chain >> 15;
        float S[8];
#pragma unroll
        for (int j = 0; j < 8; ++j) S[j] = 0.f;
        constexpr int PF = 4;
        v4u dsw[PF]; f32x4 d0[PF], d1[PF];
#define GC_LOAD(slot, step_) do { const int n_ = chunk_order(dr, (step_)); const size_t sb_ = (size_t)(((b * GH + h) * NCH + n_) * 2 + dr); \
            dsw[slot] = __builtin_nontemporal_load((const GAS v4u*)(GST + (sb_ * GDV + dv) * GDK + 8 * k8)); d0[slot] = *(const GAS f32x4*)(GDEC + sb_ * GDK + 8 * k8); d1[slot] = *(const GAS f32x4*)(GDEC + sb_ * GDK + 8 * k8 + 4); } while (0)
#pragma unroll
        for (int q = 0; q < PF; ++q) GC_LOAD(q, q);
#pragma unroll
        for (int step0 = 0; step0 < NCH; step0 += PF) {
#pragma unroll
            for (int q = 0; q < PF; ++q) {
                const int step = step0 + q;
                const int n = chunk_order(dr, step);
                const size_t sbase = (size_t)(((b * GH + h) * NCH + n) * 2 + dr);
                const v4u w = dsw[q]; const f32x4 e0d = d0[q], e1d = d1[q];
                *(GAS v4u*)(GST + (sbase * GDV + dv) * GDK + 8 * k8) = (v4u){pk2(S[0], S[1]), pk2(S[2], S[3]), pk2(S[4], S[5]), pk2(S[6], S[7])};
                if (step + PF < NCH) GC_LOAD(q, step + PF);
                f32x4 e0, e1; unpack8(w, e0, e1);
#pragma unroll
                for (int j = 0; j < 4; ++j) { S[j] = e0d[j] * S[j] + e0[j]; S[4 + j] = e1d[j] * S[4 + j] + e1[j]; }
            }
        }
#undef GC_LOAD
    }
}
DI void gla_out_item(Frame& F, int b, int h, int nl) {
    LAS float* gsc = (LAS float*)F.lds; LAS float* tot = (LAS float*)(F.lds + 4096);
    LAS bf16_t* qb = (LAS bf16_t*)(F.lds + 6144); LAS bf16_t* kb = (LAS bf16_t*)(F.lds + 23552);
    LAS bf16_t* vT = (LAS bf16_t*)(F.lds + 40960); LAS bf16_t* P = (LAS bf16_t*)(F.lds + 77824);
    LAS float* ot = (LAS float*)F.lds;
    const int n = nl + NCHC, rowbase = b * SEQ + nl * GCH;
    const bf16_t* KK = (const bf16_t*)(F.ws + WS_KK); const bf16_t* Q = (const bf16_t*)(F.ws + WS_Q);
    const bf16_t* GST = (const bf16_t*)(F.ws + WS_GST);
    const int c = F.tid & 127, tq = F.tid >> 7, lane = F.lane, l31 = lane & 31, hi = lane >> 5, w = F.wave;
    f32x16 oacc[2];
#pragma unroll
    for (int mi = 0; mi < 2; ++mi)
#pragma unroll
        for (int r = 0; r < 16; ++r) oacc[mi][r] = 0.f;
    GlaPre pre[2]; unsigned short ve[32]; float kf[16], qf[16]; bf16x8 sfr[2][8];
    gla_pre_load(F, rowbase, h, 0, pre[0]); gla_pre_load(F, rowbase, h, 1, pre[1]);
#pragma unroll
    for (int tt = 0; tt < 16; ++tt) { kf[tt] = bf2f(KK[(size_t)(rowbase + 16 * tq + tt) * GKW + h * GDK + c]); qf[tt] = bf2f(Q[(size_t)(rowbase + 16 * tq + tt) * GKW + h * GDK + c]); }
    gla_vT_load(F, rowbase, h, ve);
#pragma unroll
    for (int dr = 0; dr < 2; ++dr)
#pragma unroll
        for (int ks = 0; ks < 8; ++ks) sfr[dr][ks] = *(const GAS bf16x8*)(GST + (((size_t)(((b * GH + h) * NCH + n) * 2 + dr)) * GDV + 32 * w + l31) * GDK + 16 * ks + 8 * hi);
    v4u gov[4];
    { const size_t o_ = (size_t)(rowbase + (F.tid >> 3)) * GVW + h * GDV + 32 * (F.tid & 7); const bf16_t* GO_ = (const bf16_t*)(F.ws + WS_GO);
#pragma unroll
      for (int j2 = 0; j2 < 4; ++j2) gov[j2] = *(const GAS v4u*)(GO_ + o_ + 8 * j2); }
    gla_vT_store(F, ve, vT);
#pragma unroll
    for (int dr = 0; dr < 2; ++dr) {
        float bv[16];
        (void)gla_decay(F, dr, pre[dr], gsc, tot, bv);
#pragma unroll
        for (int tt = 0; tt < 16; ++tt) {
            const int tau = 16 * tq + tt;
            qb[tau * QST + c] = (bf16_t)f2bf(qf[tt] * __expf(bv[tt]));
            kb[tau * QST + c] = (bf16_t)f2bf(kf[tt] * __expf(-bv[tt]));
        }
        LDS_BAR();
        if (w < 4) {
            const int mi = w >> 1, nj = w & 1;
            f32x16 sc;
#pragma unroll
            for (int r = 0; r < 16; ++r) sc[r] = 0.f;
#pragma unroll
            for (int ks = 0; ks < 8; ++ks) {
                const bf16x8 a = *(const LAS bf16x8*)(qb + (32 * mi + l31) * QST + 16 * ks + 8 * hi);
                const bf16x8 bb = *(const LAS bf16x8*)(kb + (32 * nj + l31) * QST + 16 * ks + 8 * hi);
                sc = MFMA32(a, bb, sc);
            }
#pragma unroll
            for (int r = 0; r < 16; ++r) { const int i = 32 * mi + crow32(r, hi), j = 32 * nj + l31;
                const bool keep = dr ? (j > i) : (j <= i);
                P[i * KST + j] = (bf16_t)f2bf(keep ? sc[r] : 0.f); }
        } else {
        }
#pragma unroll
        for (int ks = 0; ks < 8; ++ks) {
#pragma unroll
            for (int mi = 0; mi < 2; ++mi) { const bf16x8 a = *(const LAS bf16x8*)(qb + (32 * mi + l31) * QST + 16 * ks + 8 * hi); oacc[mi] = MFMA32(a, sfr[dr][ks], oacc[mi]); }
        }
        LDS_BAR();
#pragma unroll
        for (int mi = 0; mi < 2; ++mi) {
#pragma unroll
            for (int ks = 0; ks < 4; ++ks) {
                const bf16x8 a = *(const LAS bf16x8*)(P + (32 * mi + l31) * KST + 16 * ks + 8 * hi);
                const bf16x8 bb = *(const LAS bf16x8*)(vT + (32 * w + l31) * KST + 16 * ks + 8 * hi);
                oacc[mi] = MFMA32(a, bb, oacc[mi]);
            }
        }
        LDS_BAR();
    }
#pragma unroll
    for (int mi = 0; mi < 2; ++mi)
#pragma unroll
        for (int r = 0; r < 16; ++r) ot[(32 * mi + crow32(r, hi)) * 260 + 32 * w + l31] = oacc[mi][r];
    LDS_BAR();
    {
        const int i = F.tid >> 3, seg = F.tid & 7;
        const LAS f32x4* orow = (const LAS f32x4*)(ot + i * 260 + 32 * seg);
        f32x4 v[8]; float ss = 0.f;
#pragma unroll
        for (int j = 0; j < 8; ++j) { v[j] = orow[j]; ss += (v[j].x * v[j].x + v[j].y * v[j].y) + (v[j].z * v[j].z + v[j].w * v[j].w); }
        ss += __shfl_xor(ss, 1); ss += __shfl_xor(ss, 2); ss += __shfl_xor(ss, 4);
        const float rstd = rsqrtf(ss * (1.f / GDV) + EPS);
        const size_t o = (size_t)(rowbase + i) * GVW + h * GDV + 32 * seg;
        unsigned char* OG = F.ws + WS_OG;
        const float* gnw = F.in[I_GNW] + 32 * seg; f32x4 wv[8];
#pragma unroll
        for (int j2 = 0; j2 < 8; ++j2) wv[j2] = *(const GAS f32x4*)(gnw + 4 * j2);
#pragma unroll
        for (int j2 = 0; j2 < 4; ++j2) {
            f32x4 g0, g1; unpack8(gov[j2], g0, g1);
            const f32x4 a0 = v[2 * j2] * rstd * wv[2 * j2] * g0, a1 = v[2 * j2 + 1] * rstd * wv[2 * j2 + 1] * g1;
            unsigned w0 = 0, w1 = 0;
            w0 = __builtin_amdgcn_cvt_pk_fp8_f32(a0.x, a0.y, w0, false); w0 = __builtin_amdgcn_cvt_pk_fp8_f32(a0.z, a0.w, w0, true);
            w1 = __builtin_amdgcn_cvt_pk_fp8_f32(a1.x, a1.y, w1, false); w1 = __builtin_amdgcn_cvt_pk_fp8_f32(a1.z, a1.w, w1, true);
            *(GAS v2u*)(OG + o + 8 * j2) = (v2u){w0, w1};
        }
    }
    LDS_BAR();
}

DI void p9_route(Frame& F) {
    const float* MOD = (const float*)(F.ws + WS_MOD);
    const bf16_t* X1 = (const bf16_t*)(F.ws + WS_X1);
    bf16_t* T2 = (bf16_t*)(F.ws + WS_T2);
    const bf16_t* RT = (const bf16_t*)(F.ws + WS_ROUT_T);
    unsigned* cnt = (unsigned*)(F.ws + WS_CTL) + CW_CNT;
    int* list = (int*)(F.ws + WS_ROUTE + ROUTE_LIST);
    int* eidx = (int*)(F.ws + WS_ROUTE + ROUTE_EIDX); int* slot = (int*)(F.ws + WS_ROUTE + ROUTE_SLOT); float* wts = (float*)(F.ws + WS_ROUTE + ROUTE_WTS);
    LAS float* lg = (LAS float*)(F.lds + 65536);
    LAS unsigned* hist = (LAS unsigned*)(F.lds + 65536 + 8192);
    LAS unsigned* hbase = hist + 64;
    LAS float* wcv = (LAS float*)(F.lds + 132096); LAS float* shv = wcv + 2048;
    const int lane = F.lane;
    for (int tile = F.bid; tile < T / 32; tile += F.G) {
        bf16x8 bfA[16][1]; skinny_bload<1>(bfA, RT, F.wave, lane);
        {
            v4u ra[4], rb[4];
            auto load = [&](v4u (&r)[4], int lr) { const bf16_t* xr = X1 + (size_t)(tile * 32 + lr) * D + 8 * lane;
#pragma unroll
                for (int j = 0; j < 4; ++j) r[j] = *(const GAS v4u*)(xr + 512 * j); };
            auto finish = [&](const v4u (&r)[4], int lr) { const int row = tile * 32 + lr;
                f32x4 v[8]; float ss = 0.f;
#pragma unroll
                for (int j = 0; j < 4; ++j) { unpack8(r[j], v[2 * j], v[2 * j + 1]);
                    ss += (v[2 * j].x * v[2 * j].x + v[2 * j].y * v[2 * j].y) + (v[2 * j].z * v[2 * j].z + v[2 * j].w * v[2 * j].w) + (v[2 * j + 1].x * v[2 * j + 1].x + v[2 * j + 1].y * v[2 * j + 1].y) + (v[2 * j + 1].z * v[2 * j + 1].z + v[2 * j + 1].w * v[2 * j + 1].w); }
                const float rstd = rsqrtf(wave_sum(ss) * (1.f / 2048.f) + EPS);
#pragma unroll
                for (int j = 0; j < 4; ++j) { const int col = 8 * lane + 512 * j;
                    f32x4 y[2];
#pragma unroll
                    for (int q = 0; q < 2; ++q) { const f32x4 wc = *(const LAS f32x4*)(wcv + col + 4 * q), a = *(const LAS f32x4*)(shv + col + 4 * q);
                        y[q] = (v[2 * j + q] * rstd) * wc + a; }
                    unsigned w0 = 0, w1 = 0;
                    w0 = __builtin_amdgcn_cvt_pk_fp8_f32(y[0].x, y[0].y, w0, false); w0 = __builtin_amdgcn_cvt_pk_fp8_f32(y[0].z, y[0].w, w0, true);
                    w1 = __builtin_amdgcn_cvt_pk_fp8_f32(y[1].x, y[1].y, w1, false); w1 = __builtin_amdgcn_cvt_pk_fp8_f32(y[1].z, y[1].w, w1, true);
                    *(GAS v2u*)((unsigned char*)T2 + (size_t)row * D + col) = (v2u){w0, w1};
                    *(LAS v4u*)((LAS bf16_t*)F.lds + lr * AST + col) = (v4u){pk2(y[0].x, y[0].y), pk2(y[0].z, y[0].w), pk2(y[1].x, y[1].y), pk2(y[1].z, y[1].w)}; } };
            const int lr0 = 4 * F.wave;
            load(ra, lr0);
            load(rb, lr0 + 1);
            {
                const float* mr = MOD + (size_t)((tile * 32) / SEQ) * (NMOD * D); const int c4 = 4 * F.tid;
                const f32x4 w = *(const GAS f32x4*)(F.in[I_N2W] + c4), a = *(const GAS f32x4*)(mr + 3 * D + c4), c = *(const GAS f32x4*)(mr + 4 * D + c4);
                *(LAS f32x4*)(wcv + c4) = w * (c + 1.0f); *(LAS f32x4*)(shv + c4) = a;
                __syncthreads();
            }
            finish(ra, lr0);
            load(ra, lr0 + 2); finish(rb, lr0 + 1);
            load(rb, lr0 + 3); finish(ra, lr0 + 2);
            finish(rb, lr0 + 3);
        }
        __syncthreads();
        f32x16 acc[2];
#pragma unroll
        for (int j = 0; j < 2; ++j)
#pragma unroll
            for (int r = 0; r < 16; ++r) acc[j][r] = 0.f;
        { f32x16 a0[1] = {acc[0]}, a1[1] = {acc[1]};
          skinny_gemm<1>(F.lds, bfA, a0, F.wave, lane);
          asm volatile("" ::: "memory");
          skinny_bload<1>(bfA, RT + (size_t)32 * 2048, F.wave, lane);
          skinny_gemm<1>(F.lds, bfA, a1, F.wave, lane);
          acc[0] = a0[0]; acc[1] = a1[0]; }
        __syncthreads();
        LAS float* red = (LAS float*)F.lds;
        skinny_store_partial<2>(red, acc, F.wave, lane);
        if (F.tid < 64) hist[F.tid] = 0u;
        __syncthreads();
        for (int o = F.tid; o < 32 * 64; o += 512) { float s = 0.f;
#pragma unroll
            for (int w = 0; w < 8; ++w) s += red[w * 2048 + o];
            lg[o] = s; }
        __syncthreads();
        int loc[4]; int rk[4]; float sw[4];
        const float rb = F.in[I_RB][lane];
#pragma unroll
        for (int rr = 0; rr < 4; ++rr) {
            const int lr = 4 * F.wave + rr;
            const float s = 1.0f / (1.0f + expf(-lg[lr * 64 + lane]));
            const float ch = s + rb;
            float m1 = ch; m1 = fmaxf(m1, __shfl_xor(m1, 1)); m1 = fmaxf(m1, __shfl_xor(m1, 2)); m1 = fmaxf(m1, __shfl_xor(m1, 4));
            const unsigned long long eq = __ballot(ch == m1);
            const int gshift = lane & ~7;
            const int first = __builtin_ctzll((eq >> gshift) & 0xffull) + gshift;
            float m2 = (lane == first) ? -INFINITY : ch; m2 = fmaxf(m2, __shfl_xor(m2, 1)); m2 = fmaxf(m2, __shfl_xor(m2, 2)); m2 = fmaxf(m2, __shfl_xor(m2, 4));
            const float gs = m1 + m2; const int mygrp = lane >> 3;
            int grank = 0;
#pragma unroll
            for (int gg = 0; gg < 8; ++gg) { const float og = __int_as_float(__builtin_amdgcn_readlane(__float_as_int(gs), gg * 8)); grank += (og > gs || (og == gs && gg < mygrp)) ? 1 : 0; }
            const float cm = (grank < TOPKG) ? ch : -INFINITY;
            int erank = 0;
#pragma unroll
            for (int e2 = 0; e2 < 64; ++e2) { const float oc = __int_as_float(__builtin_amdgcn_readlane(__float_as_int(cm), e2)); erank += (oc > cm || (oc == cm && e2 < lane)) ? 1 : 0; }
            const bool sel = erank < TOPK;
            const float ssum = wave_sum(sel ? s : 0.f);
            rk[rr] = sel ? erank : -1;
            sw[rr] = s / ssum * 2.5f;
            loc[rr] = sel ? (int)__hip_atomic_fetch_add(&hist[lane], 1u, __ATOMIC_RELAXED, __HIP_MEMORY_SCOPE_WORKGROUP) : 0;
        }
        __syncthreads();
        if (F.tid < 64) hbase[F.tid] = atomicAdd(&cnt[16 * F.tid], hist[F.tid]);
        __syncthreads();
#pragma unroll
        for (int rr = 0; rr < 4; ++rr) {
            const int row = tile * 32 + 4 * F.wave + rr;
            if (rk[rr] >= 0) {
                const int pos = (int)hbase[lane] + loc[rr];
                list[(size_t)lane * T + pos] = row;
                eidx[row * 8 + rk[rr]] = lane; slot[row * 8 + rk[rr]] = pos; wts[row * 8 + rk[rr]] = sw[rr];
            }
            if (lane == 0) list[(size_t)64 * T + row] = row;
        }
        __syncthreads();
    }
}

DI void p12_combine(Frame& F, volatile LAS int* tbv) {
    const float* MOD = (const float*)(F.ws + WS_MOD);
    const bf16_t* X1 = (const bf16_t*)(F.ws + WS_X1);
    const unsigned char* YB8 = F.ws + WS_YBUF;
    const int* eidx = (const int*)(F.ws + WS_ROUTE + ROUTE_EIDX); const int* slot = (const int*)(F.ws + WS_ROUTE + ROUTE_SLOT); const float* wts = (const float*)(F.ws + WS_ROUTE + ROUTE_WTS);
    const float* fnw = F.in[I_FNW];
    const int lane = F.lane;
    const LAS int* tb = (const LAS int*)tbv;
    f32x4 fw[8];
#pragma unroll
    for (int j = 0; j < 4; ++j) { fw[2 * j] = *(const GAS f32x4*)(fnw + 8 * lane + 512 * j); fw[2 * j + 1] = *(const GAS f32x4*)(fnw + 8 * lane + 512 * j + 4); }
    const int hbsh = tb[MT_HB + 64];
    for (int row = F.bid * 8 + F.wave; row < T; row += F.G * 8) {
        const float* g2 = MOD + (size_t)(row / SEQ) * (NMOD * D) + 5 * D;
        int e = 64, sl = row; float w = 1.f;
        if (lane < 8) { e = eidx[row * 8 + lane]; sl = slot[row * 8 + lane]; w = wts[row * 8 + lane]; }
        const int yrow = tb[MT_HB + e] + sl;
        unsigned ro[9]; float wk[9];
#pragma unroll
        for (int k = 0; k < 9; ++k) { ro[k] = (unsigned)__builtin_amdgcn_readlane(yrow, k); wk[k] = __builtin_bit_cast(float, __builtin_amdgcn_readlane(__builtin_bit_cast(int, w), k)); }
        f32x4 x2[8]; float ss = 0.f;
#pragma unroll
        for (int jp = 0; jp < 2; ++jp) {
            v2u y[2][9]; v4u xw[2]; f32x4 xa[2], xb[2], ga[2], gb[2];
#pragma unroll
            for (int jj = 0; jj < 2; ++jj) {
                const int col = 8 * lane + 512 * (2 * jp + jj);
#pragma unroll
                for (int k = 0; k < 9; ++k) y[jj][k] = __builtin_nontemporal_load((const GAS v2u*)(YB8 + (size_t)ro[k] * D + col));
                xw[jj] = *(const GAS v4u*)(X1 + (size_t)row * D + col);
                ga[jj] = *(const GAS f32x4*)(g2 + col); gb[jj] = *(const GAS f32x4*)(g2 + col + 4);
            }
#pragma unroll
            for (int jj = 0; jj < 2; ++jj) {
                const int j = 2 * jp + jj;
                unpack8(xw[jj], xa[jj], xb[jj]);
                f32x4 a0 = (f32x4){0.f, 0.f, 0.f, 0.f}, a1 = a0;
#pragma unroll
                for (int k = 0; k < 9; ++k) {
                    const f32x2 p0 = __builtin_amdgcn_cvt_pk_f32_fp8(y[jj][k].x, false), p1 = __builtin_amdgcn_cvt_pk_f32_fp8(y[jj][k].x, true);
                    const f32x2 p2 = __builtin_amdgcn_cvt_pk_f32_fp8(y[jj][k].y, false), p3 = __builtin_amdgcn_cvt_pk_f32_fp8(y[jj][k].y, true);
                    a0 += (f32x4){p0.x, p0.y, p1.x, p1.y} * wk[k]; a1 += (f32x4){p2.x, p2.y, p3.x, p3.y} * wk[k]; }
                x2[2 * j] = xa[jj] + ga[jj] * a0; x2[2 * j + 1] = xb[jj] + gb[jj] * a1;
                ss += (x2[2 * j].x * x2[2 * j].x + x2[2 * j].y * x2[2 * j].y) + (x2[2 * j].z * x2[2 * j].z + x2[2 * j].w * x2[2 * j].w);
                ss += (x2[2 * j + 1].x * x2[2 * j + 1].x + x2[2 * j + 1].y * x2[2 * j + 1].y) + (x2[2 * j + 1].z * x2[2 * j + 1].z + x2[2 * j + 1].w * x2[2 * j + 1].w);
            }
            asm volatile("" ::: "memory");
        }
        const float rstd = rsqrtf(wave_sum(ss) * (1.f / D) + EPS);
#pragma unroll
        for (int j = 0; j < 4; ++j) {
            const int col = 8 * lane + 512 * j;
            __builtin_nontemporal_store(x2[2 * j] * rstd * fw[2 * j], (GAS f32x4*)(F.out + (size_t)row * D + col));
            __builtin_nontemporal_store(x2[2 * j + 1] * rstd * fw[2 * j + 1], (GAS f32x4*)(F.out + (size_t)row * D + col + 4));
        }
    }
}

constexpr int NPHASE = 13;
__global__ void __launch_bounds__(512, 2) hyb_fwd(Args args) {
    extern __shared__ __attribute__((aligned(16))) unsigned char lds[];
    Frame F;
    F.lds = (LAS unsigned char*)lds; F.ws = args.ws; F.in = args.in; F.out = args.out;
    F.tid = threadIdx.x; F.lane = F.tid & 63; F.wave = __builtin_amdgcn_readfirstlane(F.tid >> 6); F.G = gridDim.x; F.bid = blockIdx.x;
    volatile LAS unsigned* MISC = (volatile LAS unsigned*)(F.lds + MISC_OFF);
    volatile LAS int* mtb = (volatile LAS int*)(F.lds + MISC_OFF + 256);
    for (int u = F.tid; u < (LDS_BYTES - MISC_OFF) / 4; u += 512) MISC[u] = 0u;
    __syncthreads();
    unsigned char* ws = args.ws;
    unsigned* ctl = (unsigned*)(ws + WS_CTL);
    const int lo = args.ph_lo, hi = args.ph_hi;
    const bool multi = (hi - lo) > 1;
    XcdBarrier bar; bar.bar = ctl + CW_BAR; bar.x = 0; bar.st = nullptr;
    if (multi) bar = xcd_barrier_post(ctl + CW_BAR, MISC + 8);
#ifndef PHMASK
#define PHMASK 0x1fff
#endif
#define IN(k) ((((PHMASK) >> (k)) & 1) && lo <= (k) && (k) < hi)
#define SEAM(k) do { if (IN(k) && IN((k) + 1)) xcd_barrier(bar); } while (0)
#ifndef REPMASK
#define REPMASK 0
#endif
#ifndef REPPART
#define REPPART 3
#endif
#define REP(k) for (int rep_ = 0; rep_ < 1 + (((REPMASK) >> (k)) & 1); ++rep_, (rep_ < 1 + (((REPMASK) >> (k)) & 1) && multi) ? (xcd_barrier(bar), 0) : 0)

    if (IN(0)) REP(0) { p0_prologue(F); }
    SEAM(0);
    if (IN(1)) REP(1) { p1_norm1(F); }
    SEAM(1);
    if (IN(2)) REP(2) {
        if (F.bid & 1) p0_convert(F, 0, NP_EXPERT);
        { G1Order S{(const bf16_t*)(ws + WS_H), (const bf16_t*)(ws + WS_WIN_T), F.G, F.bid}; EpiG1 E{ws};
          pg8::gemm_phase<EpiG1, G1Order, false>(F.lds, D, S, E); }
        { G1Order8 S{ws + WS_H8, ws + WS_WIN8, F.G, F.bid}; EpiG1 E{ws};
          pg8::gemm_phase<EpiG1, G1Order8, false, 1>(F.lds, D, S, E); }
        if (!(F.bid & 1)) p0_convert(F, 0, NP_EXPERT);
    }
    SEAM(2);
    if (IN(3)) REP(3) {
        if (!rep_ || ((REPPART) & 1)) for (int it = F.bid; it < NB * GH * NCH; it += F.G) { const int n = it % NCH, h = (it / NCH) % GH, b = it / (NCH * GH); gla_state_item(F, b, h, n); }
        if (!rep_ || ((REPPART) & 2)) s5_phase<false>(F);
    }
    SEAM(3);
    if (IN(4)) REP(4) { s5_carry(F); gla_carry(F); }
    SEAM(4);
    if (IN(5)) REP(5) {
        if (!rep_ || ((REPPART) & 1)) for (int it = F.bid; it < NB * GH * NCHL; it += F.G) { const int nl = it % NCHL, h = (it / NCHL) % GH, b = it / (NCHL * GH); gla_out_item(F, b, h, nl); }
        if (!rep_ || ((REPPART) & 2)) s5_phase<true>(F);
    }
    SEAM(5);
    if (IN(6)) REP(6) {
        DenseOrder8 S{ws + WS_YS8, ws + WS_GLU_T, 32, 4, 1024, F.G, F.bid, true};
        EpiEw<0> E{(bf16_t*)(ws + WS_S5G), (const bf16_t*)(ws + WS_YS), 1024};
        pg8::gemm_phase<EpiEw<0>, DenseOrder8, false, 1>(F.lds, 1024, S, E);
    }
    SEAM(6);
    if (IN(7)) REP(7) {
        MergeOrder S{ws + WS_S5G, ws + WS_S5P_T, ws + WS_OG, ws + WS_GLAP_T, F.G, F.bid};
        EpiMerge64 E{(bf16_t*)(ws + WS_M), (const bf16_t*)(ws + WS_GS), (const bf16_t*)(ws + WS_GG), ws + WS_M8};
        pg8::gemm_phase<EpiMerge64, MergeOrder, false, 1, true, true, 0, true>(F.lds, 1024, S, E);
    }
    SEAM(7);
    if (IN(8)) REP(8) {
        DenseOrder8 S{ws + WS_M8, ws + WS_WOUT_T, 32, 8, 2048, F.G, F.bid, false};
        EpiOut E{F.in[I_X], (const float*)(ws + WS_MOD), (bf16_t*)(ws + WS_X1)};
        pg8::gemm_phase<EpiOut, DenseOrder8, false, 1>(F.lds, 2048, S, E);
    }
    SEAM(8);
    if (IN(9)) REP(9) { p9_route(F); }
    SEAM(9);
    if (IN(10)) REP(10) {
        moe_tables(F, mtb); moe_unit_list<4>(F, mtb);
        MoeOrder<4, 1> S{mtb, ws + WS_T2, ws + WS_WGU_T, (const int*)(ws + WS_ROUTE + ROUTE_LIST), 2048, F.G, F.bid};
        EpiGU E{ws + WS_HID};
        pg8::gemm_phase<EpiGU, MoeOrder<4, 1>, true, 1, true, true, 1024>(F.lds, 2048, S, E);
    }
    SEAM(10);
    if (IN(11)) REP(11) {
        moe_tables(F, mtb); moe_unit_list<8>(F, mtb);
        MoeOrder<8, 1> S{mtb, ws + WS_HID, ws + WS_WD_T, nullptr, 512, F.G, F.bid};
        EpiY8 E{ws + WS_YBUF, 2048};
        pg8::gemm_phase<EpiY8, MoeOrder<8, 1>, false, 1, true, true, 2048, true>(F.lds, 512, S, E);
    }
    SEAM(11);
    if (IN(12)) REP(12) { moe_tables(F, mtb); p12_combine(F, mtb); }
#undef IN
#undef SEAM
}

extern "C" void kernel_launch(void* const* d_in, const int* in_sizes, int n_in, void* d_out, int out_size, void* d_ws, size_t ws_size, hipStream_t stream) {
    static int grid = 0;
    if (grid == 0) {
        if (n_in != NIN || out_size != T * D || ws_size < WS_END) { fprintf(stderr, "kernel_launch: unexpected shapes (n_in %d out %d ws %zu need %zu)\n", n_in, out_size, ws_size, (size_t)WS_END); grid = -1; return; }
        int dev = 0, cus = 0, per_cu = 0;
        if (hipGetDevice(&dev) != hipSuccess || hipDeviceGetAttribute(&cus, hipDeviceAttributeMultiprocessorCount, dev) != hipSuccess) { grid = -1; return; }
        if (hipFuncSetAttribute((const void*)hyb_fwd, hipFuncAttributeMaxDynamicSharedMemorySize, LDS_BYTES) != hipSuccess) { fprintf(stderr, "kernel_launch: hipFuncSetAttribute failed\n"); grid = -1; return; }
        if (hipOccupancyMaxActiveBlocksPerMultiprocessor(&per_cu, (const void*)hyb_fwd, 512, LDS_BYTES) != hipSuccess || per_cu < 1) { fprintf(stderr, "kernel_launch: occupancy query says %d\n", per_cu); }
        (void)hipGetLastError();
        grid = cus & ~15;
    }
    if (grid < 0) return;
    (void)hipMemsetAsync((char*)d_ws + WS_CTL, 0, CTL_ZERO_BYTES, stream);
    Args a{};
    for (int i = 0; i < NIN; ++i) a.in[i] = (const float*)d_in[i];
    a.out = (float*)d_out; a.ws = (unsigned char*)d_ws;
#if MK_N_LAUNCHES == 1
    a.ph_lo = 0; a.ph_hi = NPHASE;
    hipLaunchKernelGGL(hyb_fwd, dim3(grid), dim3(512), LDS_BYTES, stream, a);
#else
    for (int p = 0; p < NPHASE; ++p) { a.ph_lo = p; a.ph_hi = p + 1; hipLaunchKernelGGL(hyb_fwd, dim3(grid), dim3(512), LDS_BYTES, stream, a); }
#endif
}
```
